# Optimizing an MI355X kernel written in HIP

```python
import math
import jax, jax.numpy as jnp
from jax import lax
import numpy as np

D_MODEL = 1024
BATCH = 8
SEQ = 4096
DEPTH = 2

N_GROUPS = 4
MIX_HEADS = 4
HEAD_DIM = D_MODEL // (N_GROUPS * MIX_HEADS)
GROUP_WIDTH = MIX_HEADS * HEAD_DIM
MIX_WIDTH = N_GROUPS * GROUP_WIDTH
Q_BLOCK = 128
MLSTM_CHUNK = 64
MLSTM_CONV = 4
NSA_CMP_BLOCK = 32
NSA_CMP_STRIDE = 16
NSA_SEL_BLOCK = 64
NSA_N_SEL = 16
NSA_WINDOW = 512
NUM_BUCKETS = 32
MAX_DISTANCE = 128
D_FF = 2816
N_EXPERTS = 8
TOP_K = 2
D_FF_EXPERT = 3584
MOE_ROW_BLOCK = 128
NORM_EPS = 1e-6
MASK_VALUE = 1e30
N_DENSE = (DEPTH + 1) // 2
N_MOE = DEPTH // 2
IN_WIDTHS = (2 * GROUP_WIDTH, GROUP_WIDTH, GROUP_WIDTH, 2 * MIX_HEADS,
             GROUP_WIDTH, GROUP_WIDTH, GROUP_WIDTH, MIX_HEADS,
             GROUP_WIDTH, GROUP_WIDTH, GROUP_WIDTH,
             GROUP_WIDTH, 6 * HEAD_DIM, 3 * MIX_HEADS)
IN_WIDTH = sum(IN_WIDTHS)

kernel_name = "hybrid_parallel_heads_mlstm_fox_sb_nsa_moe"


def rmsnorm(x, g):
    xf = x.astype(jnp.float32)
    y = xf * lax.rsqrt(jnp.mean(xf * xf, axis=-1, keepdims=True) + NORM_EPS)
    return (y * g.astype(jnp.float32)).astype(x.dtype)


def masked_softmax(s, valid):
    p = jax.nn.softmax(jnp.where(valid, s, -MASK_VALUE), axis=-1)
    return jnp.where(valid, p, 0.0)


def t5_bias(dist, table):
    n = jnp.maximum(dist, 0)
    max_exact = NUM_BUCKETS // 2
    large = max_exact + (jnp.log(jnp.maximum(n, 1).astype(jnp.float32) / max_exact)
                         / math.log(MAX_DISTANCE / max_exact) * (NUM_BUCKETS - max_exact)).astype(jnp.int32)
    bucket = jnp.where(n < max_exact, n, jnp.minimum(large, NUM_BUCKETS - 1))
    return table[bucket].astype(jnp.float32)


def block_sweep(fn, seq):
    out = lax.map(fn, jnp.arange(seq // Q_BLOCK))
    n, b, qb, h, d = out.shape
    return jnp.moveaxis(out, 0, 1).reshape(b, n * qb, h, d)


def causal_conv(x, w):
    k, s = w.shape[0], x.shape[1]
    xp = jnp.pad(x, ((0, 0), (k - 1, 0), (0, 0)))
    return sum(w[j] * xp[:, k - 1 - j:k - 1 - j + s] for j in range(k))


def mlstm_chunkwise(q, k, v, ig, fg):
    B, S, H, Dh = q.shape
    L = MLSTM_CHUNK
    nc = S // L

    def chunks(a):
        return jnp.moveaxis(a.reshape(B, nc, L, H, *a.shape[3:]), 3, 1)

    q, k, v, ig = chunks(q), chunks(k), chunks(v), chunks(ig)
    b = jnp.cumsum(jax.nn.log_sigmoid(chunks(fg)), axis=-1)
    g = b[..., -1]
    w = g[..., None] - b + ig
    m_loc = jnp.max(w, axis=-1)
    ew = jnp.exp(w - m_loc[..., None])
    c_chunk = jnp.einsum('bhcl,bhcld,bhcle->bhcde', ew, v, k)
    n_chunk = jnp.einsum('bhcl,bhcle->bhce', ew, k)

    def step(carry, xs):
        C, n, m = carry
        c_c, n_c, ml_c, g_c = xs
        m_new = jnp.maximum(g_c + m, ml_c)
        a = jnp.exp(g_c + m - m_new)
        bb = jnp.exp(ml_c - m_new)
        C_new = a[..., None, None] * C + bb[..., None, None] * c_c
        n_new = a[..., None] * n + bb[..., None] * n_c
        return (C_new, n_new, m_new), (C, n, m)

    init = (jnp.zeros((B, H, Dh, Dh), jnp.float32), jnp.zeros((B, H, Dh), jnp.float32),
            jnp.zeros((B, H), jnp.float32))
    xs = tuple(jnp.moveaxis(a, 2, 0) for a in (c_chunk, n_chunk, m_loc, g))
    _, (C_prev, n_prev, m_prev) = lax.scan(step, init, xs)
    C_prev = jnp.moveaxis(C_prev, 0, 2)
    n_prev = jnp.moveaxis(n_prev, 0, 2)
    m_prev = jnp.moveaxis(m_prev, 0, 2)

    tri = jnp.tril(jnp.ones((L, L), bool))
    d_log = jnp.where(tri, b[..., :, None] - b[..., None, :] + ig[..., None, :], -MASK_VALUE)
    m_inter = b + m_prev[..., None]
    m_t = jnp.maximum(jnp.max(d_log, axis=-1), m_inter)
    s = jnp.einsum('bhcld,bhcsd->bhcls', q, k) * jnp.exp(d_log - m_t[..., None])
    inter_w = jnp.exp(m_inter - m_t)
    num = jnp.einsum('bhcls,bhcsd->bhcld', s, v) + inter_w[..., None] * jnp.einsum('bhcde,bhcle->bhcld', C_prev, q)
    den = jnp.sum(s, axis=-1) + inter_w * jnp.einsum('bhce,bhcle->bhcl', n_prev, q)
    h = num / jnp.maximum(jnp.abs(den), jnp.exp(-m_t))[..., None]
    return jnp.moveaxis(h, 1, 3).reshape(B, S, H, Dh)


def mlstm_mixer(qk_raw, v_raw, o_pre, if_pre, conv_w, gate_b, out_g):
    B, S, _ = v_raw.shape
    H, Dh = MIX_HEADS, HEAD_DIM
    qk = jax.nn.silu(causal_conv(qk_raw, conv_w))
    q, k = jnp.split(qk, 2, axis=-1)
    q = q.reshape(B, S, H, Dh).astype(jnp.float32)
    k = k.reshape(B, S, H, Dh).astype(jnp.float32) * (Dh ** -0.5)
    v = v_raw.reshape(B, S, H, Dh).astype(jnp.float32)
    gates = if_pre.astype(jnp.float32) + gate_b.astype(jnp.float32)
    h = mlstm_chunkwise(q, k, v, gates[..., :H], gates[..., H:])
    h = rmsnorm(h, out_g.reshape(H, Dh)).reshape(B, S, GROUP_WIDTH)
    return (h * jax.nn.sigmoid(o_pre.astype(jnp.float32))).astype(v_raw.dtype)


def fox_mixer(q, k, v, f_pre, f_b, q_g, k_g):
    B, S, _ = q.shape
    H, Dh = MIX_HEADS, HEAD_DIM
    q = rmsnorm(q.reshape(B, S, H, Dh), q_g)
    k = rmsnorm(k.reshape(B, S, H, Dh), k_g)
    v = v.reshape(B, S, H, Dh)
    F = jnp.cumsum(jax.nn.log_sigmoid(f_pre.astype(jnp.float32) + f_b.astype(jnp.float32)), axis=1)
    F = jnp.transpose(F, (0, 2, 1))
    kpos = jnp.arange(S)
    scale = Dh ** -0.5

    def blk(i):
        t0 = i * Q_BLOCK
        t = t0 + jnp.arange(Q_BLOCK)
        qb = lax.dynamic_slice_in_dim(q, t0, Q_BLOCK, axis=1)
        Fq = lax.dynamic_slice_in_dim(F, t0, Q_BLOCK, axis=2)
        s = jnp.einsum('bthd,bshd->bhts', qb, k).astype(jnp.float32) * scale + (Fq[..., :, None] - F[..., None, :])
        p = masked_softmax(s, kpos[None, :] <= t[:, None])
        return jnp.einsum('bhts,bshd->bthd', p.astype(v.dtype), v)

    return block_sweep(blk, S).reshape(B, S, GROUP_WIDTH)


def stick_breaking_mixer(q, k, v):
    B, S, _ = q.shape
    H, Dh = MIX_HEADS, HEAD_DIM
    q = q.reshape(B, S, H, Dh)
    k = k.reshape(B, S, H, Dh)
    v = v.reshape(B, S, H, Dh)
    kpos = jnp.arange(S)
    scale = Dh ** -0.5

    def blk(i):
        t0 = i * Q_BLOCK
        t = t0 + jnp.arange(Q_BLOCK)
        qb = lax.dynamic_slice_in_dim(q, t0, Q_BLOCK, axis=1)
        z = jnp.einsum('bthd,bshd->bhts', qb, k).astype(jnp.float32) * scale
        strict = kpos[None, :] < t[:, None]
        log_rest = jnp.where(strict, jax.nn.log_sigmoid(-z), 0.0)
        suffix = lax.cumsum(log_rest, axis=3, reverse=True) - log_rest
        a = jnp.where(strict, jnp.exp(jax.nn.log_sigmoid(z) + suffix), 0.0)
        return jnp.einsum('bhts,bshd->bthd', a.astype(v.dtype), v)

    return block_sweep(blk, S).reshape(B, S, GROUP_WIDTH)


def nsa_mixer(q, kv, g_pre, rel_bias, q_g, k_g, cmp_pos, cmp_wk, cmp_wv, gate_b):
    B, S, _ = q.shape
    H, Dh = MIX_HEADS, HEAD_DIM
    q = rmsnorm(q.reshape(B, S, H, Dh), q_g)
    kc_tok, vc_tok, k_sel, v_sel, k_win, v_win = jnp.split(kv, 6, axis=-1)
    k_sel = rmsnorm(k_sel, k_g[1])
    k_win = rmsnorm(k_win, k_g[2])
    n_cmp = (S - NSA_CMP_BLOCK) // NSA_CMP_STRIDE + 1
    cmp_start = jnp.arange(n_cmp) * NSA_CMP_STRIDE
    cmp_idx = cmp_start[:, None] + jnp.arange(NSA_CMP_BLOCK)[None, :]

    def compress(tok, w):
        return (tok[:, cmp_idx] + cmp_pos).reshape(B, n_cmp, NSA_CMP_BLOCK * Dh) @ w

    k_cmp = rmsnorm(compress(kc_tok, cmp_wk), k_g[0])
    v_cmp = compress(vc_tok, cmp_wv)
    cmp_end = cmp_start + NSA_CMP_BLOCK - 1
    n_sel = S // NSA_SEL_BLOCK
    k_top = min(NSA_N_SEL, n_sel)
    sel_start = jnp.arange(n_sel) * NSA_SEL_BLOCK
    overlap = jnp.clip(jnp.minimum(cmp_end[:, None] + 1, sel_start[None, :] + NSA_SEL_BLOCK)
                       - jnp.maximum(cmp_start[:, None], sel_start[None, :]), 0).astype(jnp.float32) / NSA_CMP_BLOCK
    k_win_p = jnp.pad(k_win, ((0, 0), (NSA_WINDOW, 0), (0, 0)))
    v_win_p = jnp.pad(v_win, ((0, 0), (NSA_WINDOW, 0), (0, 0)))
    gates = jax.nn.sigmoid(g_pre.astype(jnp.float32) + gate_b.astype(jnp.float32)).reshape(B, S, H, 3)
    scale = Dh ** -0.5
    gather = jax.vmap(lambda a, idx: a[idx])
    blk_id = jnp.arange(n_sel)

    def blk(i):
        t0 = i * Q_BLOCK
        t = t0 + jnp.arange(Q_BLOCK)
        qb = lax.dynamic_slice_in_dim(q, t0, Q_BLOCK, axis=1)
        s_c = (jnp.einsum('bthd,bnd->bhtn', qb, k_cmp).astype(jnp.float32) * scale
               + jnp.transpose(t5_bias(t[:, None] - cmp_end[None, :], rel_bias), (2, 0, 1)))
        p_c = masked_softmax(s_c, cmp_end[None, :] <= t[:, None])
        o_cmp = jnp.einsum('bhtn,bnd->bthd', p_c.astype(v_cmp.dtype), v_cmp)
        imp = jnp.einsum('bhtn,nj->btj', p_c, overlap)
        cur = t // NSA_SEL_BLOCK
        forced = (blk_id[None, :] == 0) | (blk_id[None, :] == cur[:, None]) | (blk_id[None, :] == cur[:, None] - 1)
        score = jnp.where(forced, MASK_VALUE, jnp.where(sel_start[None, :] <= t[:, None], imp, -MASK_VALUE))
        _, top = lax.top_k(score, k_top)
        tok = (top[..., None] * NSA_SEL_BLOCK + jnp.arange(NSA_SEL_BLOCK)).reshape(B, Q_BLOCK, k_top * NSA_SEL_BLOCK)
        ks = gather(k_sel, tok)
        vs = gather(v_sel, tok)
        dist_s = t[None, :, None] - tok
        s_s = (jnp.einsum('bthd,btkd->bhtk', qb, ks).astype(jnp.float32) * scale
               + jnp.transpose(t5_bias(dist_s, rel_bias), (0, 3, 1, 2)))
        p_s = masked_softmax(s_s, (dist_s >= 0)[:, None])
        o_sel = jnp.einsum('bhtk,btkd->bthd', p_s.astype(vs.dtype), vs)
        kw = lax.dynamic_slice_in_dim(k_win_p, t0, Q_BLOCK + NSA_WINDOW, axis=1)
        vw = lax.dynamic_slice_in_dim(v_win_p, t0, Q_BLOCK + NSA_WINDOW, axis=1)
        spos = t0 - NSA_WINDOW + jnp.arange(Q_BLOCK + NSA_WINDOW)
        dist_w = t[:, None] - spos[None, :]
        valid_w = (dist_w >= 0) & (dist_w < NSA_WINDOW) & (spos[None, :] >= 0)
        s_w = (jnp.einsum('bthd,bsd->bhts', qb, kw).astype(jnp.float32) * scale
               + jnp.transpose(t5_bias(dist_w, rel_bias), (2, 0, 1)))
        p_w = masked_softmax(s_w, valid_w)
        o_win = jnp.einsum('bhts,bsd->bthd', p_w.astype(vw.dtype), vw)
        g = lax.dynamic_slice_in_dim(gates, t0, Q_BLOCK, axis=1)
        return (g[..., 0:1] * o_cmp + g[..., 1:2] * o_sel + g[..., 2:3] * o_win).astype(q.dtype)

    return block_sweep(blk, S).reshape(B, S, GROUP_WIDTH)


def swiglu(h, wg, wu, wd):
    return (jax.nn.silu(h @ wg) * (h @ wu)) @ wd


def moe_swiglu(h, router_w, router_b, wg, wu, wd):
    B, S, D = h.shape
    T = B * S
    xf = h.reshape(T, D)
    logits = (xf @ router_w).astype(jnp.float32) + router_b.astype(jnp.float32)
    top_logit, top_e = lax.top_k(logits, TOP_K)
    top_w = jax.nn.softmax(top_logit, axis=-1)
    n_assign = T * TOP_K
    e_flat = top_e.reshape(-1)
    tok_flat = jnp.repeat(jnp.arange(T, dtype=jnp.int32), TOP_K)
    w_flat = top_w.reshape(-1)
    order = jnp.argsort(e_flat)
    e_s = e_flat[order]
    counts = jnp.bincount(e_flat, length=N_EXPERTS)
    padded = (counts + MOE_ROW_BLOCK - 1) // MOE_ROW_BLOCK * MOE_ROW_BLOCK
    start = jnp.cumsum(counts) - counts
    pstart = jnp.cumsum(padded) - padded
    dest = pstart[e_s] + jnp.arange(n_assign) - start[e_s]
    n_blocks = -(-(n_assign + N_EXPERTS * MOE_ROW_BLOCK) // MOE_ROW_BLOCK)
    n_rows = n_blocks * MOE_ROW_BLOCK
    row_tok = jnp.zeros((n_rows,), jnp.int32).at[dest].set(tok_flat[order])
    row_w = jnp.zeros((n_rows,), jnp.float32).at[dest].set(w_flat[order])
    blk_expert = jnp.minimum(jnp.searchsorted(jnp.cumsum(padded), jnp.arange(n_blocks) * MOE_ROW_BLOCK,
                                              side='right'), N_EXPERTS - 1)

    def expert_block(args):
        tok_b, e = args
        xb = xf[tok_b]
        return (jax.nn.silu(xb @ wg[e]) * (xb @ wu[e])) @ wd[e]

    y = lax.map(expert_block, (row_tok.reshape(n_blocks, MOE_ROW_BLOCK), blk_expert)).reshape(n_rows, D)
    out = jnp.zeros((T, D), y.dtype).at[row_tok].add(y * row_w[:, None].astype(y.dtype))
    return out.reshape(B, S, D).astype(h.dtype)


def setup_inputs(seed: int = 0) -> dict:
    key = jax.random.key(seed)
    ks = iter(jax.random.split(key, 40))
    f32 = jnp.float32

    def nrm(shape, scale):
        return jax.random.normal(next(ks), shape, f32) * scale

    def gain(shape):
        return 1.0 + nrm(shape, 0.05)

    D, H, Dh = D_MODEL, MIX_HEADS, HEAD_DIM
    return {
        "x": nrm((BATCH, SEQ, D), 1.0),
        "c": nrm((BATCH, D), 1.0),
        "rel_bias": nrm((NUM_BUCKETS, H), 0.5),
        "ada_w": nrm((DEPTH, D, 6 * D), 0.5 * D ** -0.5),
        "ada_b": nrm((DEPTH, 6 * D), 0.02),
        "norm1_g": gain((DEPTH, D)),
        "norm2_g": gain((DEPTH, D)),
        "w_in": nrm((DEPTH, D, IN_WIDTH), D ** -0.5),
        "w_out": nrm((DEPTH, MIX_WIDTH, D), MIX_WIDTH ** -0.5),
        "mlstm_conv_w": nrm((DEPTH, MLSTM_CONV, 2 * GROUP_WIDTH), MLSTM_CONV ** -0.5),
        "mlstm_gate_b": jnp.concatenate([nrm((DEPTH, H), 0.1), 3.0 + nrm((DEPTH, H), 0.5)], axis=-1),
        "mlstm_out_g": gain((DEPTH, GROUP_WIDTH)),
        "fox_f_b": 3.0 + nrm((DEPTH, H), 0.5),
        "fox_q_g": gain((DEPTH, Dh)),
        "fox_k_g": gain((DEPTH, Dh)),
        "nsa_q_g": gain((DEPTH, Dh)),
        "nsa_k_g": gain((DEPTH, 3, Dh)),
        "nsa_cmp_pos": nrm((DEPTH, NSA_CMP_BLOCK, Dh), 0.1),
        "nsa_cmp_wk": nrm((DEPTH, NSA_CMP_BLOCK * Dh, Dh), (NSA_CMP_BLOCK * Dh) ** -0.5),
        "nsa_cmp_wv": nrm((DEPTH, NSA_CMP_BLOCK * Dh, Dh), (NSA_CMP_BLOCK * Dh) ** -0.5),
        "nsa_gate_b": nrm((DEPTH, 3 * H), 0.1),
        "ffn_wg": nrm((N_DENSE, D, D_FF), D ** -0.5),
        "ffn_wu": nrm((N_DENSE, D, D_FF), D ** -0.5),
        "ffn_wd": nrm((N_DENSE, D_FF, D), D_FF ** -0.5),
        "moe_router_w": nrm((N_MOE, D, N_EXPERTS), D ** -0.5),
        "moe_router_b": nrm((N_MOE, N_EXPERTS), 0.01),
        "moe_wg": nrm((N_MOE, N_EXPERTS, D, D_FF_EXPERT), D ** -0.5),
        "moe_wu": nrm((N_MOE, N_EXPERTS, D, D_FF_EXPERT), D ** -0.5),
        "moe_wd": nrm((N_MOE, N_EXPERTS, D_FF_EXPERT, D), D_FF_EXPERT ** -0.5),
    }


def reference(x, c, rel_bias, ada_w, ada_b, norm1_g, norm2_g, w_in, w_out,
              mlstm_conv_w, mlstm_gate_b, mlstm_out_g, fox_f_b, fox_q_g, fox_k_g,
              nsa_q_g, nsa_k_g, nsa_cmp_pos, nsa_cmp_wk, nsa_cmp_wv, nsa_gate_b,
              ffn_wg, ffn_wu, ffn_wd, moe_router_w, moe_router_b, moe_wg, moe_wu, moe_wd):
    split_at = [int(v) for v in np.cumsum(IN_WIDTHS)[:-1]]
    cond = jax.nn.silu(c)
    for l in range(DEPTH):
        mod = cond @ ada_w[l] + ada_b[l]
        sh1, sc1, g1, sh2, sc2, g2 = [m[:, None, :] for m in jnp.split(mod, 6, axis=-1)]
        h = rmsnorm(x, norm1_g[l]) * (1.0 + sc1) + sh1
        (m_qk, m_v, m_o, m_if, f_q, f_k, f_v, f_f,
         s_q, s_k, s_v, n_q, n_kv, n_g) = jnp.split(h @ w_in[l], split_at, axis=-1)
        y_a = mlstm_mixer(m_qk, m_v, m_o, m_if, mlstm_conv_w[l], mlstm_gate_b[l], mlstm_out_g[l])
        y_b = fox_mixer(f_q, f_k, f_v, f_f, fox_f_b[l], fox_q_g[l], fox_k_g[l])
        y_c = stick_breaking_mixer(s_q, s_k, s_v)
        y_d = nsa_mixer(n_q, n_kv, n_g, rel_bias, nsa_q_g[l], nsa_k_g[l], nsa_cmp_pos[l],
                        nsa_cmp_wk[l], nsa_cmp_wv[l], nsa_gate_b[l])
        mix = jnp.concatenate([y_a, y_b, y_c, y_d], axis=-1)
        x = x + g1 * (mix @ w_out[l])
        h = rmsnorm(x, norm2_g[l]) * (1.0 + sc2) + sh2
        if l % 2 == 0:
            f = swiglu(h, ffn_wg[l // 2], ffn_wu[l // 2], ffn_wd[l // 2])
        else:
            f = moe_swiglu(h, moe_router_w[l // 2], moe_router_b[l // 2], moe_wg[l // 2], moe_wu[l // 2], moe_wd[l // 2])
        x = x + g2 * f
    return x
```

```cpp
#include <hip/hip_runtime.h>
#include <cstdio>
#include <cstdint>
#include <cmath>
#ifndef N_LAUNCHES
#define N_LAUNCHES 1
#endif
#ifndef RES_BATCH
#define RES_BATCH 4
#endif
#ifndef FOX_STATIC
#define FOX_STATIC 1
#endif
#ifndef NSA_STATIC
#define NSA_STATIC 1
#endif
#ifndef MIX_FOX
#define MIX_FOX 1
#endif
#ifndef MIX_SB
#define MIX_SB 1
#endif
#ifndef MIX_NSA
#define MIX_NSA 1
#endif
#ifndef MIX_MLSTM
#define MIX_MLSTM 1
#endif
#ifndef EN_PRO
#define EN_PRO 1
#endif
#ifndef EN_NORM
#define EN_NORM 1
#endif
#ifndef EN_GIN
#define EN_GIN 1
#endif
#ifndef EN_PREP
#define EN_PREP 1
#endif
#ifndef EN_SCAN
#define EN_SCAN 1
#endif
#ifndef EN_MIX
#define EN_MIX 1
#endif
#ifndef EN_GOUT
#define EN_GOUT 1
#endif
#ifndef EN_GU
#define EN_GU 1
#endif
#ifndef EN_DOWN
#define EN_DOWN 1
#endif
#ifndef EN_MOE
#define EN_MOE 1
#endif
#ifndef EN_MGU
#define EN_MGU 1
#endif
#ifndef EN_MDOWN
#define EN_MDOWN 1
#endif
#ifndef REP_PRO
#define REP_PRO 1
#endif
#ifndef REP_GIN
#define REP_GIN 1
#endif
#ifndef REP_PREP
#define REP_PREP 1
#endif
#ifndef REP_MIX
#define REP_MIX 1
#endif
#ifndef REP_GU
#define REP_GU 1
#endif
#ifndef REP_NORM
#define REP_NORM 1
#endif
#ifndef REPU_FOX
#define REPU_FOX 1
#endif
#ifndef REPU_SB
#define REPU_SB 1
#endif
#ifndef REPU_NSA
#define REPU_NSA 1
#endif
#ifndef REPU_ML
#define REPU_ML 1
#endif
#ifndef XTRA_BAR
#define XTRA_BAR 0
#endif
#ifndef REP_GATHER
#define REP_GATHER 1
#endif
#ifndef REP_RES
#define REP_RES 1
#endif
#ifndef RPF
#define RPF 15
#endif
#ifndef NSADRY
#define NSADRY 0
#endif
#ifndef GU_ALIGN
#define GU_ALIGN true
#endif
#ifndef REP_THIN
#define REP_THIN 1
#endif
#ifndef PREP_RMODE
#define PREP_RMODE 1
#endif
#ifndef GDRY
#define GDRY 0
#endif
#ifndef QORDER
#define QORDER 0
#endif
namespace pg8 {
#define PG8_LAS __attribute__((address_space(3)))
typedef unsigned short bf16_t;
typedef short bf16x8 __attribute__((ext_vector_type(8)));
typedef float f32x4 __attribute__((ext_vector_type(4)));
typedef unsigned u32x4 __attribute__((ext_vector_type(4)));
constexpr int BM = 256, BK = 64, HALF = 128, HTB = HALF * BK * 2  , STAGE_BYTES = 8 * HTB, NXCD = 8, WGM = 8;

__host__ __device__ __forceinline__ int lds_byte(int r, int c) { const int st = (r >> 4) * 2 + (c >> 5), rr = r & 15, cc = c & 31, ob = rr * 64 + cc * 2; return st * 1024 + (ob ^ (((ob >> 9) & 1) << 5)); }
__host__ __device__ __forceinline__ void stage_rc(int b, int& R, int& C) { const int st = b / 1024, sb = b % 1024, swz = sb ^ (((sb >> 9) & 1) << 5); R = (st >> 1) * 16 + swz / 64; C = (st & 1) * 32 + (swz % 64) / 2; }
__host__ __device__ __forceinline__ int perm32(int rho) { const int n = rho >> 4, i = rho & 15; return 8 * (i >> 2) + 4 * n + (i & 3); }

struct Unit { int pm, pn; };
struct Gemm { const bf16_t* A; const bf16_t* Bt; int M, N, K; };

struct StaticOrder {
    int nM, nN, nwg, G, c;
    __host__ __device__ void init(int M, int N, int G_, int c_) { nM = M / BM; nN = N / BM; nwg = nM * nN; G = G_; c = c_; }
    __host__ __device__ bool next(int i, Unit& u) const {
        const long L = (long)i * G + c; if (L >= nwg) return false;
        int wgid = (int)L; { const int q = nwg / NXCD, r = nwg % NXCD, xcd = wgid % NXCD, off = wgid / NXCD; wgid = (xcd < r ? xcd * (q + 1) : r * (q + 1) + (xcd - r) * q) + off; }
        const int nig = WGM * nN, gid = wgid / nig, fm = gid * WGM, gsz = (nM - fm) < WGM ? (nM - fm) : WGM;
        u.pm = fm + ((wgid % nig) % gsz); u.pn = (wgid % nig) / gsz; return true;
    }
    __device__ __forceinline__ void a_ready(const Unit&) const {}
    __device__ __forceinline__ void done(const Unit&) const {}
};
__device__ __forceinline__ unsigned cvt_pk_bf16(float lo, float hi) { unsigned r; asm volatile("v_cvt_pk_bf16_f32 %0, %1, %2" : "=v"(r) : "v"(lo), "v"(hi)); return r; }
typedef float f32x2 __attribute__((ext_vector_type(2)));

__device__ __forceinline__ float silu_f(float x) { return x * __builtin_amdgcn_rcpf(1.0f + __builtin_amdgcn_exp2f(-1.4426950408889634f * x)); }
struct EpiBf16 {
    static constexpr bool PERM = true, AFTER_DRAIN = false;
    bf16_t* O; int ldc; int dry;
    __device__ __forceinline__ void operator()(const f32x4 (&acc)[2][2][4][2], const Unit& u, int wr, int wc, int fr, int fq) const {
        if (dry) return;
        const int row0 = u.pm * BM + wr * 64 + fr, col0 = u.pn * BM + wc * 32 + 8 * fq;
#pragma unroll
        for (int ai = 0; ai < 2; ++ai)
#pragma unroll
            for (int m = 0; m < 4; ++m) { bf16_t* rowp = O + (size_t)(row0 + ai * HALF + m * 16) * ldc + col0;
#pragma unroll
                for (int bj = 0; bj < 2; ++bj) { const f32x4 v0 = acc[ai][bj][m][0], v1 = acc[ai][bj][m][1];
                    u32x4 w; w.x = cvt_pk_bf16(v0[0], v0[1]); w.y = cvt_pk_bf16(v0[2], v0[3]); w.z = cvt_pk_bf16(v1[0], v1[1]); w.w = cvt_pk_bf16(v1[2], v1[3]);
                    *(u32x4*)(rowp + bj * HALF) = w; } }
    }
};
struct EpiBf16N {
    static constexpr bool PERM = true, AFTER_DRAIN = false;
    bf16_t* O; int ldc; const float* GT; PG8_LAS float* SC; int dry;
    __device__ __forceinline__ static int head_type(int hc) { return (hc >= 1024 && hc < 1280) ? 0 : (hc >= 1280 && hc < 1536) ? 1 : (hc >= 1792 && hc < 2048) ? 2 : (hc >= 2560 && hc < 2816) ? 3 : hc == 2944 ? 4 : hc == 3072 ? 5 : -1; }
    __device__ __forceinline__ void operator()(const f32x4 (&acc)[2][2][4][2], const Unit& u, int wr, int wc, int fr, int fq) const {
        if (dry) return;
        asm volatile("" : "+v"(fr), "+v"(fq));
        const int pn = __builtin_amdgcn_readfirstlane(u.pn);
        const int row0 = u.pm * BM + wr * 64 + fr, col0 = pn * BM + wc * 32 + 8 * fq;
        const bool ntile = (pn == 4) | (pn == 5) | (pn == 10) | (pn == 11) | (pn == 12), stile = ntile | (pn == 7);
        if (!stile) {
#pragma unroll
            for (int ai = 0; ai < 2; ++ai)
#pragma unroll
                for (int m = 0; m < 4; ++m) { bf16_t* rowp = O + (size_t)(row0 + ai * HALF + m * 16) * ldc + col0;
#pragma unroll
                    for (int bj = 0; bj < 2; ++bj) { const f32x4 v0 = acc[ai][bj][m][0], v1 = acc[ai][bj][m][1];
                        u32x4 w; w.x = cvt_pk_bf16(v0[0], v0[1]); w.y = cvt_pk_bf16(v0[2], v0[3]); w.z = cvt_pk_bf16(v1[0], v1[1]); w.w = cvt_pk_bf16(v1[2], v1[3]);
                        *(u32x4*)(rowp + bj * HALF) = w; } }
            return;
        }
        const int wid = wr * 4 + wc;
#pragma unroll
        for (int bj = 0; bj < 2; ++bj) {
            const int ty = head_type(pn * BM + bj * HALF + (wc >> 1) * 64);
            const bool nrm = ntile && ty >= 0 && ty != 2;
            float ps[2][4];
            if (ntile) {
#pragma unroll
                for (int ai = 0; ai < 2; ++ai)
#pragma unroll
                    for (int m = 0; m < 4; ++m) { const f32x4 v0 = acc[ai][bj][m][0], v1 = acc[ai][bj][m][1];
                        float ss = (v0[0] * v0[0] + v0[1] * v0[1]) + (v0[2] * v0[2] + v0[3] * v0[3]) + (v1[0] * v1[0] + v1[1] * v1[1]) + (v1[2] * v1[2] + v1[3] * v1[3]);
                        ss += __shfl_xor(ss, 16); ss += __shfl_xor(ss, 32);
                        ps[ai][m] = ss;
                        if (fq == 0) SC[(wid * 16 + bj * 8 + ai * 4 + m) * 16 + fr] = ss; }
                asm volatile("s_waitcnt lgkmcnt(0)" ::: "memory");
                __builtin_amdgcn_s_barrier();
            }
            f32x4 g0 = (f32x4){1.f, 1.f, 1.f, 1.f}, g1 = g0;
            if (ty >= 0) { const float* gp = GT + ty * 64 + (wc & 1) * 32 + 8 * fq; g0 = *(const f32x4*)gp; g1 = *(const f32x4*)(gp + 4); }
#pragma unroll
            for (int ai = 0; ai < 2; ++ai)
#pragma unroll
                for (int m = 0; m < 4; ++m) { float r = 1.0f;
                    if (nrm) { const float tot = ps[ai][m] + SC[((wid ^ 1) * 16 + bj * 8 + ai * 4 + m) * 16 + fr]; r = __builtin_amdgcn_rsqf(tot * (1.0f / 64.0f) + 1e-6f); }
                    const f32x4 v0 = acc[ai][bj][m][0] * g0 * r, v1 = acc[ai][bj][m][1] * g1 * r;
                    u32x4 w; w.x = cvt_pk_bf16(v0[0], v0[1]); w.y = cvt_pk_bf16(v0[2], v0[3]); w.z = cvt_pk_bf16(v1[0], v1[1]); w.w = cvt_pk_bf16(v1[2], v1[3]);
                    *(u32x4*)(O + (size_t)(row0 + ai * HALF + m * 16) * ldc + col0 + bj * HALF) = w; }
        }
    }
};
struct EpiResGate {
    static constexpr bool PERM = false, AFTER_DRAIN = false;
    const float* base; float* out; const float* gate; int ldc; int gate_ld; int dry;
    __device__ __forceinline__ void operator()(const f32x4 (&acc)[2][2][4][2], const Unit& u, int wr, int wc, int fr, int fq) const {
        if (dry) return;
        const int row0 = u.pm * BM + wr * 64 + fr, col0 = u.pn * BM + wc * 32 + 4 * fq;
        const float* gp = gate + (size_t)((u.pm * BM) >> 12) * gate_ld + col0;
        f32x4 gv[2][2];
#pragma unroll
        for (int bj = 0; bj < 2; ++bj)
#pragma unroll
            for (int n = 0; n < 2; ++n) gv[bj][n] = *(const f32x4*)(gp + bj * HALF + n * 16);
#pragma unroll
        for (int ai = 0; ai < 2; ++ai)
#pragma unroll
            for (int mb = 0; mb < 4; mb += RES_BATCH) {
                f32x4 bs[RES_BATCH][2][2];
#pragma unroll
                for (int mi = 0; mi < RES_BATCH; ++mi) { const size_t off = (size_t)(row0 + ai * HALF + (mb + mi) * 16) * ldc + col0;
#pragma unroll
                    for (int bj = 0; bj < 2; ++bj)
#pragma unroll
                        for (int n = 0; n < 2; ++n) bs[mi][bj][n] = *(const __attribute__((address_space(1))) f32x4*)(base + off + bj * HALF + n * 16); }
                asm volatile("" ::: "memory");
#pragma unroll
                for (int mi = 0; mi < RES_BATCH; ++mi) { const size_t off = (size_t)(row0 + ai * HALF + (mb + mi) * 16) * ldc + col0;
#pragma unroll
                    for (int bj = 0; bj < 2; ++bj)
#pragma unroll
                        for (int n = 0; n < 2; ++n) *(__attribute__((address_space(1))) f32x4*)(out + off + bj * HALF + n * 16) = bs[mi][bj][n] + gv[bj][n] * acc[ai][bj][mb + mi][n]; }
                asm volatile("" ::: "memory"); }
    }
};
struct EpiSwiGLU {
    static constexpr bool PERM = true, AFTER_DRAIN = false;
    bf16_t* O; int ldc; int pn_mod; int row_sub; int dry;
    __device__ __forceinline__ void operator()(const f32x4 (&acc)[2][2][4][2], const Unit& u, int wr, int wc, int fr, int fq) const {
        if (dry) return;
        const int row0 = u.pm * BM - row_sub + wr * 64 + fr, col0 = (u.pn % pn_mod) * HALF + wc * 32 + 8 * fq;
#pragma unroll
        for (int ai = 0; ai < 2; ++ai)
#pragma unroll
            for (int m = 0; m < 4; ++m) { bf16_t* rowp = O + (size_t)(row0 + ai * HALF + m * 16) * ldc + col0;
                const f32x4 g0 = acc[ai][0][m][0], g1 = acc[ai][0][m][1], u0 = acc[ai][1][m][0], u1 = acc[ai][1][m][1];
                float v[8];
#pragma unroll
                for (int j = 0; j < 4; ++j) { v[j] = silu_f(g0[j]) * u0[j]; v[4 + j] = silu_f(g1[j]) * u1[j]; }
                u32x4 w; w.x = cvt_pk_bf16(v[0], v[1]); w.y = cvt_pk_bf16(v[2], v[3]); w.z = cvt_pk_bf16(v[4], v[5]); w.w = cvt_pk_bf16(v[6], v[7]);
                *(u32x4*)rowp = w; }
    }
};
struct MoeMap {
    int c0, c1, c2, c3, c4, c5, c6, c7, p1, p2, p3, p4, p5, p6, p7; const int* tokof; const float* tokw;
    __device__ __forceinline__ int expert(int tile) const { return (tile >= p1) + (tile >= p2) + (tile >= p3) + (tile >= p4) + (tile >= p5) + (tile >= p6) + (tile >= p7); }
    __device__ __forceinline__ int index(int tile, int r) const {
        tile = __builtin_amdgcn_readfirstlane(tile);
        const int g1 = tile >= p1, g2 = tile >= p2, g3 = tile >= p3, g4 = tile >= p4, g5 = tile >= p5, g6 = tile >= p6, g7 = tile >= p7;
        const int e = g1 + g2 + g3 + g4 + g5 + g6 + g7;
        int pte = g1 * p1; pte = max(pte, g2 * p2); pte = max(pte, g3 * p3); pte = max(pte, g4 * p4); pte = max(pte, g5 * p5); pte = max(pte, g6 * p6); pte = max(pte, g7 * p7);
        const int ce = c0 + g1 * (c1 - c0) + g2 * (c2 - c1) + g3 * (c3 - c2) + g4 * (c4 - c3) + g5 * (c5 - c4) + g6 * (c6 - c5) + g7 * (c7 - c6);
        const int slot = (tile - pte) * 256 + r; return slot < ce ? e * 32768 + slot : -1; }
};
struct EpiMoeDown {
    static constexpr bool PERM = false, AFTER_DRAIN = false;
    MoeMap mm; float* out; bf16_t* y1; const float* gate; int gate_ld; int tile_add; int pn_mod; int dry;
    __device__ __forceinline__ void operator()(const f32x4 (&acc)[2][2][4][2], const Unit& u, int wr, int wc, int fr, int fq) const {
        if (dry) return;
        const int tile = u.pm + tile_add, rl0 = wr * 64 + fr, col0 = (u.pn % pn_mod) * BM + wc * 32 + 4 * fq;
        int tks[8]; float ws[8];
#pragma unroll
        for (int q = 0; q < 8; ++q) { const int ix = mm.index(tile, rl0 + (q >> 2) * HALF + (q & 3) * 16); tks[q] = ix >= 0 ? mm.tokof[ix] : -1; ws[q] = ix >= 0 ? mm.tokw[ix] : 0.f; }
#pragma unroll
        for (int ai = 0; ai < 2; ++ai)
#pragma unroll
            for (int m = 0; m < 4; ++m) { const int tk = tks[ai * 4 + m];
                if (tk >= 0) { const float w = ws[ai * 4 + m]; const int tok = tk & 0x3fffffff; const bool s1 = (tk >> 30) & 1;
                    const float* gp = gate + (size_t)(tok >> 12) * gate_ld + col0; const size_t off = (size_t)tok * 1024 + col0;
#pragma unroll
                    for (int bj = 0; bj < 2; ++bj)
#pragma unroll
                        for (int n = 0; n < 2; ++n) { const f32x4 gv = *(const f32x4*)(gp + bj * HALF + n * 16); const f32x4 v = gv * acc[ai][bj][m][n] * w;
                            if (s1) { typedef unsigned u32x2v __attribute__((ext_vector_type(2))); u32x2v pw; pw.x = cvt_pk_bf16(v[0], v[1]); pw.y = cvt_pk_bf16(v[2], v[3]); *(u32x2v*)(y1 + off + bj * HALF + n * 16) = pw; }
                            else { float* op = out + off + bj * HALF + n * 16; *(f32x4*)op = *(const f32x4*)op + v; } } }
                if (m & 1) asm volatile("" ::: "memory"); }
    }
};
struct MoeOrder {
    int t0, nt, ncol, G, c, pm_off; MoeMap mm;
    __device__ __forceinline__ bool next(int i, Unit& u) const {
        int tile, pnr;
        if (nt == 64 && G == 256) {
            pnr = i * 4 + (c >> 6); if (pnr >= ncol) return false; tile = t0 + (c & 7) * 8 + ((c >> 3) & 7);
        } else { const long L = (long)i * G + c; if (L >= (long)nt * ncol) return false; const int idx = (int)L; tile = t0 + idx % nt; pnr = idx / nt; }
        u.pm = tile - pm_off; u.pn = mm.expert(tile) * ncol + pnr; return true;
    }
    __device__ __forceinline__ unsigned row_byte(const Unit& u, int r) const { const int ix = mm.index(u.pm + pm_off, r); const int tok = ix >= 0 ? (mm.tokof[ix] & 0x3fffffff) : 0; return (unsigned)tok * 2048u; }
    __device__ __forceinline__ void a_ready(const Unit&) const {}
    __device__ __forceinline__ void done(const Unit&) const {}
};
struct MoeOrderB {
    int t0, ncol, c, nd; MoeMap mm;
    __device__ __forceinline__ bool next(int i, Unit& u) const {
        int ii = i, cc = c;
        if (c < nd) { if (i >= 4) return false; }
        else if (i == 7) { const int k = c - nd; if (k >= 3 * nd) return false; ii = 4 + k / nd; cc = k % nd; }
        else if (i > 7) return false;
        const int pnr = ii * 4 + (cc >> 6); if (pnr >= ncol) return false;
        const int tile = t0 + (cc & 7) * 8 + ((cc >> 3) & 7);
        u.pm = tile; u.pn = mm.expert(tile) * ncol + pnr; return true;
    }
    __device__ __forceinline__ unsigned row_byte(const Unit& u, int r) const { const int ix = mm.index(u.pm, r); const int tok = ix >= 0 ? (mm.tokof[ix] & 0x3fffffff) : 0; return (unsigned)tok * 2048u; }
    __device__ __forceinline__ void a_ready(const Unit&) const {}
    __device__ __forceinline__ void done(const Unit&) const {}
};
template <class Epi, class Sched, bool ALIGN_EPI = false, bool SP2 = false>
__device__ __forceinline__ void gemm_phase(PG8_LAS unsigned char* lds, const Gemm g, const Sched& S, const Epi& E) {
    int tid_ = threadIdx.x; asm volatile("" : "+v"(tid_));
    const int tid = tid_, wid = __builtin_amdgcn_readfirstlane(tid >> 6), lane = tid & 63, wr = wid >> 2, wc = wid & 3, fr = lane & 15, fq = lane >> 4;
    const int K = g.K, nt = K / BK;
    unsigned voffA[2], voffB[2];
#pragma unroll
    for (int i = 0; i < 2; ++i) { int R, C; stage_rc(tid * 16 + i * 8192, R, C); const int Rb = Epi::PERM ? ((R & ~31) + perm32(R & 31)) : R;
        voffA[i] = (unsigned)(R * K + C) * 2u; voffB[i] = (unsigned)(Rb * K + C) * 2u; }
    const size_t kstep = (size_t)(BK * 2);
    const size_t hstep = (size_t)HALF * K * 2;
    const size_t tstep = 2 * hstep;
    const unsigned ldsw = (unsigned)wid * 1024u;
    const int aoff = lds_byte(wr * 64 + fr, fq * 8), boff = lds_byte(wc * 32 + fr, fq * 8);
#define PG8_SA(b, h) (((b) * 2 + (h)) * HTB)
#define PG8_SB(b, h) ((4 + (b) * 2 + (h)) * HTB)
#define PG8_STAGE(bufoff, gbase, voff) do { _Pragma("unroll") for (int _i = 0; _i < 2; ++_i) \
        __builtin_amdgcn_global_load_lds((const unsigned*)((const char*)(gbase) + (voff)[_i]), (PG8_LAS unsigned*)(lds + (bufoff) + ldsw + _i * 8192), 16, 0, 0); } while (0)
#define PG8_LDA(dst, b, h) do { _Pragma("unroll") for (int m = 0; m < 4; ++m) _Pragma("unroll") for (int k = 0; k < 2; ++k) dst[m][k] = *(const PG8_LAS bf16x8*)(lds + PG8_SA(b, h) + aoff + m * 2048 + k * 1024); } while (0)
#define PG8_LDB(dst, b, h) do { _Pragma("unroll") for (int n = 0; n < 2; ++n) _Pragma("unroll") for (int k = 0; k < 2; ++k) dst[n][k] = *(const PG8_LAS bf16x8*)(lds + PG8_SB(b, h) + boff + n * 2048 + k * 1024); } while (0)
#define PG8_MMA(ai, bj, At, Bt) do { __builtin_amdgcn_s_setprio(1); _Pragma("unroll") for (int m = 0; m < 4; ++m) _Pragma("unroll") for (int n = 0; n < 2; ++n) _Pragma("unroll") for (int k = 0; k < 2; ++k) \
        acc[ai][bj][m][n] = __builtin_amdgcn_mfma_f32_16x16x32_bf16(Bt[n][k], At[m][k], acc[ai][bj][m][n], 0, 0, 0); __builtin_amdgcn_s_setprio(0); } while (0)
#define PG8_WAIT_V(n) asm volatile("s_waitcnt vmcnt(" #n ")" ::: "memory")
#define PG8_WAIT_L(n) asm volatile("s_waitcnt lgkmcnt(" #n ")" ::: "memory")
#define PG8_BAR __builtin_amdgcn_s_barrier()
#define PG8_SCHED __builtin_amdgcn_sched_barrier(0)
    Unit cur, nxt; int ui = 0;
    if (!S.next(0, cur)) return;
    f32x4 acc[2][2][4][2];
#pragma unroll
    for (int a = 0; a < 2; ++a)
#pragma unroll
        for (int b = 0; b < 2; ++b)
#pragma unroll
            for (int m = 0; m < 4; ++m)
#pragma unroll
                for (int n = 0; n < 2; ++n) acc[a][b][m][n] = (f32x4){0.f, 0.f, 0.f, 0.f};
    bf16x8 At[4][2], B0[2][2], B1[2][2];
    const char* cA = (const char*)g.A + (size_t)cur.pm * tstep; const char* cB = (const char*)g.Bt + (size_t)cur.pn * tstep;
    S.a_ready(cur);
    if constexpr (SP2) {
        PG8_STAGE(PG8_SB(0, 0), cB, voffB); PG8_STAGE(PG8_SB(0, 1), cB + hstep, voffB); PG8_STAGE(PG8_SA(0, 0), cA, voffA); PG8_STAGE(PG8_SA(0, 1), cA + hstep, voffA);
        if (wr == 1) PG8_BAR;
        PG8_WAIT_V(2); PG8_BAR;
        PG8_STAGE(PG8_SB(1, 0), cB + kstep, voffB); PG8_STAGE(PG8_SA(1, 0), cA + kstep, voffA); PG8_STAGE(PG8_SB(1, 1), cB + hstep + kstep, voffB);
        PG8_WAIT_V(6); PG8_BAR;
    } else {
        PG8_STAGE(PG8_SB(0, 0), cB, voffB); PG8_STAGE(PG8_SA(0, 0), cA, voffA); PG8_STAGE(PG8_SB(0, 1), cB + hstep, voffB); PG8_STAGE(PG8_SA(0, 1), cA + hstep, voffA);
        if (wr == 1) PG8_BAR;
        PG8_WAIT_V(4); PG8_BAR;
        PG8_STAGE(PG8_SB(1, 0), cB + kstep, voffB); PG8_STAGE(PG8_SA(1, 0), cA + kstep, voffA); PG8_STAGE(PG8_SB(1, 1), cB + hstep + kstep, voffB);
        PG8_WAIT_V(6); PG8_BAR;
    }
    for (;;) {
        const bool has_next = S.next(ui + 1, nxt);
        const char* nA = has_next ? (const char*)g.A + (size_t)nxt.pm * tstep : cA; const char* nB = has_next ? (const char*)g.Bt + (size_t)nxt.pn * tstep : cB;
        for (int t = 0; t < nt; t += 2) {
            const bool last = (t == nt - 2);
            const char* a1 = cA + (size_t)(t + 1) * kstep;
            const char* a2 = last ? nA : cA + (size_t)(t + 2) * kstep; const char* b2 = last ? nB : cB + (size_t)(t + 2) * kstep;
            const char* a3 = a2 + kstep; const char* b3 = b2 + kstep;
            if (last && has_next) S.a_ready(nxt);
            if constexpr (SP2) {
            PG8_LDB(B0, 0, 0); PG8_LDB(B1, 0, 1); PG8_SCHED; PG8_LDA(At, 0, 0); PG8_STAGE(PG8_SA(1, 1), a1 + hstep, voffA);
            PG8_WAIT_V(8); PG8_WAIT_L(0); PG8_BAR; PG8_MMA(0, 0, At, B0); PG8_MMA(0, 1, At, B1); PG8_BAR; PG8_SCHED;
            PG8_LDA(At, 0, 1); PG8_STAGE(PG8_SB(0, 0), b2, voffB); PG8_STAGE(PG8_SB(0, 1), b2 + hstep, voffB); PG8_STAGE(PG8_SA(0, 0), a2, voffA);
            PG8_WAIT_V(8); PG8_WAIT_L(0); PG8_BAR; PG8_MMA(1, 0, At, B0); PG8_MMA(1, 1, At, B1); PG8_BAR; PG8_SCHED;
            PG8_LDB(B0, 1, 0); PG8_LDB(B1, 1, 1); PG8_SCHED; PG8_LDA(At, 1, 0); PG8_STAGE(PG8_SA(0, 1), a2 + hstep, voffA);
            PG8_WAIT_V(8); PG8_WAIT_L(0); PG8_BAR; PG8_MMA(0, 0, At, B0); PG8_MMA(0, 1, At, B1); PG8_BAR; PG8_SCHED;
            PG8_LDA(At, 1, 1); PG8_STAGE(PG8_SB(1, 0), b3, voffB); PG8_STAGE(PG8_SB(1, 1), b3 + hstep, voffB); PG8_STAGE(PG8_SA(1, 0), a3, voffA);
            PG8_WAIT_V(8); PG8_WAIT_L(0); PG8_BAR; PG8_MMA(1, 0, At, B0); PG8_MMA(1, 1, At, B1); PG8_BAR; PG8_SCHED;
            } else {
            PG8_LDB(B0, 0, 0); PG8_SCHED; PG8_LDA(At, 0, 0); PG8_STAGE(PG8_SA(1, 1), a1 + hstep, voffA);
            PG8_WAIT_L(8); PG8_BAR; PG8_WAIT_L(0); PG8_MMA(0, 0, At, B0); PG8_BAR; PG8_SCHED;
            PG8_LDB(B1, 0, 1); PG8_STAGE(PG8_SB(0, 0), b2, voffB);
            PG8_BAR; PG8_WAIT_L(0); PG8_MMA(0, 1, At, B1); PG8_BAR;
            PG8_LDA(At, 0, 1); PG8_STAGE(PG8_SA(0, 0), a2, voffA);
            PG8_BAR; PG8_WAIT_L(0); PG8_MMA(1, 0, At, B0); PG8_BAR; PG8_SCHED;
            PG8_STAGE(PG8_SB(0, 1), b2 + hstep, voffB);
            PG8_WAIT_V(6); PG8_BAR; PG8_MMA(1, 1, At, B1); PG8_BAR;
            PG8_LDB(B0, 1, 0); PG8_SCHED; PG8_LDA(At, 1, 0); PG8_STAGE(PG8_SA(0, 1), a2 + hstep, voffA);
            PG8_WAIT_L(8); PG8_BAR; PG8_WAIT_L(0); PG8_MMA(0, 0, At, B0); PG8_BAR; PG8_SCHED;
            PG8_LDB(B1, 1, 1); PG8_STAGE(PG8_SB(1, 0), b3, voffB);
            PG8_BAR; PG8_WAIT_L(0); PG8_MMA(0, 1, At, B1); PG8_BAR;
            PG8_LDA(At, 1, 1); PG8_STAGE(PG8_SA(1, 0), a3, voffA);
            PG8_BAR; PG8_WAIT_L(0); PG8_MMA(1, 0, At, B0); PG8_BAR; PG8_SCHED;
            PG8_STAGE(PG8_SB(1, 1), b3 + hstep, voffB);
            PG8_WAIT_V(6); PG8_BAR; PG8_MMA(1, 1, At, B1); PG8_BAR;
            }
        }
        if constexpr (ALIGN_EPI) { if (wr == 0) PG8_BAR; }
        if constexpr (!Epi::AFTER_DRAIN) { E(acc, cur, wr, wc, fr, fq); S.done(cur); }
        if (!has_next) break;
#pragma unroll
        for (int a = 0; a < 2; ++a)
#pragma unroll
            for (int b = 0; b < 2; ++b)
#pragma unroll
                for (int m = 0; m < 4; ++m)
#pragma unroll
                    for (int n = 0; n < 2; ++n) acc[a][b][m][n] = (f32x4){0.f, 0.f, 0.f, 0.f};
        cur = nxt; cA = nA; cB = nB; ++ui;
        if constexpr (ALIGN_EPI) { if (wr == 1) PG8_BAR; }
    }
    PG8_WAIT_V(0);
    if constexpr (!ALIGN_EPI) { if (wr == 0) PG8_BAR; }
    PG8_BAR;
    if constexpr (Epi::AFTER_DRAIN) { E.fused(acc, cur, wr, wc, fr, fq, lds, wid, lane); S.done(cur); }
#undef PG8_SA
#undef PG8_SB
#undef PG8_STAGE
#undef PG8_LDA
#undef PG8_LDB
#undef PG8_MMA
#undef PG8_WAIT_V
#undef PG8_WAIT_L
#undef PG8_BAR
#undef PG8_SCHED
}
template <class Epi, class Sched, bool ALIGN_EPI = false, bool SP2 = false>
__device__ __forceinline__ void gemm_phase_ga(PG8_LAS unsigned char* lds, const Gemm g, const Sched& S, const Epi& E) {
    int tid_ = threadIdx.x; asm volatile("" : "+v"(tid_));
    const int tid = tid_, wid = __builtin_amdgcn_readfirstlane(tid >> 6), lane = tid & 63, wr = wid >> 2, wc = wid & 3, fr = lane & 15, fq = lane >> 4;
    const int K = g.K, nt = K / BK;
    static_assert(SP2, "gemm_phase_ga: SP2 loop only");
    unsigned voffA[2], voffB[2], colA[2]; int rowA[2];
#pragma unroll
    for (int i = 0; i < 2; ++i) { int R, C; stage_rc(tid * 16 + i * 8192, R, C); const int Rb = Epi::PERM ? ((R & ~31) + perm32(R & 31)) : R;
        voffA[i] = (unsigned)(R * K + C) * 2u; voffB[i] = (unsigned)(Rb * K + C) * 2u; rowA[i] = R; colA[i] = (unsigned)C * 2u; }
    const size_t kstep = (size_t)(BK * 2);
    const size_t hstep = (size_t)HALF * K * 2;
    const size_t tstep = 2 * hstep;
    const unsigned ldsw = (unsigned)wid * 1024u;
    const int aoff = lds_byte(wr * 64 + fr, fq * 8), boff = lds_byte(wc * 32 + fr, fq * 8);
#define PG8_SA(b, h) (((b) * 2 + (h)) * HTB)
#define PG8_SB(b, h) ((4 + (b) * 2 + (h)) * HTB)
#define PG8_STAGE(bufoff, gbase, voff) do { _Pragma("unroll") for (int _i = 0; _i < 2; ++_i) \
        __builtin_amdgcn_global_load_lds((const unsigned*)((const char*)(gbase) + (voff)[_i]), (PG8_LAS unsigned*)(lds + (bufoff) + ldsw + _i * 8192), 16, 0, 0); } while (0)
#define PG8_STAGE_A(bufoff, koff, V0, V1) do { \
        __builtin_amdgcn_global_load_lds((const unsigned*)(A0 + (koff) + (V0)), (PG8_LAS unsigned*)(lds + (bufoff) + ldsw), 16, 0, 0); \
        __builtin_amdgcn_global_load_lds((const unsigned*)(A0 + (koff) + (V1)), (PG8_LAS unsigned*)(lds + (bufoff) + ldsw + 8192), 16, 0, 0); } while (0)
#define PG8_FILLA(V, U) do { _Pragma("unroll") for (int h_ = 0; h_ < 2; ++h_) _Pragma("unroll") for (int i_ = 0; i_ < 2; ++i_) V[h_][i_] = S.row_byte(U, h_ * HALF + rowA[i_]) + colA[i_]; } while (0)
#define PG8_LDA(dst, b, h) do { _Pragma("unroll") for (int m = 0; m < 4; ++m) _Pragma("unroll") for (int k = 0; k < 2; ++k) dst[m][k] = *(const PG8_LAS bf16x8*)(lds + PG8_SA(b, h) + aoff + m * 2048 + k * 1024); } while (0)
#define PG8_LDB(dst, b, h) do { _Pragma("unroll") for (int n = 0; n < 2; ++n) _Pragma("unroll") for (int k = 0; k < 2; ++k) dst[n][k] = *(const PG8_LAS bf16x8*)(lds + PG8_SB(b, h) + boff + n * 2048 + k * 1024); } while (0)
#define PG8_MMA(ai, bj, At, Bt) do { __builtin_amdgcn_s_setprio(1); _Pragma("unroll") for (int m = 0; m < 4; ++m) _Pragma("unroll") for (int n = 0; n < 2; ++n) _Pragma("unroll") for (int k = 0; k < 2; ++k) \
        acc[ai][bj][m][n] = __builtin_amdgcn_mfma_f32_16x16x32_bf16(Bt[n][k], At[m][k], acc[ai][bj][m][n], 0, 0, 0); __builtin_amdgcn_s_setprio(0); } while (0)
#define PG8_WAIT_V(n) asm volatile("s_waitcnt vmcnt(" #n ")" ::: "memory")
#define PG8_WAIT_L(n) asm volatile("s_waitcnt lgkmcnt(" #n ")" ::: "memory")
#define PG8_BAR __builtin_amdgcn_s_barrier()
#define PG8_SCHED __builtin_amdgcn_sched_barrier(0)
    Unit cur, nxt; int ui = 0;
    if (!S.next(0, cur)) return;
    f32x4 acc[2][2][4][2];
#pragma unroll
    for (int a = 0; a < 2; ++a)
#pragma unroll
        for (int b = 0; b < 2; ++b)
#pragma unroll
            for (int m = 0; m < 4; ++m)
#pragma unroll
                for (int n = 0; n < 2; ++n) acc[a][b][m][n] = (f32x4){0.f, 0.f, 0.f, 0.f};
    bf16x8 At[4][2], B0[2][2], B1[2][2];
    const char* A0 = (const char*)g.A; const char* cB = (const char*)g.Bt + (size_t)cur.pn * tstep;
    unsigned cv[2][2], nv[2][2];
    PG8_FILLA(cv, cur);
    S.a_ready(cur);
    if constexpr (SP2) {
        PG8_STAGE(PG8_SB(0, 0), cB, voffB); PG8_STAGE(PG8_SB(0, 1), cB + hstep, voffB); PG8_STAGE_A(PG8_SA(0, 0), 0, cv[0][0], cv[0][1]); PG8_STAGE_A(PG8_SA(0, 1), 0, cv[1][0], cv[1][1]);
        if (wr == 1) PG8_BAR;
        PG8_WAIT_V(2); PG8_BAR;
        PG8_STAGE(PG8_SB(1, 0), cB + kstep, voffB); PG8_STAGE_A(PG8_SA(1, 0), kstep, cv[0][0], cv[0][1]); PG8_STAGE(PG8_SB(1, 1), cB + hstep + kstep, voffB);
        PG8_WAIT_V(6); PG8_BAR;
    } else {
        PG8_STAGE(PG8_SB(0, 0), cB, voffB); PG8_STAGE_A(PG8_SA(0, 0), 0, cv[0][0], cv[0][1]); PG8_STAGE(PG8_SB(0, 1), cB + hstep, voffB); PG8_STAGE_A(PG8_SA(0, 1), 0, cv[1][0], cv[1][1]);
        if (wr == 1) PG8_BAR;
        PG8_WAIT_V(4); PG8_BAR;
        PG8_STAGE(PG8_SB(1, 0), cB + kstep, voffB); PG8_STAGE_A(PG8_SA(1, 0), kstep, cv[0][0], cv[0][1]); PG8_STAGE(PG8_SB(1, 1), cB + hstep + kstep, voffB);
        PG8_WAIT_V(6); PG8_BAR;
    }
    for (;;) {
        const bool has_next = S.next(ui + 1, nxt);
        const char* nB = has_next ? (const char*)g.Bt + (size_t)nxt.pn * tstep : cB;
        if (has_next && nxt.pm != cur.pm) PG8_FILLA(nv, nxt);
        else { nv[0][0] = cv[0][0]; nv[0][1] = cv[0][1]; nv[1][0] = cv[1][0]; nv[1][1] = cv[1][1]; }
        for (int t = 0; t < nt; t += 2) {
            const bool last = (t == nt - 2);
            const size_t k1 = (size_t)(t + 1) * kstep, k2 = last ? (size_t)0 : (size_t)(t + 2) * kstep; const char* b2 = last ? nB : cB + (size_t)(t + 2) * kstep;
            const unsigned w00 = last ? nv[0][0] : cv[0][0], w01 = last ? nv[0][1] : cv[0][1], w10 = last ? nv[1][0] : cv[1][0], w11 = last ? nv[1][1] : cv[1][1];
            const char* b3 = b2 + kstep;
            if (last && has_next) S.a_ready(nxt);
            if constexpr (SP2) {
            PG8_LDB(B0, 0, 0); PG8_LDB(B1, 0, 1); PG8_SCHED; PG8_LDA(At, 0, 0); PG8_STAGE_A(PG8_SA(1, 1), k1, cv[1][0], cv[1][1]);
            PG8_WAIT_V(8); PG8_WAIT_L(0); PG8_BAR; PG8_MMA(0, 0, At, B0); PG8_MMA(0, 1, At, B1); PG8_BAR; PG8_SCHED;
            PG8_LDA(At, 0, 1); PG8_STAGE(PG8_SB(0, 0), b2, voffB); PG8_STAGE(PG8_SB(0, 1), b2 + hstep, voffB); PG8_STAGE_A(PG8_SA(0, 0), k2, w00, w01);
            PG8_WAIT_V(8); PG8_WAIT_L(0); PG8_BAR; PG8_MMA(1, 0, At, B0); PG8_MMA(1, 1, At, B1); PG8_BAR; PG8_SCHED;
            PG8_LDB(B0, 1, 0); PG8_LDB(B1, 1, 1); PG8_SCHED; PG8_LDA(At, 1, 0); PG8_STAGE_A(PG8_SA(0, 1), k2, w10, w11);
            PG8_WAIT_V(8); PG8_WAIT_L(0); PG8_BAR; PG8_MMA(0, 0, At, B0); PG8_MMA(0, 1, At, B1); PG8_BAR; PG8_SCHED;
            PG8_LDA(At, 1, 1); PG8_STAGE(PG8_SB(1, 0), b3, voffB); PG8_STAGE(PG8_SB(1, 1), b3 + hstep, voffB); PG8_STAGE_A(PG8_SA(1, 0), k2 + kstep, w00, w01);
            PG8_WAIT_V(8); PG8_WAIT_L(0); PG8_BAR; PG8_MMA(1, 0, At, B0); PG8_MMA(1, 1, At, B1); PG8_BAR; PG8_SCHED;
            } else {
            PG8_LDB(B0, 0, 0); PG8_SCHED; PG8_LDA(At, 0, 0); PG8_STAGE_A(PG8_SA(1, 1), k1, cv[1][0], cv[1][1]);
            PG8_WAIT_L(8); PG8_BAR; PG8_WAIT_L(0); PG8_MMA(0, 0, At, B0); PG8_BAR; PG8_SCHED;
            PG8_LDB(B1, 0, 1); PG8_STAGE(PG8_SB(0, 0), b2, voffB);
            PG8_BAR; PG8_WAIT_L(0); PG8_MMA(0, 1, At, B1); PG8_BAR;
            PG8_LDA(At, 0, 1); PG8_STAGE_A(PG8_SA(0, 0), k2, w00, w01);
            PG8_BAR; PG8_WAIT_L(0); PG8_MMA(1, 0, At, B0); PG8_BAR; PG8_SCHED;
            PG8_STAGE(PG8_SB(0, 1), b2 + hstep, voffB);
            PG8_WAIT_V(6); PG8_BAR; PG8_MMA(1, 1, At, B1); PG8_BAR;
            PG8_LDB(B0, 1, 0); PG8_SCHED; PG8_LDA(At, 1, 0); PG8_STAGE_A(PG8_SA(0, 1), k2, w10, w11);
            PG8_WAIT_L(8); PG8_BAR; PG8_WAIT_L(0); PG8_MMA(0, 0, At, B0); PG8_BAR; PG8_SCHED;
            PG8_LDB(B1, 1, 1); PG8_STAGE(PG8_SB(1, 0), b3, voffB);
            PG8_BAR; PG8_WAIT_L(0); PG8_MMA(0, 1, At, B1); PG8_BAR;
            PG8_LDA(At, 1, 1); PG8_STAGE_A(PG8_SA(1, 0), k2 + kstep, w00, w01);
            PG8_BAR; PG8_WAIT_L(0); PG8_MMA(1, 0, At, B0); PG8_BAR; PG8_SCHED;
            PG8_STAGE(PG8_SB(1, 1), b3 + hstep, voffB);
            PG8_WAIT_V(6); PG8_BAR; PG8_MMA(1, 1, At, B1); PG8_BAR;
            }
        }
        if constexpr (ALIGN_EPI) { if (wr == 0) PG8_BAR; }
        if constexpr (!Epi::AFTER_DRAIN) { E(acc, cur, wr, wc, fr, fq); S.done(cur); }
        if (!has_next) break;
#pragma unroll
        for (int a = 0; a < 2; ++a)
#pragma unroll
            for (int b = 0; b < 2; ++b)
#pragma unroll
                for (int m = 0; m < 4; ++m)
#pragma unroll
                    for (int n = 0; n < 2; ++n) acc[a][b][m][n] = (f32x4){0.f, 0.f, 0.f, 0.f};
        cur = nxt; cB = nB; ++ui; cv[0][0] = nv[0][0]; cv[0][1] = nv[0][1]; cv[1][0] = nv[1][0]; cv[1][1] = nv[1][1];
        if constexpr (ALIGN_EPI) { if (wr == 1) PG8_BAR; }
    }
    PG8_WAIT_V(0);
    if constexpr (!ALIGN_EPI) { if (wr == 0) PG8_BAR; }
    PG8_BAR;
    if constexpr (Epi::AFTER_DRAIN) { E.fused(acc, cur, wr, wc, fr, fq, lds, wid, lane); S.done(cur); }
#undef PG8_SA
#undef PG8_SB
#undef PG8_STAGE
#undef PG8_STAGE_A
#undef PG8_FILLA
#undef PG8_LDA
#undef PG8_LDB
#undef PG8_MMA
#undef PG8_WAIT_V
#undef PG8_WAIT_L
#undef PG8_BAR
#undef PG8_SCHED
}
}

constexpr int NB = 8, SEQ = 4096, D = 1024, T = NB * SEQ, DEPTH = 2;
constexpr int INW = 3224, PW = 3328;
constexpr int FF = 2816, FFE = 3584, NEXP = 8;
constexpr int NWAVES = 8, NTHR = 512;
constexpr float NORM_EPS = 1e-6f, LOG2E = 1.4426950408889634f, QSCALE = 0.125f * 1.4426950408889634f;
constexpr int C_MQ = 0, C_MK = 256, C_MV = 512, C_MO = 768, C_FQ = 1024, C_FK = 1280, C_FV = 1536, C_SQ = 1792, C_SK = 2048, C_SV = 2304,
              C_NQ = 2560, C_KC = 2816, C_VC = 2880, C_KS = 2944, C_VS = 3008, C_KW = 3072, C_VW = 3136, C_MIF = 3200, C_FF = 3208, C_NG = 3212;
__host__ __device__ __forceinline__ int map_in_col(int c) {
    if (c < 1024) return c;
    if (c < 1792) return 1032 + (c - 1024);
    if (c < 2560) return 1804 + (c - 1792);
    if (c < 2816) return 2572 + (c - 2560);
    if (c < 3200) return 2828 + (c - 2816);
    if (c < 3208) return 1024 + (c - 3200);
    if (c < 3212) return 1800 + (c - 3208);
    if (c < 3224) return 3212 + (c - 3212);
    return -1;
}
constexpr size_t MiB = 1u << 20;
constexpr size_t WS_CTL = 0, CTL_ZERO_BYTES = 1 * MiB;
constexpr size_t WS_MODP = 1 * MiB;
constexpr size_t WS_MOD = 7 * MiB;
constexpr size_t WS_BL = 7 * MiB + 512 * 1024;
constexpr size_t WS_KCMP = 8 * MiB, WS_VCMP = 8 * MiB + 256 * 1024;
constexpr size_t WS_GB = 8 * MiB + 512 * 1024, WS_GI = 9 * MiB, WS_FLOC = 9 * MiB + 512 * 1024, WS_F2 = 10 * MiB;
constexpr size_t WS_G = 10 * MiB + 512 * 1024, WS_MLOC = WS_G + 8192, WS_MPREV = WS_G + 16384, WS_FTOT = WS_G + 24576;
constexpr size_t WS_NCH = 11 * MiB;
constexpr size_t WS_NG = 12 * MiB;
constexpr size_t WS_TOKOF = 14 * MiB, WS_TOKW = 15 * MiB;
constexpr size_t WS_ROWTOK = 16 * MiB, WS_ROWW = 16 * MiB + 512 * 1024;
constexpr size_t WS_WCT = 17 * MiB;
constexpr size_t WS_P0 = WS_BL + 4096;
constexpr size_t WS_GT = WS_BL + 8192;
constexpr size_t WS_U = 1 * MiB;
constexpr size_t WS_WIN = 18 * MiB;
constexpr size_t WS_WOUT = 31 * MiB;
constexpr size_t WS_WGU = 35 * MiB;
constexpr size_t WS_WD = 46 * MiB;
constexpr size_t WS_MWGU = 52 * MiB;
constexpr size_t WS_MWD = 164 * MiB;
constexpr size_t WS_H = 220 * MiB;
constexpr size_t WS_QKC = WS_H, WS_STATE = WS_H + 32 * MiB;
constexpr size_t WS_PROJ = 284 * MiB;
constexpr size_t WS_MIX = 492 * MiB;
constexpr size_t WS_ACT = WS_PROJ;
constexpr size_t WS_Y1 = WS_PROJ;
constexpr size_t WS_ACTE = WS_PROJ + 132 * MiB;
constexpr size_t WS_ACT2 = WS_ACTE + 112 * MiB;
constexpr size_t WS_END = 556 * MiB;
static_assert(WS_ACT2 + (size_t)8 * 256 * 3584 * 2 <= WS_END && WS_ACTE + (size_t)16384 * 3584 * 2 <= WS_ACT2 && WS_Y1 + (size_t)T * D * 2 <= WS_ACTE, "ws map");
constexpr int CHUNK_TILES = 64;
constexpr int CW_TMO = 0, CW_QUEUE = 64, CW_ECNT = 512, CW_BAR = 4096;
constexpr int LDS_BYTES = 160 * 1024, MISC_OFF = LDS_BYTES - 512;

#define GAS __attribute__((address_space(1)))
#define LAS __attribute__((address_space(3)))
#define DI __device__ __forceinline__
typedef unsigned short bf16;
typedef unsigned v4u __attribute__((ext_vector_type(4)));
typedef unsigned v2u __attribute__((ext_vector_type(2)));
typedef float f32x4 __attribute__((ext_vector_type(4)));
typedef float f32x16 __attribute__((ext_vector_type(16)));
typedef short bf16x8 __attribute__((ext_vector_type(8)));
typedef short s16x4 __attribute__((ext_vector_type(4)));
typedef GAS unsigned gu32;
#define RLX_AGENT __ATOMIC_RELAXED, __HIP_MEMORY_SCOPE_AGENT
DI float bf2f(bf16 v) { return __uint_as_float(((unsigned)v) << 16); }
DI float bflo(unsigned w) { return __uint_as_float(w << 16); }
DI float bfhi(unsigned w) { return __uint_as_float(w & 0xffff0000u); }
DI unsigned pk2(float lo, float hi) { typedef float f2_t __attribute__((ext_vector_type(2))); typedef __bf16 b2_t __attribute__((ext_vector_type(2))); f2_t v = {lo, hi}; b2_t b = __builtin_convertvector(v, b2_t); return __builtin_bit_cast(unsigned, b); }
DI bf16 f2bf(float f) { return (bf16)(pk2(f, 0.f) & 0xffffu); }
DI float ex2(float x) { return __builtin_amdgcn_exp2f(x); }
DI float lg2(float x) { return __builtin_amdgcn_logf(x); }
DI float rcp(float x) { return __builtin_amdgcn_rcpf(x); }
DI float wave_sum(float v) {
#pragma unroll
    for (int o = 1; o < 64; o <<= 1) v += __shfl_xor(v, o);
    return v;
}
DI float wave_max(float v) {
#pragma unroll
    for (int o = 1; o < 64; o <<= 1) v = fmaxf(v, __shfl_xor(v, o));
    return v;
}
DI float log_sigmoid(float x) { return fminf(x, 0.f) - 0.6931471805599453f * lg2(1.0f + ex2(-fabsf(x) * LOG2E)); }
DI float sigmoid_f(float x) { return rcp(1.0f + ex2(-x * LOG2E)); }
DI float silu(float x) { return x * sigmoid_f(x); }
#define BLOCK_SYNC() __syncthreads()
#define LDS_BARRIER() asm volatile("s_waitcnt lgkmcnt(0)\n\ts_barrier" ::: "memory")
typedef short v4i16_tr __attribute__((ext_vector_type(4)));
DI s16x4 att_trr(LAS const char* p) { return __builtin_bit_cast(s16x4, __builtin_amdgcn_ds_read_tr16_b64_v4i16((LAS v4i16_tr*)p)); }
#define XB_TMO      128
#define XB_XCNT(j)  (256  + 64 * (j))
#define XB_XSUB(j)  (1280 + 64 * (j))
#define XB_XGEN(j)  (2304 + 64 * (j))
#define XB_TOP      3328
#define XB_TOPGEN   3392
#define XCD_BAR_WORDS 3456
#define XB_SPIN_CAP (1u << 18)

__device__ __forceinline__ unsigned xb_ld(unsigned* p)              { return __hip_atomic_load(p, __ATOMIC_RELAXED, __HIP_MEMORY_SCOPE_AGENT); }
__device__ __forceinline__ unsigned xb_add(unsigned* p, unsigned v) { return __hip_atomic_fetch_add(p, v, __ATOMIC_RELAXED, __HIP_MEMORY_SCOPE_AGENT); }
__device__ __forceinline__ unsigned xb_xcc_id() { return (unsigned)__builtin_amdgcn_s_getreg((3 << 11) | 20) & 0xFu; }
#define XB_SPIN(cond, bar) do { unsigned _sp = 0; while (cond) { __builtin_amdgcn_s_sleep(1); \
    if ((++_sp & 255u) == 0u) { if (xb_ld(&(bar)[XB_TMO])) break; if (_sp > XB_SPIN_CAP) { atomicAdd(&(bar)[XB_TMO], 1u); break; } } } } while (0)

struct XcdBarrier {
    unsigned* bar; unsigned x;
    volatile LAS unsigned* st;
};

__device__ __forceinline__ XcdBarrier xcd_barrier_post(unsigned* bar, volatile LAS unsigned* st) {
    XcdBarrier b; b.bar = bar; b.x = xb_xcc_id(); b.st = st;
    if (threadIdx.x == 0) (void)xb_add(&bar[XB_XCNT(b.x)], 1u);
    return b;
}
__device__ __forceinline__ void xcd_barrier_complete(unsigned* bar, unsigned x, unsigned& nloc, unsigned& nx) {
    const unsigned G = gridDim.x * gridDim.y * gridDim.z;
    unsigned sum, cnt, mine, sp = 0u;
    for (;;) {
        sum = 0u; cnt = 0u; mine = 0u;
#pragma unroll
        for (unsigned j = 0; j < 16; ++j) { const unsigned c = xb_ld(&bar[XB_XCNT(j)]); sum += c; cnt += (c > 0u) ? 1u : 0u; mine = (j == x) ? c : mine; }
        if (sum == G) break;
        __builtin_amdgcn_s_sleep(1);
        if ((++sp & 255u) == 0u) { if (xb_ld(&bar[XB_TMO])) break; if (sp > XB_SPIN_CAP) { atomicAdd(&bar[XB_TMO], 1u); break; } }
    }
    nloc = mine > 0u ? mine : 1u; nx = cnt > 0u ? cnt : 1u;
}

__device__ __forceinline__ void xcd_barrier(const XcdBarrier& b) {
    asm volatile("s_waitcnt vmcnt(0)" ::: "memory");
    __syncthreads();
    if (threadIdx.x == 0) {
        unsigned* bar = b.bar;
        __builtin_amdgcn_s_waitcnt(0);
        unsigned nloc = b.st[0], nx = b.st[1];
        if (nloc == 0u) { xcd_barrier_complete(bar, b.x, nloc, nx); b.st[0] = nloc; b.st[1] = nx; }
        const unsigned old = xb_add(&bar[XB_XSUB(b.x)], 1u);
        const unsigned gen = old / nloc;
        if (old + 1u == (gen + 1u) * nloc) {
            __builtin_amdgcn_fence(__ATOMIC_RELEASE, "agent");
            asm volatile("s_waitcnt vmcnt(0)" ::: "memory");
            const unsigned og = xb_add(&bar[XB_TOP], 1u);
            const unsigned tg = og / nx;
            if (og + 1u == (tg + 1u) * nx) xb_add(&bar[XB_TOPGEN], 1u);
            else XB_SPIN(xb_ld(&bar[XB_TOPGEN]) == tg, bar);
            __builtin_amdgcn_fence(__ATOMIC_ACQUIRE, "agent");
            xb_add(&bar[XB_XGEN(b.x)], 1u);
            asm volatile("s_waitcnt vmcnt(0)" ::: "memory");
        } else {
            XB_SPIN(xb_ld(&bar[XB_XGEN(b.x)]) == gen, bar);
            __builtin_amdgcn_fence(__ATOMIC_ACQUIRE, "agent");
            asm volatile("s_waitcnt vmcnt(0)" ::: "memory");
        }
    }
    __syncthreads();
}

struct Ctx {
    LAS unsigned char* lds;
    volatile LAS unsigned* MISC;
    gu32* ctl;
    int tid, lane, wave, G, blk;
    float* out; unsigned char* ws;
    const void __attribute__((address_space(4)))* ka;
};
#define WSP(T_, off) ((T_*)(C.ws + (off)))
#define KIN(k) (((const float* const __attribute__((address_space(4)))*)C.ka)[k])

DI void tr_load(float (&v_)[32], const float* W, int ldw, int k0, int sc, int lane) {
    const GAS float* wp_ = (const GAS float*)(W + (size_t)(k0 + (lane >> 5)) * ldw + (sc >= 0 ? sc : 0));
#pragma unroll
    for (int i = 0; i < 32; ++i) v_[i] = wp_[(size_t)(2 * i) * ldw];
}
DI void tr_finish(const float (&v_)[32], int sc, int k0, bf16* WT, int ldt, int dstrow0, LAS float* scr, int lane) {
#pragma unroll
    for (int i = 0; i < 32; ++i) scr[(2 * i + (lane >> 5)) * 33 + (lane & 31)] = sc >= 0 ? v_[i] : 0.f;
    asm volatile("s_waitcnt lgkmcnt(0)" ::: "memory");
    const int c = lane & 7;
#pragma unroll
    for (int j = 0; j < 4; ++j) { const int n = (lane >> 3) + 8 * j; const LAS float* s = scr + (8 * c) * 33 + n;
        v4u o; o.x = pk2(s[0 * 33], s[1 * 33]); o.y = pk2(s[2 * 33], s[3 * 33]); o.z = pk2(s[4 * 33], s[5 * 33]); o.w = pk2(s[6 * 33], s[7 * 33]);
        *(GAS v4u*)(WT + (size_t)(dstrow0 + n) * ldt + k0 + 8 * c) = o; }
    asm volatile("s_waitcnt lgkmcnt(0)" ::: "memory");
}
DI void tr_item(const float* W, int ldw, int k0, int sc, bf16* WT, int ldt, int dstrow0, LAS float* scr, int lane) {
    float v_[32];
    tr_load(v_, W, ldw, k0, sc, lane);
    tr_finish(v_, sc, k0, WT, ldt, dstrow0, scr, lane);
}
DI void p_prologue(Ctx& C) {
    const int gw = C.blk * NWAVES + C.wave, NGW = C.G * NWAVES, lane = C.lane;
    LAS float* SC = (LAS float*)(C.lds + 96 * 1024);
    for (int i = C.tid; i < NB * D; i += NTHR) SC[i] = silu(KIN(1)[i]);
    BLOCK_SYNC();
    {
        float* MODP = WSP(float, WS_MODP);
        for (int it = gw; it < 2 * 96 * 16; it += NGW) {
            const int ks = it & 15, nb = (it >> 4) % 96, l = it / (16 * 96);
            const int n = nb * 64 + lane; const float* wp = KIN(3) + (size_t)l * D * 6144 + (size_t)(ks * 64) * 6144 + n;
            float acc[8];
#pragma unroll
            for (int b = 0; b < 8; ++b) acc[b] = 0.f;
#pragma unroll 16
            for (int k = 0; k < 64; ++k) { const float w = wp[(size_t)k * 6144];
#pragma unroll
                for (int b = 0; b < 8; ++b) acc[b] += SC[b * D + ks * 64 + k] * w; }
#pragma unroll
            for (int b = 0; b < 8; ++b) MODP[(((size_t)ks * 2 + l) * 8 + b) * 6144 + n] = acc[b];
        }
    }
    if (C.blk == 0 && C.tid < 129) {
        const int n = C.tid; int bucket;
        if (n < 16) bucket = n; else { const int large = 16 + (int)(logf((float)n / 16.0f) / 2.0794415416798357f * 16.0f); bucket = large < 31 ? large : 31; }
        if (n == 128) bucket = 31;
        float* BL = WSP(float, WS_BL);
#pragma unroll
        for (int h = 0; h < 4; ++h) BL[h * 132 + n] = KIN(2)[bucket * 4 + h] * LOG2E;
    }
    if (C.blk == 1 && C.tid < 128) { const int l = C.tid >> 6, d = C.tid & 63; float* gt = WSP(float, WS_GT) + l * 384 + d;
        gt[0] = KIN(13)[l * 64 + d] * QSCALE; gt[64] = KIN(14)[l * 64 + d]; gt[128] = QSCALE; gt[192] = KIN(15)[l * 64 + d] * QSCALE;
        gt[256] = KIN(16)[l * 192 + 64 + d]; gt[320] = KIN(16)[l * 192 + 128 + d]; }
    if (gw >= NGW - 4) { const int q = gw - (NGW - 4), l = q >> 1, kv = q & 1; const float* W = (kv ? KIN(19) : KIN(18)) + (size_t)l * 2048 * 64 + lane; const float* pos = KIN(17) + (size_t)l * 2048;
        float a0 = 0.f, a1 = 0.f, a2 = 0.f, a3 = 0.f;
#pragma unroll 4
        for (int i = 0; i < 2048; i += 4) { a0 += pos[i] * W[(size_t)i * 64]; a1 += pos[i + 1] * W[(size_t)(i + 1) * 64]; a2 += pos[i + 2] * W[(size_t)(i + 2) * 64]; a3 += pos[i + 3] * W[(size_t)(i + 3) * 64]; }
        WSP(float, WS_P0)[(l * 2 + kv) * 64 + lane] = (a0 + a1) + (a2 + a3); }
    LAS float* scr = (LAS float*)(C.lds + C.wave * 8448);
    constexpr int I_IN = 16 * (PW / 32), I_OUT = 16 * 32, I_GU = 16 * (2 * FF / 32), I_D = (FF / 64) * 32;
    constexpr int I_WC = 2 * 2 * 2 * 16 * 2;
    constexpr int NITEMS = 2 * I_IN + 2 * I_OUT + I_GU + I_D + I_WC;
    for (int it = gw; it < NITEMS; it += NGW) {
        int r = it;
        if (r < 2 * I_IN) { const int l = r / I_IN; r -= l * I_IN; const int nblk = PW / 32, kb = r / nblk, nb = r % nblk;
            tr_item(KIN(7) + (size_t)l * D * INW, INW, 64 * kb, map_in_col(32 * nb + (lane & 31)), WSP(bf16, WS_WIN) + (size_t)l * PW * D, D, 32 * nb, scr, lane); continue; }
        r -= 2 * I_IN;
        if (r < 2 * I_OUT) { const int l = r / I_OUT; r -= l * I_OUT; const int kb = r / 32, nb = r % 32;
            tr_item(KIN(8) + (size_t)l * D * D, D, 64 * kb, 32 * nb + (lane & 31), WSP(bf16, WS_WOUT) + (size_t)l * D * D, D, 32 * nb, scr, lane); continue; }
        r -= 2 * I_OUT;
        if (r < I_GU) { const int nblk = 2 * FF / 32, kb = r / nblk, nb = r % nblk; const int pn = nb >> 3, jb = nb & 7;
            tr_item(jb < 4 ? KIN(21) : KIN(22), FF, 64 * kb, pn * 128 + (jb & 3) * 32 + (lane & 31), WSP(bf16, WS_WGU), D, 32 * nb, scr, lane); continue; }
        r -= I_GU;
        if (r < I_D) { const int kb = r / 32, nb = r % 32;
            tr_item(KIN(23), D, 64 * kb, 32 * nb + (lane & 31), WSP(bf16, WS_WD), FF, 32 * nb, scr, lane); continue; }
        r -= I_D;
        { const int nb = r & 1, kb = (r >> 1) & 15, a = (r >> 5) & 1, kv = (r >> 6) & 1, l = r >> 7;
            tr_item((kv ? KIN(19) : KIN(18)) + (size_t)l * 2048 * 64 + (size_t)a * 1024 * 64, 64, 64 * kb, 32 * nb + (lane & 31), WSP(bf16, WS_WCT) + (size_t)(l * 2 + kv) * 128 * 1024, 1024, a * 64 + 32 * nb, scr, lane); }
    }
}
constexpr int MOE_I_MGU = 16 * (2 * FFE / 32), MOE_I_MD = (FFE / 64) * 32, MOE_CONV_ITEMS = NEXP * (MOE_I_MGU + MOE_I_MD);
struct ConvIt { const float* W; int ldw, k0, sc, ldt, dstrow0; bf16* WT; };
DI ConvIt moe_conv_decode(Ctx& C, int r) {
    const int lane = C.lane; ConvIt q;
    if (r < NEXP * MOE_I_MGU) { const int e = r / MOE_I_MGU; r -= e * MOE_I_MGU; const int nblk = 2 * FFE / 32, kb = r / nblk, nb = r % nblk; const int pn = nb >> 3, jb = nb & 7;
        q.W = (jb < 4 ? KIN(26) : KIN(27)) + (size_t)e * D * FFE; q.ldw = FFE; q.k0 = 64 * kb; q.sc = pn * 128 + (jb & 3) * 32 + (lane & 31); q.WT = WSP(bf16, WS_MWGU) + (size_t)e * 2 * FFE * D; q.ldt = D; q.dstrow0 = 32 * nb; return q; }
    r -= NEXP * MOE_I_MGU;
    { const int e = r / MOE_I_MD; r -= e * MOE_I_MD; const int kb = r / 32, nb = r % 32;
        q.W = KIN(28) + (size_t)e * FFE * D; q.ldw = D; q.k0 = 64 * kb; q.sc = 32 * nb + (lane & 31); q.WT = WSP(bf16, WS_MWD) + (size_t)e * D * FFE; q.ldt = FFE; q.dstrow0 = 32 * nb; return q; }
}
DI void moe_conv_items4(Ctx& C, int r0, LAS float* scr) {
    const ConvIt q0 = moe_conv_decode(C, r0), q1 = moe_conv_decode(C, r0 + 1), q2 = moe_conv_decode(C, r0 + 2), q3 = moe_conv_decode(C, r0 + 3);
    float v0[32], v1[32], v2[32], v3[32];
    tr_load(v0, q0.W, q0.ldw, q0.k0, q0.sc, C.lane); tr_load(v1, q1.W, q1.ldw, q1.k0, q1.sc, C.lane); tr_load(v2, q2.W, q2.ldw, q2.k0, q2.sc, C.lane); tr_load(v3, q3.W, q3.ldw, q3.k0, q3.sc, C.lane);
    tr_finish(v0, q0.sc, q0.k0, q0.WT, q0.ldt, q0.dstrow0, scr, C.lane); tr_finish(v1, q1.sc, q1.k0, q1.WT, q1.ldt, q1.dstrow0, scr, C.lane);
    tr_finish(v2, q2.sc, q2.k0, q2.WT, q2.ldt, q2.dstrow0, scr, C.lane); tr_finish(v3, q3.sc, q3.k0, q3.WT, q3.ldt, q3.dstrow0, scr, C.lane);
}
DI void p_modfin(Ctx& C) {
    const float* MODP = WSP(float, WS_MODP); float* MOD = WSP(float, WS_MOD);
    for (int i = C.blk * NTHR + C.tid; i < 2 * 8 * 6144; i += C.G * NTHR) {
        const int n = i % 6144, l = i / (8 * 6144); float s = KIN(4)[l * 6144 + n];
#pragma unroll
        for (int ks = 0; ks < 16; ++ks) s += MODP[(size_t)ks * (2 * 8 * 6144) + i];
        MOD[i] = s;
    }
}

template <bool ROUTE> DI void p_norm(Ctx& C, int l, const float* xin, const float* gain, int off_sh, int off_sc) {
    const int lane = C.lane; bf16* H = WSP(bf16, WS_H);
    const int rows_per_blk = T / C.G;
    const int m_base = C.blk * rows_per_blk, b = m_base >> 12;
    const float* MOD = WSP(float, WS_MOD) + (size_t)(l * 8 + b) * 6144;
    f32x4 gs[4], sh[4];
#pragma unroll
    for (int j = 0; j < 4; ++j) { const int c0 = 4 * lane + 256 * j; const f32x4 g = *(const f32x4*)(gain + c0), sc = *(const f32x4*)(MOD + off_sc + c0); gs[j] = g * (sc + 1.0f); sh[j] = *(const f32x4*)(MOD + off_sh + c0); }
    LAS int* cntL = (LAS int*)(C.lds);
    LAS int* baseL = (LAS int*)(C.lds + 64);
    LAS int* recE = (LAS int*)(C.lds + 1024);
    LAS int* recS = (LAS int*)(C.lds + 1024 + 2048);
    LAS float* recW = (LAS float*)(C.lds + 1024 + 4096);
    LAS float* RW = (LAS float*)(C.lds + 8192);
    if (ROUTE) { if (C.tid < 8) cntL[C.tid] = 0; for (int i = C.tid; i < D * 8 / 4; i += NTHR) *(LAS f32x4*)(RW + 4 * i) = *(const f32x4*)(KIN(24) + 4 * i); BLOCK_SYNC(); }
    for (int r = C.wave; r < rows_per_blk; r += NWAVES) {
        const int m = m_base + r; const f32x4* xr = (const f32x4*)(xin + (size_t)m * D) + lane;
        f32x4 v[4]; float s = 0.f;
#pragma unroll
        for (int j = 0; j < 4; ++j) { v[j] = xr[64 * j]; s += (v[j].x * v[j].x + v[j].y * v[j].y) + (v[j].z * v[j].z + v[j].w * v[j].w); }
        const float rstd = 1.0f / sqrtf(wave_sum(s) * (1.0f / D) + NORM_EPS);
        v2u* o8 = (v2u*)(H + (size_t)m * D) + lane;
#pragma unroll
        for (int j = 0; j < 4; ++j) { v[j] = v[j] * rstd * gs[j] + sh[j]; v2u w; w.x = pk2(v[j].x, v[j].y); w.y = pk2(v[j].z, v[j].w); o8[64 * j] = w; }
        if (ROUTE) {
            float lg[8];
#pragma unroll
            for (int e = 0; e < 8; ++e) lg[e] = 0.f;
#pragma unroll
            for (int j = 0; j < 4; ++j)
#pragma unroll
                for (int i = 0; i < 4; ++i) { const LAS float* rw = RW + (4 * lane + 256 * j + i) * 8; const f32x4 w0 = *(const LAS f32x4*)rw, w1 = *(const LAS f32x4*)(rw + 4); const float hv = v[j][i];
                    lg[0] += hv * w0.x; lg[1] += hv * w0.y; lg[2] += hv * w0.z; lg[3] += hv * w0.w; lg[4] += hv * w1.x; lg[5] += hv * w1.y; lg[6] += hv * w1.z; lg[7] += hv * w1.w; }
#pragma unroll
            for (int e = 0; e < 8; ++e) lg[e] = wave_sum(lg[e]) + KIN(25)[e];
            int e0 = 0; float l0 = lg[0];
#pragma unroll
            for (int e = 1; e < 8; ++e) if (lg[e] > l0) { l0 = lg[e]; e0 = e; }
            int e1 = -1; float l1 = -3.0e38f;
#pragma unroll
            for (int e = 0; e < 8; ++e) if (e != e0 && lg[e] > l1) { l1 = lg[e]; e1 = e; }
            const float p1 = ex2((l1 - l0) * LOG2E), w0 = 1.0f / (1.0f + p1), w1 = p1 * w0;
            if (lane == 0) { const int s0 = atomicAdd((int*)&cntL[e0], 1), s1 = atomicAdd((int*)&cntL[e1], 1);
                recE[2 * r] = e0; recE[2 * r + 1] = e1; recS[2 * r] = s0; recS[2 * r + 1] = s1; recW[2 * r] = w0; recW[2 * r + 1] = w1; }
        }
    }
    if (ROUTE) {
        BLOCK_SYNC();
        if (C.tid < 8) baseL[C.tid] = (int)__hip_atomic_fetch_add((unsigned*)(C.ctl + CW_ECNT + C.tid), (unsigned)cntL[C.tid], RLX_AGENT);
        BLOCK_SYNC();
        int* TOKOF = WSP(int, WS_TOKOF); float* TOKW = WSP(float, WS_TOKW);
        for (int i = C.tid; i < 2 * rows_per_blk; i += NTHR) { const int e = recE[i], slot = baseL[e] + recS[i], tok = m_base + (i >> 1);
            TOKOF[e * T + slot] = tok | ((i & 1) << 30); TOKW[e * T + slot] = recW[i]; }
    }
}

DI void prep_unit(Ctx& C, int l, int b, int c, int mode) {
    const int tid = C.tid, lane = C.lane, wave = C.wave;
    bf16* PROJ = WSP(bf16, WS_PROJ); bf16* QKC = WSP(bf16, WS_QKC);
    const int t0 = 64 * c; const size_t m0 = (size_t)b * SEQ + t0;
    LAS char* KWt = (LAS char*)(C.lds); LAS char* Vt = (LAS char*)(C.lds + 49152); LAS float* EW = (LAS float*)(C.lds + 98304);
    constexpr int VP = 192, VTB = 64 * 192;
    v4u xr[11], vr[4];
    { const int rg = tid >> 6, ch0 = (tid & 63) * 8;
#pragma unroll
      for (int i = 0; i < 11; ++i) { const int r = 8 * rg - 3 + i; xr[i] = (r >= 0 || c > 0) ? *(const GAS v4u*)(PROJ + (long)((long)m0 + r) * PW + ch0) : (v4u){0u, 0u, 0u, 0u}; }
#pragma unroll
      for (int hh = 0; hh < 4; ++hh) { const int r = tid >> 3, c8 = tid & 7; vr[hh] = *(const GAS v4u*)(PROJ + (m0 + r) * PW + C_MV + hh * 64 + c8 * 8); } }
    {
        const int hd = wave & 3, bh = b * 4 + hd; const size_t m = m0 + lane;
        if (wave < 4) {
            const float ig = bf2f(PROJ[m * PW + C_MIF + hd]) + KIN(10)[l * 8 + hd], fg = bf2f(PROJ[m * PW + C_MIF + 4 + hd]) + KIN(10)[l * 8 + 4 + hd];
            float bcs = log_sigmoid(fg);
#pragma unroll
            for (int o = 1; o < 64; o <<= 1) { const float t = __shfl_up(bcs, o); if (lane >= o) bcs += t; }
            const float g = __shfl(bcs, 63), w = g - bcs + ig, mloc = wave_max(w);
            EW[hd * 64 + lane] = ex2((w - mloc) * LOG2E);
            WSP(float, WS_GB)[(size_t)bh * SEQ + t0 + lane] = bcs; WSP(float, WS_GI)[(size_t)bh * SEQ + t0 + lane] = ig;
            if (lane == 0) { WSP(float, WS_G)[bh * 64 + c] = g; WSP(float, WS_MLOC)[bh * 64 + c] = mloc; }
        } else {
            const float ff = bf2f(PROJ[m * PW + C_FF + hd]) + KIN(12)[l * 4 + hd];
            float fcs = log_sigmoid(ff);
#pragma unroll
            for (int o = 1; o < 64; o <<= 1) { const float t = __shfl_up(fcs, o); if (lane >= o) fcs += t; }
            WSP(float, WS_FLOC)[(size_t)bh * SEQ + t0 + lane] = fcs;
            if (lane == 63) WSP(float, WS_FTOT)[bh * 64 + c] = fcs;
        }
    }
    LDS_BARRIER();
    {
        const int rg = tid >> 6, cp = tid & 63, ch0 = cp * 8; const float* cw = KIN(9) + (size_t)l * 4 * 512 + ch0;
        float wj[4][8];
#pragma unroll
        for (int j = 0; j < 4; ++j) { const f32x4 a = *(const f32x4*)(cw + j * 512), b4 = *(const f32x4*)(cw + j * 512 + 4); wj[j][0] = a.x; wj[j][1] = a.y; wj[j][2] = a.z; wj[j][3] = a.w; wj[j][4] = b4.x; wj[j][5] = b4.y; wj[j][6] = b4.z; wj[j][7] = b4.w; }
        const bool isk = ch0 >= 256; const int kh = (ch0 - 256) >> 6, kc = ch0 & 63;
#pragma unroll
        for (int i = 0; i < 8; ++i) { const int r = 8 * rg + i; float y[8];
#pragma unroll
            for (int e = 0; e < 8; ++e) { float acc = 0.f;
#pragma unroll
                for (int j = 0; j < 4; ++j) { const v4u xv = xr[i + 3 - j]; const unsigned wd = (e < 2) ? xv.x : (e < 4) ? xv.y : (e < 6) ? xv.z : xv.w; acc += wj[j][e] * ((e & 1) ? bfhi(wd) : bflo(wd)); }
                y[e] = silu(acc) * (isk ? 0.125f : 1.0f); }
            v4u o; o.x = pk2(y[0], y[1]); o.y = pk2(y[2], y[3]); o.z = pk2(y[4], y[5]); o.w = pk2(y[6], y[7]);
            *(GAS v4u*)(QKC + (m0 + r) * 512 + ch0) = o;
            if (isk) { const float ew = EW[kh * 64 + r]; v4u k2; k2.x = pk2(y[0] * ew, y[1] * ew); k2.y = pk2(y[2] * ew, y[3] * ew); k2.z = pk2(y[4] * ew, y[5] * ew); k2.w = pk2(y[6] * ew, y[7] * ew);
                *(LAS v4u*)(KWt + kh * VTB + r * VP + kc * 2) = k2; } }
#pragma unroll
        for (int hh = 0; hh < 4; ++hh) { const int r = tid >> 3, c8 = tid & 7; *(LAS v4u*)(Vt + hh * VTB + r * VP + c8 * 16) = vr[hh]; }
    }
    LDS_BARRIER();
    {
        const int hd = wave & 3, dvh = wave >> 2, bh = b * 4 + hd, h = lane >> 5, i16 = lane & 15, q4 = i16 >> 2, p = i16 & 3, blk = (lane >> 4) & 1;
        LAS const char* va = Vt + hd * VTB + (8 * h + q4) * VP + (32 * dvh + 16 * blk + 4 * p) * 2;
        LAS const char* kb = KWt + hd * VTB + (8 * h + q4) * VP + (16 * blk + 4 * p) * 2;
        float* ST = WSP(float, WS_STATE) + ((size_t)bh * 64 + c) * 4096;
#pragma unroll
        for (int nt = 0; nt < 2; ++nt) {
            f32x16 acc;
#pragma unroll
            for (int r = 0; r < 16; ++r) acc[r] = 0.f;
#pragma unroll
            for (int s = 0; s < 4; ++s) {
                const s16x4 alo = att_trr(va + 16 * s * VP), ahi = att_trr(va + (16 * s + 4) * VP), blo = att_trr(kb + 16 * s * VP + nt * 64), bhi = att_trr(kb + (16 * s + 4) * VP + nt * 64);
                acc = __builtin_amdgcn_mfma_f32_32x32x16_bf16(__builtin_shufflevector(alo, ahi, 0, 1, 2, 3, 4, 5, 6, 7), __builtin_shufflevector(blo, bhi, 0, 1, 2, 3, 4, 5, 6, 7), acc, 0, 0, 0);
            }
#pragma unroll
            for (int r = 0; r < 16; ++r) ST[(32 * dvh + (r & 3) + 8 * (r >> 2) + 4 * h) * 64 + 32 * nt + (lane & 31)] = acc[r];
        }
        if (tid < 256) { const int hh = tid >> 6, dk = tid & 63; float s = 0.f;
#pragma unroll 8
            for (int r = 0; r < 64; ++r) s += bf2f(*(LAS const bf16*)(KWt + hh * VTB + r * VP + dk * 2));
            WSP(float, WS_NCH)[((size_t)(b * 4 + hh) * 64 + c) * 64 + dk] = s; }
    }
    for (int i = tid; i < 64 * 12; i += NTHR) { const int r = i / 12, j = i % 12; WSP(float, WS_NG)[(m0 + r) * 16 + j] = sigmoid_f(bf2f(PROJ[(m0 + r) * PW + C_NG + j]) + KIN(20)[l * 12 + j]); }
    LDS_BARRIER();
}
DI void compress_tile(Ctx& C, int l, int wt) {
    const int lane = C.lane, h = lane >> 5, r32 = lane & 31;
    const int nt = wt & 3, mt = (wt >> 2) & 7, b = (wt >> 5) & 7, kv = wt >> 8;
    const bf16* PROJ = WSP(bf16, WS_PROJ);
    const bf16* ap = PROJ + ((size_t)b * SEQ + 16 * (mt * 32 + r32)) * PW + (kv ? C_VC : C_KC) + 8 * h;
    const bf16* bp = WSP(bf16, WS_WCT) + ((size_t)(l * 2 + kv) * 128 + nt * 32 + r32) * 1024 + 8 * h;
    f32x16 acc;
#pragma unroll
    for (int r = 0; r < 16; ++r) acc[r] = 0.f;
#pragma unroll 4
    for (int ks = 0; ks < 64; ++ks) {
        const bf16x8 a = *(const bf16x8*)(ap + (size_t)(ks >> 2) * PW + 16 * (ks & 3)), bb = *(const bf16x8*)(bp + 16 * ks);
        acc = __builtin_amdgcn_mfma_f32_32x32x16_bf16(a, bb, acc, 0, 0, 0);
    }
    float* U = WSP(float, WS_U) + (((size_t)kv * 8 + b) * 256 + mt * 32) * 128 + nt * 32 + r32;
#pragma unroll
    for (int r = 0; r < 16; ++r) U[(size_t)((r & 3) + 8 * (r >> 2) + 4 * h) * 128] = acc[r];
}
DI void p_prep(Ctx& C, int l, int mode) {
    { const int gw = C.blk * NWAVES + C.wave; if (gw < 512) compress_tile(C, l, gw); }
    for (int u = C.blk; u < NB * 64; u += C.G) prep_unit(C, l, u >> 6, u & 63, mode);
}

DI void p_scan(Ctx& C, int l, bool dry) {
    { const int gw = C.blk * NWAVES + C.wave, NGW = C.G * NWAVES, lane = C.lane; const float* U = WSP(float, WS_U); const float* P0 = WSP(float, WS_P0) + l * 128;
      for (int it = gw; it < 8 * 256; it += NGW) { const int b = it >> 8, n = it & 255; float kx = 0.f, vx = 0.f;
          if (n < 255) { const float* u0 = U + ((size_t)b * 256 + n) * 128; const float* u1 = U + ((size_t)(8 + b) * 256 + n) * 128;
              kx = u0[lane] + u0[128 + 64 + lane] + P0[lane]; vx = u1[lane] + u1[128 + 64 + lane] + P0[64 + lane];
              const float ss = wave_sum(kx * kx); kx = kx / sqrtf(ss * (1.0f / 64.0f) + NORM_EPS) * KIN(16)[l * 192 + lane]; }
          if (!dry) { WSP(bf16, WS_KCMP)[((size_t)b * 256 + n) * 64 + lane] = f2bf(kx); WSP(bf16, WS_VCMP)[((size_t)b * 256 + n) * 64 + lane] = f2bf(vx); } } }
    const int gid = C.blk * NTHR + C.tid;
    for (int g = gid; g < 32 * 4096; g += C.G * NTHR) {
        const int bh = g >> 12, e = g & 4095;
        const float* Gp = WSP(float, WS_G) + bh * 64; const float* ML = WSP(float, WS_MLOC) + bh * 64;
        float* ST = WSP(float, WS_STATE) + (size_t)bh * 64 * 4096 + e; float* NC = WSP(float, WS_NCH) + (size_t)bh * 64 * 64 + e;
        float Cst = 0.f, nst = 0.f, m = 0.f;
        float cc[64];
#pragma unroll
        for (int c = 0; c < 64; ++c) cc[c] = *(const GAS float*)(ST + (size_t)c * 4096);
        const float gq = Gp[C.lane], mq = ML[C.lane];
#pragma unroll
        for (int c = 0; c < 64; ++c) {
            const float nc = (e < 64) ? *(const GAS float*)(NC + c * 64) : 0.f;
            if (!dry) { ST[(size_t)c * 4096] = Cst; if (e < 64) NC[c * 64] = nst;
                if (e == 0) WSP(float, WS_MPREV)[bh * 64 + c] = m; }
            const float gc = __shfl(gq, c), ml = __shfl(mq, c), mn = fmaxf(gc + m, ml), a = ex2((gc + m - mn) * LOG2E), bb = ex2((ml - mn) * LOG2E);
            Cst = a * Cst + bb * cc[c]; nst = a * nst + bb * nc; m = mn;
        }
        { const float* FT = WSP(float, WS_FTOT) + bh * 64; const int ch = e >> 6; const float off = wave_sum((C.lane < ch) ? FT[C.lane] : 0.f);
          const float f2v = (WSP(float, WS_FLOC)[g] + off) * LOG2E; if (!dry) WSP(float, WS_F2)[g] = f2v; else if (f2v == 123.456f) WSP(float, WS_F2)[g] = Cst + nst; }
    }
}

namespace att {
constexpr int KP = 144, VP = 192;
constexpr int KT = 64 * KP, VT = 64 * VP;
constexpr int L_K0 = 0, L_V0 = 3 * KT, L_F = 3 * KT + 3 * VT  , L_BL = L_F + 512, L_IMP = 67584, L_TOT = L_IMP + 65536, L_SEL = L_TOT + 16384, L_FLAG = L_SEL + 512, L_EL = L_FLAG + 64  , L_BL2 = L_EL + 4 * 320 * 4  , L_NST = L_BL2 + 4 * 132 * 4  , L_END = L_NST + 64;
static_assert(L_BL + 4 * 132 * 4 <= L_IMP && L_END <= MISC_OFF, "attention LDS map");
typedef short v4i16_t __attribute__((ext_vector_type(4)));
#define MFMA32(a, b, c) __builtin_amdgcn_mfma_f32_32x32x16_bf16((a), (b), (c), 0, 0, 0)
DI int crow(int r, int h) { return (r & 3) + 8 * (r >> 2) + 4 * h; }
DI s16x4 trr(LAS const char* p) { return __builtin_bit_cast(s16x4, __builtin_amdgcn_ds_read_tr16_b64_v4i16((LAS v4i16_t*)p)); }
struct Stg { v4u k, v; };
DI void stage_load(Stg& s, const bf16* Kg, const bf16* Vg, int ld, int tid) { const int row = tid >> 3, ch = tid & 7; s.k = *(const GAS v4u*)(Kg + (size_t)row * ld + ch * 8); s.v = *(const GAS v4u*)(Vg + (size_t)row * ld + ch * 8); }
DI void stage_store(const Stg& s, LAS char* Kt, LAS char* Vt, int tid) { const int row = tid >> 3, ch = tid & 7; *(LAS v4u*)(Kt + row * KP + ch * 16) = s.k; *(LAS v4u*)(Vt + row * VP + ch * 16) = s.v; }
DI void qkt(f32x16& p0, f32x16& p1, LAS const char* Kt, const bf16x8 (&qf)[4], int lane) {
    LAS const char* kb = Kt + (lane & 31) * KP + (lane >> 5) * 16;
#pragma unroll
    for (int d0 = 0; d0 < 4; ++d0) {
        const bf16x8 a0 = *(LAS const bf16x8*)(kb + d0 * 32), a1 = *(LAS const bf16x8*)(kb + 32 * KP + d0 * 32);
        p0 = MFMA32(a0, qf[d0], p0); p1 = MFMA32(a1, qf[d0], p1);
    }
}
DI bf16x8 pack8(const f32x16& p, int b) { v4u w; w.x = pk2(p[b], p[b + 1]); w.y = pk2(p[b + 2], p[b + 3]); w.z = pk2(p[b + 4], p[b + 5]); w.w = pk2(p[b + 6], p[b + 7]); return __builtin_bit_cast(bf16x8, w); }
DI void pv_packed(f32x16 (&o)[2], LAS const char* Vt, const bf16x8 (&pb)[4], int lane) {
    const int h = lane >> 5, i16 = lane & 15, q4 = i16 >> 2, p = i16 & 3, blk = (lane >> 4) & 1;
    LAS const char* vb = Vt + (4 * h + q4) * VP + (16 * blk + 4 * p) * 2;
#pragma unroll
    for (int hf = 0; hf < 2; ++hf) {
        s16x4 lo[4], hi[4];
#pragma unroll
        for (int i = 0; i < 4; ++i) { const int s = 2 * hf + (i >> 1), dh = i & 1; lo[i] = trr(vb + (16 * s) * VP + dh * 64); hi[i] = trr(vb + (16 * s + 8) * VP + dh * 64); }
        __builtin_amdgcn_sched_barrier(0);
#pragma unroll
        for (int i = 0; i < 4; ++i) { const int s = 2 * hf + (i >> 1), dh = i & 1;
            o[dh] = MFMA32(__builtin_shufflevector(lo[i], hi[i], 0, 1, 2, 3, 4, 5, 6, 7), pb[s], o[dh]); }
    }
}
DI void pack_p(bf16x8 (&pb)[4], const f32x16& p0, const f32x16& p1) { pb[0] = pack8(p0, 0); pb[1] = pack8(p0, 8); pb[2] = pack8(p1, 0); pb[3] = pack8(p1, 8); }
DI void pv(f32x16 (&o)[2], LAS const char* Vt, const f32x16& p0, const f32x16& p1, int lane) { bf16x8 pb[4]; pack_p(pb, p0, p1); pv_packed(o, Vt, pb, lane); }
DI float half_max(float v) { return fmaxf(v, __shfl_xor(v, 32)); }
DI float half_sum(float v) { return v + __shfl_xor(v, 32); }
template <bool MASKED> DI void osm(f32x16& p0, f32x16& p1, float& m_run, float& lsum, f32x16 (&o)[2]) {
    float tm = -1e30f;
#pragma unroll
    for (int r = 0; r < 16; ++r) tm = fmaxf(tm, fmaxf(p0[r], p1[r]));
    tm = half_max(tm);
    const float mn = fmaxf(m_run, tm);
    if (__any(mn > m_run)) {
        const float f = ex2(m_run - mn); m_run = mn; lsum *= f;
#pragma unroll
        for (int r = 0; r < 16; ++r) { o[0][r] *= f; o[1][r] *= f; }
    }
    float ps = 0.f;
#pragma unroll
    for (int r = 0; r < 16; ++r) { float a = ex2(p0[r] - mn), b = ex2(p1[r] - mn); if (MASKED) { a = p0[r] > -1e29f ? a : 0.f; b = p1[r] > -1e29f ? b : 0.f; } p0[r] = a; p1[r] = b; ps += a + b; }
    lsum += ps;
}
DI void osm_fast(f32x16& p0, f32x16& p1, float cb, bool active, float& m_run, float& lsum, f32x16 (&o)[2]) {
    float t0 = fmaxf(p0[0], p1[0]), t1 = fmaxf(p0[1], p1[1]);
#pragma unroll
    for (int r = 2; r < 16; r += 2) { t0 = fmaxf(t0, fmaxf(p0[r], p1[r])); t1 = fmaxf(t1, fmaxf(p0[r + 1], p1[r + 1])); }
    float tm = active ? fmaxf(t0, t1) + cb : -1e30f;
    tm = half_max(tm);
    const float mn = fmaxf(m_run, tm);
    if (__any(mn > m_run)) {
        const float f = ex2(m_run - mn); m_run = mn; lsum *= f;
#pragma unroll
        for (int r = 0; r < 16; ++r) { o[0][r] *= f; o[1][r] *= f; }
    }
    const float e = active ? mn - cb : 1e30f;
    float ps0 = 0.f, ps1 = 0.f;
#pragma unroll
    for (int r = 0; r < 16; ++r) { const float a = ex2(p0[r] - e), b = ex2(p1[r] - e); p0[r] = a; p1[r] = b; ps0 += a; ps1 += b; }
    lsum += ps0 + ps1;
}
DI void store_o(bf16* orow, const f32x16 (&o)[2], float sc, int h) {
#pragma unroll
    for (int dh = 0; dh < 2; ++dh)
#pragma unroll
        for (int g = 0; g < 4; ++g) { v2u w; w.x = pk2(o[dh][4 * g] * sc, o[dh][4 * g + 1] * sc); w.y = pk2(o[dh][4 * g + 2] * sc, o[dh][4 * g + 3] * sc); *(v2u*)(orow + 32 * dh + 8 * g + 4 * h) = w; }
}

DI void fox_tile(LAS const char* Kt, LAS const char* Vt, const LAS float* fk, const bf16x8 (&qf)[4], int key0, bool diag, int tq, float f2q, float& m_run, float& lsum, f32x16 (&o)[2], int lane) {
    const int h = lane >> 5;
    f32x16 p0, p1;
#pragma unroll
    for (int r = 0; r < 16; ++r) { p0[r] = 0.f; p1[r] = 0.f; }
    qkt(p0, p1, Kt, qf, lane);
    if (diag) {
#pragma unroll
        for (int g = 0; g < 4; ++g) { const f32x4 fa = *(const LAS f32x4*)(fk + 8 * g + 4 * h), fb = *(const LAS f32x4*)(fk + 32 + 8 * g + 4 * h);
#pragma unroll
            for (int i = 0; i < 4; ++i) { const int r = 4 * g + i, ka = key0 + 8 * g + 4 * h + i; float sa = p0[r] + (f2q - fa[i]), sb = p1[r] + (f2q - fb[i]);
                if (ka > tq) sa = -1e30f; if (ka + 32 > tq) sb = -1e30f; p0[r] = sa; p1[r] = sb; } }
        osm<true>(p0, p1, m_run, lsum, o);
    } else {
#pragma unroll
        for (int g = 0; g < 4; ++g) { const f32x4 fa = *(const LAS f32x4*)(fk + 8 * g + 4 * h), fb = *(const LAS f32x4*)(fk + 32 + 8 * g + 4 * h);
#pragma unroll
            for (int i = 0; i < 4; ++i) { p0[4 * g + i] -= fa[i]; p1[4 * g + i] -= fb[i]; } }
        osm_fast(p0, p1, f2q, true, m_run, lsum, o);
    }
    pv(o, Vt, p0, p1, lane);
}
DI void fox_tile_s(LAS const char* Kt, LAS const char* Vt, const LAS float* fk, const bf16x8 (&qf)[4], int key0, bool diag, int tq, const f32x16& cq, float& lsum, f32x16 (&o)[2], int lane) {
    const int h = lane >> 5;
    f32x16 p0 = cq, p1 = cq;
    qkt(p0, p1, Kt, qf, lane);
    float ps0 = 0.f, ps1 = 0.f;
    if (diag) {
#pragma unroll
        for (int g = 0; g < 4; ++g) { const f32x4 fa = *(const LAS f32x4*)(fk + 8 * g + 4 * h), fb = *(const LAS f32x4*)(fk + 32 + 8 * g + 4 * h);
#pragma unroll
            for (int i = 0; i < 4; ++i) { const int r = 4 * g + i, ka = key0 + 8 * g + 4 * h + i; float sa = p0[r] - fa[i], sb = p1[r] - fb[i];
                if (ka > tq) sa = -1e30f; if (ka + 32 > tq) sb = -1e30f; const float a = ex2(sa), b = ex2(sb); p0[r] = a; p1[r] = b; ps0 += a; ps1 += b; } }
    } else {
#pragma unroll
        for (int g = 0; g < 4; ++g) { const f32x4 fa = *(const LAS f32x4*)(fk + 8 * g + 4 * h), fb = *(const LAS f32x4*)(fk + 32 + 8 * g + 4 * h);
#pragma unroll
            for (int i = 0; i < 4; ++i) { const int r = 4 * g + i; const float a = ex2(p0[r] - fa[i]), b = ex2(p1[r] - fb[i]); p0[r] = a; p1[r] = b; ps0 += a; ps1 += b; } }
    }
    lsum += ps0 + ps1;
    pv(o, Vt, p0, p1, lane);
}
constexpr int RING = 5, L_KR = 0, L_VR = RING * KT, L_FR = RING * (KT + VT);
static_assert(L_FR + RING * 256 <= L_FLAG, "ring LDS map");
DI void fox_unit(Ctx& C, int l, int b, int hd, int qb) {
    const int tid = C.tid, lane = C.lane, w = C.wave, r32 = lane & 31, h = lane >> 5;
    const bf16* PROJ = WSP(bf16, WS_PROJ); const size_t m0 = (size_t)b * SEQ;
    const bf16* Kg = PROJ + m0 * PW + C_FK + hd * 64; const bf16* Vg = PROJ + m0 * PW + C_FV + hd * 64;
    const float* F2 = WSP(float, WS_F2) + (size_t)(b * 4 + hd) * SEQ;
    LAS char* lds = (LAS char*)C.lds; LAS float* Fr = (LAS float*)(lds + L_FR); volatile LAS int* flag = (volatile LAS int*)(lds + L_FLAG);
    const int tq = 256 * qb + 32 * w + r32;
    bf16x8 qf[4];
    { const bf16* qp = PROJ + (m0 + tq) * PW + C_FQ + hd * 64 + 8 * h;
#pragma unroll
      for (int d0 = 0; d0 < 4; ++d0) qf[d0] = *(const bf16x8*)(qp + 16 * d0); }
    const float f2q = F2[tq];
    const float sbound = ((const LAS float*)(lds + L_NST))[4];
    float lsum = 0.f; f32x16 o[2]; f32x16 cq;
#pragma unroll
    for (int r = 0; r < 16; ++r) { o[0][r] = 0.f; o[1][r] = 0.f; cq[r] = f2q; }
    const int j0 = 4 * qb, jd = j0 + (w >> 1);
#define FOX_LD(S_, F_, j_) do { stage_load(S_, Kg + (size_t)(j_) * 64 * PW, Vg + (size_t)(j_) * 64 * PW, PW, tid); if (tid < 64) F_ = *(const GAS float*)(F2 + (j_) * 64 + tid); } while (0)
#define FOX_ST(S_, F_, j_) do { stage_store(S_, lds + L_KR + ((j_) % RING) * KT, lds + L_VR + ((j_) % RING) * VT, tid); if (tid < 64) Fr[((j_) % RING) * 64 + tid] = F_; } while (0)
    Stg sA, sB; float fA = 0.f, fB = 0.f;
    { Stg s0, s1, s2, s3; float f0 = 0.f, f1 = 0.f, f2 = 0.f, f3 = 0.f; FOX_LD(s0, f0, j0 + 3); FOX_LD(s1, f1, j0 + 2); FOX_LD(s2, f2, j0 + 1); FOX_LD(s3, f3, j0);
      if (j0 - 1 >= 0) FOX_LD(sA, fA, j0 - 1);
      if (j0 - 2 >= 0) FOX_LD(sB, fB, j0 - 2);
      FOX_ST(s0, f0, j0 + 3); FOX_ST(s1, f1, j0 + 2); FOX_ST(s2, f2, j0 + 1); FOX_ST(s3, f3, j0); }
    if (tid < 16) flag[tid] = 0;
    LDS_BARRIER();
#define FOX_STEP(s_, DIAG_, SX_, FX_) { const int t_ = jd - (s_); bool done = true; \
        if (t_ >= 0) { LAS const char* kt_ = lds + L_KR + (t_ % RING) * KT; LAS const char* vt_ = lds + L_VR + (t_ % RING) * VT; const LAS float* ft_ = Fr + (t_ % RING) * 64; asm volatile("" : "+v"(kt_), "+v"(vt_), "+v"(ft_)); \
            fox_tile_s(kt_, vt_, ft_, qf, 64 * t_, DIAG_, tq, cq, lsum, o, lane); \
            if (t_ > 0) { const float fl = *(const GAS float*)(F2 + 64 * t_ - 1); done = __all(sbound + f2q - fl + 40.0f < lg2(lsum)); } } \
        if (lane == 0) flag[((s_) & 1) * 8 + w] = done ? 1 : 0; \
        if (j0 - (s_) - 1 >= 0) FOX_ST(SX_, FX_, j0 - (s_) - 1); \
        LDS_BARRIER(); \
        int alld = 1; _Pragma("unroll") for (int i = 0; i < 8; ++i) alld &= flag[((s_) & 1) * 8 + i]; \
        if (alld) break; \
        if (j0 - (s_) - 3 >= 0) FOX_LD(SX_, FX_, j0 - (s_) - 3); }
    for (int s = 0; ; s += 2) {
        if (s == 0) FOX_STEP(0, true, sA, fA) else FOX_STEP(s, false, sA, fA)
        FOX_STEP(s + 1, false, sB, fB)
    }
#undef FOX_LD
#undef FOX_ST
#undef FOX_STEP
    LDS_BARRIER();
    lsum = half_sum(lsum);
    { int tq2 = tq; asm volatile("" : "+v"(tq2)); store_o(WSP(bf16, WS_MIX) + (m0 + tq2) * 1024 + 256 + hd * 64, o, 1.0f / lsum, h); }
}

DI void fox_unit_safe(Ctx& C, int l, int b, int hd, int qb) {
    const int tid = C.tid, lane = C.lane, w = C.wave, r32 = lane & 31, h = lane >> 5;
    const bf16* PROJ = WSP(bf16, WS_PROJ); const size_t m0 = (size_t)b * SEQ;
    const bf16* Kg = PROJ + m0 * PW + C_FK + hd * 64; const bf16* Vg = PROJ + m0 * PW + C_FV + hd * 64;
    const float* F2 = WSP(float, WS_F2) + (size_t)(b * 4 + hd) * SEQ;
    LAS char* lds = (LAS char*)C.lds; LAS float* Ft = (LAS float*)(lds + L_F);
    const int tq = 256 * qb + 32 * w + r32;
    bf16x8 qf[4];
    { const bf16* qp = PROJ + (m0 + tq) * PW + C_FQ + hd * 64 + 8 * h;
#pragma unroll
      for (int d0 = 0; d0 < 4; ++d0) qf[d0] = *(const bf16x8*)(qp + 16 * d0); }
    const float f2q = F2[tq];
    float m_run = -1e30f, lsum = 0.f; f32x16 o[2];
#pragma unroll
    for (int r = 0; r < 16; ++r) { o[0][r] = 0.f; o[1][r] = 0.f; }
    const int jtop = 4 * qb + 3, jd = 4 * qb + (w >> 1);
    for (int j = jtop; j >= 0; --j) {
        Stg st; stage_load(st, Kg + (size_t)j * 64 * PW, Vg + (size_t)j * 64 * PW, PW, tid); float fv = 0.f; if (tid < 64) fv = F2[j * 64 + tid];
        stage_store(st, lds + L_K0, lds + L_V0, tid); if (tid < 64) Ft[tid] = fv;
        LDS_BARRIER();
        if (j <= jd) fox_tile(lds + L_K0, lds + L_V0, Ft, qf, 64 * j, j == jd, tq, f2q, m_run, lsum, o, lane);
        LDS_BARRIER();
    }
    lsum = half_sum(lsum);
    store_o(WSP(bf16, WS_MIX) + (m0 + tq) * 1024 + 256 + hd * 64, o, 1.0f / lsum, h);
}

constexpr float SB_CUT = -48.0f;
template <bool diag> DI void sb_tile(LAS const char* Kt, LAS const char* Vt, const bf16x8 (&qf)[4], int key0, int tq, float& R2, f32x16 (&o)[2], int lane) {
    const int h = lane >> 5;
    f32x16 p0, p1;
#pragma unroll
    for (int r = 0; r < 16; ++r) { p0[r] = 0.f; p1[r] = 0.f; }
    qkt(p0, p1, Kt, qf, lane);
    float sp[2][16], gs[8];
#pragma unroll
    for (int pi = 0; pi < 2; ++pi)
#pragma unroll
        for (int r = 0; r < 16; ++r) { const float z = pi ? p1[r] : p0[r]; float s = fmaxf(z, 0.f) + lg2(1.0f + ex2(-fabsf(z)));
            if (diag && (key0 + 32 * pi + crow(r, h) >= tq)) s = 0.f; sp[pi][r] = s; }
#pragma unroll
    for (int k = 0; k < 8; ++k) { const int pi = k >> 2, c4 = k & 3; gs[k] = (sp[pi][4 * c4] + sp[pi][4 * c4 + 1]) + (sp[pi][4 * c4 + 2] + sp[pi][4 * c4 + 3]); }
    float Tk[8]; float run = 0.f;
    float og[8];
#pragma unroll
    for (int k = 0; k < 8; ++k) og[k] = __shfl_xor(gs[k], 32);
#pragma unroll
    for (int k = 7; k >= 0; --k) { Tk[k] = run; run += gs[k] + og[k]; }
#pragma unroll
    for (int pi = 0; pi < 2; ++pi)
#pragma unroll
        for (int c4 = 0; c4 < 4; ++c4) { const int k = 4 * pi + c4; const float later = Tk[k] + (h == 0 ? og[k] : 0.f);
            const float s1 = sp[pi][4 * c4 + 1], s2 = sp[pi][4 * c4 + 2], s3 = sp[pi][4 * c4 + 3];
            const float e3 = later, e2 = later + s3, e1 = e2 + s2, e0 = e1 + s1;
            const float ee[4] = {e0, e1, e2, e3};
#pragma unroll
            for (int i = 0; i < 4; ++i) { const int r = 4 * c4 + i; const float z = pi ? p1[r] : p0[r]; const bool msk = diag && (key0 + 32 * pi + crow(r, h) >= tq);
                const float a = msk ? 0.f : ex2(z - sp[pi][r] + R2 - ee[i]); if (pi) p1[r] = a; else p0[r] = a; } }
    R2 -= run;
    pv(o, Vt, p0, p1, lane);
}
DI void sb_unit(Ctx& C, int b, int hd, int qb) {
    const int tid = C.tid, lane = C.lane, w = C.wave, r32 = lane & 31, h = lane >> 5;
    const bf16* PROJ = WSP(bf16, WS_PROJ); const size_t m0 = (size_t)b * SEQ;
    const bf16* Kg = PROJ + m0 * PW + C_SK + hd * 64; const bf16* Vg = PROJ + m0 * PW + C_SV + hd * 64;
    LAS char* lds = (LAS char*)C.lds; volatile LAS int* flag = (volatile LAS int*)(lds + L_FLAG);
    const int tq = 256 * qb + 32 * w + r32;
    bf16x8 qf[4];
    { const bf16* qp = PROJ + (m0 + tq) * PW + C_SQ + hd * 64 + 8 * h;
#pragma unroll
      for (int d0 = 0; d0 < 4; ++d0) qf[d0] = *(const bf16x8*)(qp + 16 * d0); }
    float R2 = 0.f; f32x16 o[2];
#pragma unroll
    for (int r = 0; r < 16; ++r) { o[0][r] = 0.f; o[1][r] = 0.f; }
    const int j0 = 4 * qb, jd = j0 + (w >> 1);
#define SB_LD(S_, j_) stage_load(S_, Kg + (size_t)(j_) * 64 * PW, Vg + (size_t)(j_) * 64 * PW, PW, tid)
#define SB_ST(S_, j_) stage_store(S_, lds + L_KR + ((j_) % RING) * KT, lds + L_VR + ((j_) % RING) * VT, tid)
    Stg sA, sB;
    { Stg s0, s1, s2, s3; SB_LD(s0, j0 + 3); SB_LD(s1, j0 + 2); SB_LD(s2, j0 + 1); SB_LD(s3, j0);
      if (j0 - 1 >= 0) SB_LD(sA, j0 - 1);
      if (j0 - 2 >= 0) SB_LD(sB, j0 - 2);
      SB_ST(s0, j0 + 3); SB_ST(s1, j0 + 2); SB_ST(s2, j0 + 1); SB_ST(s3, j0); }
    if (tid < 16) flag[tid] = 0;
    LDS_BARRIER();
#define SB_STEP(s_, DIAG_, SX_) { const int t_ = jd - (s_); bool done = true; \
        if (t_ >= 0) { done = __all(R2 < SB_CUT); if (!done) { LAS const char* kt_ = lds + L_KR + (t_ % RING) * KT; LAS const char* vt_ = lds + L_VR + (t_ % RING) * VT; asm volatile("" : "+v"(kt_), "+v"(vt_));   \
            sb_tile<DIAG_>(kt_, vt_, qf, 64 * t_, tq, R2, o, lane); done = __all(R2 < SB_CUT); } } \
        if (lane == 0) flag[((s_) & 1) * 8 + w] = done ? 1 : 0; \
        if (j0 - (s_) - 1 >= 0) SB_ST(SX_, j0 - (s_) - 1); \
        LDS_BARRIER(); \
        int alld = 1; _Pragma("unroll") for (int i = 0; i < 8; ++i) alld &= flag[((s_) & 1) * 8 + i]; \
        if (alld) break; \
        if (j0 - (s_) - 3 >= 0) SB_LD(SX_, j0 - (s_) - 3); }
    for (int s = 0; ; s += 2) {
        if (s == 0) SB_STEP(0, true, sA) else SB_STEP(s, false, sA)
        SB_STEP(s + 1, false, sB)
    }
#undef SB_LD
#undef SB_ST
#undef SB_STEP
    LDS_BARRIER();
    { int tq2 = tq; asm volatile("" : "+v"(tq2));
      store_o(WSP(bf16, WS_MIX) + (m0 + tq2) * 1024 + 512 + hd * 64, o, 1.0f, h); }
}
}

namespace att {
template <int MODE> DI void nsa_tile(LAS const char* Kt, LAS const char* Vt, const bf16x8 (&qf)[4], int j, int t, int c, bool active, const LAS float* el, float bfar, float& m_run, float& lsum, f32x16 (&o)[2], int lane, int dry) {
    const int h = lane >> 5;
    f32x16 p0, p1;
#pragma unroll
    for (int r = 0; r < 16; ++r) { p0[r] = 0.f; p1[r] = 0.f; }
    qkt(p0, p1, Kt, qf, lane);
    if (j >= c - 2) {
        const int bd = t - 64 * j - 4 * h; const LAS float* eb = el + (255 - bd); const int bde = active ? bd : -1;
        float bv0[16], bv1[16];
#pragma unroll
        for (int r = 0; r < 16; ++r) { bv0[r] = eb[8 * (r >> 2) + (r & 3)]; bv1[r] = eb[32 + 8 * (r >> 2) + (r & 3)]; }
#pragma unroll
        for (int r = 0; r < 16; ++r) { asm volatile("" : "+v"(bv0[r])); asm volatile("" : "+v"(bv1[r])); }
#pragma unroll
        for (int r = 0; r < 16; ++r) { const int kc = 8 * (r >> 2) + (r & 3);
            p0[r] = (kc <= bde) ? p0[r] + bv0[r] : -1e30f; p1[r] = (kc + 32 <= bde) ? p1[r] + bv1[r] : -1e30f; }
        osm<true>(p0, p1, m_run, lsum, o);
    } else if (MODE == 1 && j == c - 8) {
        const int bd = t - 64 * j - 4 * h - 512;
#pragma unroll
        for (int pi = 0; pi < 2; ++pi)
#pragma unroll
            for (int r = 0; r < 16; ++r) { const int kc = 32 * pi + 8 * (r >> 2) + (r & 3); const bool valid = kc > bd;
                const float s = valid ? (pi ? p1[r] : p0[r]) + bfar : -1e30f; if (pi) p1[r] = s; else p0[r] = s; }
        osm<true>(p0, p1, m_run, lsum, o);
    } else {
        if (!(dry & 16)) osm_fast(p0, p1, bfar, active, m_run, lsum, o);
    }
    if (!(dry & 8)) pv(o, Vt, p0, p1, lane);
}
template <int MODE> DI void nsa_branch(Ctx& C, const bf16* Kg, const bf16* Vg, int j_lo, int j_hi, const bf16* qp, int t, int c, unsigned sel_lo, unsigned sel_hi,
                                       const LAS float* bl, float gate, LAS float* RES, bf16* orow, int dry) {
    const int tid = C.tid, lane = C.lane, h = lane >> 5; LAS char* lds = (LAS char*)C.lds;
    bf16x8 qf[4];
    asm volatile("" : "+v"(qp));
#pragma unroll
    for (int d0 = 0; d0 < 4; ++d0) qf[d0] = *(const bf16x8*)(qp + 16 * d0);
    float m_run = -1e30f, lsum = 0.f; f32x16 o[2];
#pragma unroll
    for (int r = 0; r < 16; ++r) { o[0][r] = 0.f; o[1][r] = 0.f; }
    const float bfar = bl[128]; const LAS float* el = (const LAS float*)(lds + L_EL) + (bl - (const LAS float*)(lds + L_BL2)) / 132 * 320;
    Stg sA, sB;
#define NB_LD(S_, j_) stage_load(S_, Kg + (size_t)(j_) * 64 * PW, Vg + (size_t)(j_) * 64 * PW, PW, tid)
#define NB_ST(S_, buf_) stage_store(S_, lds + L_K0 + (buf_) * KT, lds + L_V0 + (buf_) * VT, tid)
#define NB_ACT(j_) ((MODE == 1) ? true : ((((j_) < 32 ? (sel_lo >> (j_)) : (sel_hi >> ((j_) - 32))) & 1u) != 0u))
    NB_LD(sA, j_lo); NB_ST(sA, 0); if (j_lo + 1 <= j_hi) NB_LD(sB, j_lo + 1);
    LDS_BARRIER();
    for (int j = j_lo; j <= j_hi; j += 2) {
        if (j + 2 <= j_hi && !(dry & 32)) NB_LD(sA, j + 2);
        { const bool act = NB_ACT(j); if (__any(act) && !(dry & 64)) nsa_tile<MODE>(lds + L_K0, lds + L_V0, qf, j, t, c, act, el, bfar, m_run, lsum, o, lane, dry); }
        if (j + 1 <= j_hi && !(dry & 32)) NB_ST(sB, 1);
        LDS_BARRIER();
        if (j + 1 > j_hi) break;
        if (j + 3 <= j_hi && !(dry & 32)) NB_LD(sB, j + 3);
        { const bool act = NB_ACT(j + 1); if (__any(act) && !(dry & 64)) nsa_tile<MODE>(lds + L_K0 + KT, lds + L_V0 + VT, qf, j + 1, t, c, act, el, bfar, m_run, lsum, o, lane, dry); }
        if (j + 2 <= j_hi && !(dry & 32)) NB_ST(sA, 0);
        LDS_BARRIER();
    }
#undef NB_LD
#undef NB_ST
#undef NB_ACT
    lsum = half_sum(lsum); const float sc = lsum > 0.f ? gate / lsum : 0.f;
#pragma unroll
    for (int dh = 0; dh < 2; ++dh)
#pragma unroll
        for (int r = 0; r < 16; ++r) { const float v = RES[(dh * 16 + r) * 64 + lane] + o[dh][r] * sc; if (MODE == 1) o[dh][r] = v; else RES[(dh * 16 + r) * 64 + lane] = v; }
    if (MODE == 1 && orow) store_o(orow, o, 1.0f, h);
}
DI void nsa_selwin(Ctx& C, const bf16* Ks, const bf16* Vs, const bf16* Kw, const bf16* Vw, const bf16* qp, int t, int c, unsigned sel_lo, unsigned sel_hi,
                   const LAS float* bl, float g_sel, float g_win, LAS float* RES, bf16* orow, int dry) {
    const int tid = C.tid, lane = C.lane, h = lane >> 5; LAS char* lds = (LAS char*)C.lds;
    bf16x8 qf[4];
    asm volatile("" : "+v"(qp));
#pragma unroll
    for (int d0 = 0; d0 < 4; ++d0) qf[d0] = *(const bf16x8*)(qp + 16 * d0);
    float m_run = -1e30f, lsum = 0.f; f32x16 o[2];
#pragma unroll
    for (int r = 0; r < 16; ++r) { o[0][r] = 0.f; o[1][r] = 0.f; }
    const float bfar = bl[128]; const LAS float* el = (const LAS float*)(lds + L_EL) + (bl - (const LAS float*)(lds + L_BL2)) / 132 * 320;
    const int nsel = c + 1, jw0 = c >= 8 ? c - 8 : 0, ntot = nsel + (c - jw0 + 1);
    Stg sA, sB;
#define SW_J(v_) ((v_) < nsel ? (v_) : jw0 + ((v_) - nsel))
#define SW_LD(S_, v_) do { const int j_ = SW_J(v_); if ((v_) < nsel) stage_load(S_, Ks + (size_t)j_ * 64 * PW, Vs + (size_t)j_ * 64 * PW, PW, tid); else stage_load(S_, Kw + (size_t)j_ * 64 * PW, Vw + (size_t)j_ * 64 * PW, PW, tid); } while (0)
#define SW_ST(S_, buf_) stage_store(S_, lds + L_K0 + (buf_) * KT, lds + L_V0 + (buf_) * VT, tid)
#define SW_CLOSE() do { lsum = half_sum(lsum); const float sc_ = lsum > 0.f ? g_sel / lsum : 0.f; \
        _Pragma("unroll") for (int dh = 0; dh < 2; ++dh) _Pragma("unroll") for (int r = 0; r < 16; ++r) { RES[(dh * 16 + r) * 64 + lane] += o[dh][r] * sc_; o[dh][r] = 0.f; } \
        m_run = -1e30f; lsum = 0.f; } while (0)
#define SW_TILE(v_, buf_) do { const int j_ = SW_J(v_); \
        if ((v_) == nsel) SW_CLOSE(); \
        if ((v_) < nsel) { const bool act = (((j_ < 32 ? (sel_lo >> j_) : (sel_hi >> (j_ - 32))) & 1u) != 0u); if (__any(act)) nsa_tile<0>(lds + L_K0 + (buf_) * KT, lds + L_V0 + (buf_) * VT, qf, j_, t, c, act, el, bfar, m_run, lsum, o, lane, dry); } \
        else nsa_tile<1>(lds + L_K0 + (buf_) * KT, lds + L_V0 + (buf_) * VT, qf, j_, t, c, true, el, bfar, m_run, lsum, o, lane, dry); } while (0)
    SW_LD(sA, 0); SW_ST(sA, 0); SW_LD(sB, 1);
    LDS_BARRIER();
    for (int v = 0; v < ntot; v += 2) {
        if (v + 2 < ntot) SW_LD(sA, v + 2);
        SW_TILE(v, 0);
        if (v + 1 < ntot) SW_ST(sB, 1);
        LDS_BARRIER();
        if (v + 1 >= ntot) break;
        if (v + 3 < ntot) SW_LD(sB, v + 3);
        SW_TILE(v + 1, 1);
        if (v + 2 < ntot) SW_ST(sA, 0);
        LDS_BARRIER();
    }
#undef SW_J
#undef SW_LD
#undef SW_ST
#undef SW_CLOSE
#undef SW_TILE
    lsum = half_sum(lsum); const float sc = lsum > 0.f ? g_win / lsum : 0.f;
#pragma unroll
    for (int dh = 0; dh < 2; ++dh)
#pragma unroll
        for (int r = 0; r < 16; ++r) o[dh][r] = RES[(dh * 16 + r) * 64 + lane] + o[dh][r] * sc;
    if (orow) store_o(orow, o, 1.0f, h);
}
template <int MODE> DI void nsa_tile_s(LAS const char* Kt, LAS const char* Vt, const bf16x8 (&qf)[4], int j, int t, int c, bool active, const LAS float* el, float& lsum, f32x16 (&o)[2], int lane, int dry) {
    const int h = lane >> 5;
    f32x16 p0, p1;
#pragma unroll
    for (int r = 0; r < 16; ++r) { p0[r] = 0.f; p1[r] = 0.f; }
    LAS const char* kb = Kt + (lane & 31) * KP + h * 16;
    const int i16 = lane & 15, q4 = i16 >> 2, pp = i16 & 3, blk = (lane >> 4) & 1;
    LAS const char* vb = Vt + (4 * h + q4) * VP + (16 * blk + 4 * pp) * 2;
    bf16x8 ka[4], kc2[4]; s16x4 lo[8], hi[8];
#pragma unroll
    for (int d0 = 0; d0 < 4; ++d0) { if (dry & 64) { ka[d0] = qf[d0]; kc2[d0] = qf[d0]; } else { ka[d0] = *(LAS const bf16x8*)(kb + d0 * 32); kc2[d0] = *(LAS const bf16x8*)(kb + 32 * KP + d0 * 32); } }
#pragma unroll
    for (int i = 0; i < 4; ++i) { const int s = i >> 1, dh = i & 1; if (dry & 128) { lo[i] = s16x4{0,0,0,0}; hi[i] = lo[i]; } else { lo[i] = trr(vb + (16 * s) * VP + dh * 64); hi[i] = trr(vb + (16 * s + 8) * VP + dh * 64); } }
    __builtin_amdgcn_sched_barrier(0);
    if (!(dry & 8)) {
#pragma unroll
        for (int d0 = 0; d0 < 4; ++d0) { p0 = MFMA32(ka[d0], qf[d0], p0); p1 = MFMA32(kc2[d0], qf[d0], p1); } }
#pragma unroll
    for (int i = 4; i < 8; ++i) { const int s = i >> 1, dh = i & 1; if (dry & 128) { lo[i] = s16x4{0,0,0,0}; hi[i] = lo[i]; } else { lo[i] = trr(vb + (16 * s) * VP + dh * 64); hi[i] = trr(vb + (16 * s + 8) * VP + dh * 64); } }
    __builtin_amdgcn_sched_barrier(0);
    bf16x8 pb[4];
    float ps0 = 0.f, ps1 = 0.f;
    if (j >= c - 2 && !(dry & 256)) {
        const int bd = t - 64 * j - 4 * h; const LAS float* eb = el + (255 - bd); const int bde = active ? bd : -1;
        float bv0[16], bv1[16];
#pragma unroll
        for (int r = 0; r < 16; ++r) { bv0[r] = eb[8 * (r >> 2) + (r & 3)]; bv1[r] = eb[32 + 8 * (r >> 2) + (r & 3)]; }
#pragma unroll
        for (int r = 0; r < 16; ++r) { asm volatile("" : "+v"(bv0[r])); asm volatile("" : "+v"(bv1[r])); }
#pragma unroll
        for (int r = 0; r < 16; ++r) { const int kc = 8 * (r >> 2) + (r & 3);
            const float a = ex2((kc <= bde) ? p0[r] + bv0[r] : -1e30f), b = ex2((kc + 32 <= bde) ? p1[r] + bv1[r] : -1e30f); p0[r] = a; p1[r] = b; ps0 += a; ps1 += b; }
        pack_p(pb, p0, p1);
    } else if (MODE == 1 && j == c - 8 && !(dry & 256)) {
        const int bd = t - 64 * j - 4 * h - 512;
#pragma unroll
        for (int r = 0; r < 16; ++r) { const int kc = 8 * (r >> 2) + (r & 3);
            const float a = ex2((kc > bd) ? p0[r] : -1e30f), b = ex2((kc + 32 > bd) ? p1[r] : -1e30f); p0[r] = a; p1[r] = b; ps0 += a; ps1 += b; }
        pack_p(pb, p0, p1);
    } else {
        if (!(dry & 2)) {
#pragma unroll
        for (int r = 0; r < 16; ++r) { const float a = ex2(p0[r]), b = ex2(p1[r]); p0[r] = a; p1[r] = b; ps0 += a; ps1 += b; } }
        if (dry & 512) { pb[0] = qf[0]; pb[1] = qf[1]; pb[2] = qf[2]; pb[3] = qf[3]; } else pack_p(pb, p0, p1);
        if (MODE == 0 && !(dry & 512)) {
#pragma unroll
            for (int i = 0; i < 4; ++i) { v4u w = __builtin_bit_cast(v4u, pb[i]); w.x = active ? w.x : 0u; w.y = active ? w.y : 0u; w.z = active ? w.z : 0u; w.w = active ? w.w : 0u; pb[i] = __builtin_bit_cast(bf16x8, w); }
            ps0 = active ? ps0 : 0.f; ps1 = active ? ps1 : 0.f;
        }
    }
    lsum += ps0 + ps1;
    __builtin_amdgcn_sched_barrier(0);
    if (!(dry & 4)) {
#pragma unroll
        for (int i = 0; i < 8; ++i) { const int s = i >> 1, dh = i & 1; o[dh] = MFMA32(__builtin_shufflevector(lo[i], hi[i], 0, 1, 2, 3, 4, 5, 6, 7), pb[s], o[dh]); } }
}
DI void nsa_selwin_s(Ctx& C, const bf16* Ks, const bf16* Vs, const bf16* Kw, const bf16* Vw, const bf16* qp, int t, int c, unsigned sel_lo, unsigned sel_hi,
                     const LAS float* bl, float g_sel, float g_win, LAS float* RES, bf16* orow, int dry) {
    const int tid = C.tid, lane = C.lane, h = lane >> 5; LAS char* lds = (LAS char*)C.lds;
    bf16x8 qf[4];
    asm volatile("" : "+v"(qp));
#pragma unroll
    for (int d0 = 0; d0 < 4; ++d0) qf[d0] = *(const bf16x8*)(qp + 16 * d0);
    float lsum = 0.f; f32x16 o[2];
#pragma unroll
    for (int r = 0; r < 16; ++r) { o[0][r] = 0.f; o[1][r] = 0.f; }
    const float fbf = ex2(bl[128]); const LAS float* el = (const LAS float*)(lds + L_EL) + (bl - (const LAS float*)(lds + L_BL2)) / 132 * 320;
    const int nsel = c + 1, jw0 = c >= 8 ? c - 8 : 0, ntot = nsel + (c - jw0 + 1);
    Stg sA, sB;
#define SW_J(v_) ((v_) < nsel ? (v_) : jw0 + ((v_) - nsel))
#define SW_LD(S_, v_) do { const int j_ = SW_J(v_); if ((v_) < nsel) stage_load(S_, Ks + (size_t)j_ * 64 * PW, Vs + (size_t)j_ * 64 * PW, PW, tid); else stage_load(S_, Kw + (size_t)j_ * 64 * PW, Vw + (size_t)j_ * 64 * PW, PW, tid); } while (0)
#define SW_ST(S_, buf_) stage_store(S_, lds + L_K0 + (buf_) * KT, lds + L_V0 + (buf_) * VT, tid)
#define SW_CLOSE() do { lsum = half_sum(lsum); const float sc_ = lsum > 0.f ? g_sel / lsum : 0.f; \
        _Pragma("unroll") for (int dh = 0; dh < 2; ++dh) _Pragma("unroll") for (int r = 0; r < 16; ++r) { RES[(dh * 16 + r) * 64 + lane] += o[dh][r] * sc_; o[dh][r] = 0.f; } \
        lsum = 0.f; } while (0)
#define SW_TILE(v_, buf_) do { const int j_ = SW_J(v_); \
        if ((v_) == nsel) SW_CLOSE(); \
        if (j_ == c - 2) { lsum *= fbf; _Pragma("unroll") for (int r = 0; r < 16; ++r) { o[0][r] *= fbf; o[1][r] *= fbf; } } \
        if ((v_) < nsel) { const bool act = (((j_ < 32 ? (sel_lo >> j_) : (sel_hi >> (j_ - 32))) & 1u) != 0u); if (!(dry & 16)) nsa_tile_s<0>(lds + L_K0 + (buf_) * KT, lds + L_V0 + (buf_) * VT, qf, j_, t, c, act, el, lsum, o, lane, dry); } \
        else if (!(dry & 16)) nsa_tile_s<1>(lds + L_K0 + (buf_) * KT, lds + L_V0 + (buf_) * VT, qf, j_, t, c, true, el, lsum, o, lane, dry); } while (0)
    SW_LD(sA, 0); SW_ST(sA, 0); SW_LD(sB, 1);
    LDS_BARRIER();
    for (int v = 0; v < ntot; v += 2) {
        if (v + 2 < ntot && !(dry & 32)) SW_LD(sA, v + 2);
        SW_TILE(v, 0);
        if (v + 1 < ntot && !(dry & 32)) SW_ST(sB, 1);
        LDS_BARRIER();
        if (v + 1 >= ntot) break;
        if (v + 3 < ntot && !(dry & 32)) SW_LD(sB, v + 3);
        SW_TILE(v + 1, 1);
        if (v + 2 < ntot && !(dry & 32)) SW_ST(sA, 0);
        LDS_BARRIER();
    }
#undef SW_J
#undef SW_LD
#undef SW_ST
#undef SW_CLOSE
#undef SW_TILE
    lsum = half_sum(lsum); const float sc = lsum > 0.f ? g_win / lsum : 0.f;
#pragma unroll
    for (int dh = 0; dh < 2; ++dh)
#pragma unroll
        for (int r = 0; r < 16; ++r) o[dh][r] = RES[(dh * 16 + r) * 64 + lane] + o[dh][r] * sc;
    if (orow) store_o(orow, o, 1.0f, h);
}
DI void nsa_unit(Ctx& C, int b, int c, int dry) {
    const int tid = C.tid, lane = C.lane, w = C.wave, r32 = lane & 31, h = lane >> 5, hd = w & 3, th = w >> 2;
    const bf16* PROJ = WSP(bf16, WS_PROJ); const size_t m0 = (size_t)b * SEQ;
    LAS char* lds = (LAS char*)C.lds; LAS float* BLl = (LAS float*)(lds + L_BL2); LAS float* IMP = (LAS float*)(lds + L_IMP); LAS float* TOT = (LAS float*)(lds + L_TOT); LAS unsigned* SEL = (LAS unsigned*)(lds + L_SEL);
    const int tl = 32 * th + r32, t = 64 * c + tl;
    bf16x8 qf[4];
    { const bf16* qp = PROJ + (m0 + t) * PW + C_NQ + hd * 64 + 8 * h;
#pragma unroll
      for (int d0 = 0; d0 < 4; ++d0) qf[d0] = *(const bf16x8*)(qp + 16 * d0); }
    const float g0 = WSP(float, WS_NG)[(m0 + t) * 16 + hd * 3];
    const LAS float* bl = BLl + hd * 132;
    f32x16 res[2];
#pragma unroll
    for (int r = 0; r < 16; ++r) { res[0][r] = 0.f; res[1][r] = 0.f; }
    LAS float* MREF = (LAS float*)(lds);
    LAS float* MFIN = (LAS float*)(lds + 4096);
    if (!(dry & 1)) {
        const bf16* Kc = WSP(bf16, WS_KCMP) + (size_t)b * 256 * 64; const bf16* Vc = WSP(bf16, WS_VCMP) + (size_t)b * 256 * 64;
        const int ntc = (4 * c + 2) / 64 + 1, nlim = (t >= 31) ? ((t - 31) >> 4) : -1;
        float m_run = -1e30f, lsum = 0.f, carry = 0.f, mref0 = 0.f, mref1 = 0.f, mref2 = 0.f, mref3 = 0.f; f32x16 o[2];
#pragma unroll
        for (int r = 0; r < 16; ++r) { o[0][r] = 0.f; o[1][r] = 0.f; }
        const float bfar_c = bl[128];
        Stg st; stage_load(st, Kc, Vc, 64, tid); stage_store(st, lds + L_K0, lds + L_V0, tid);
        LDS_BARRIER();
        for (int nt = 0; nt < ntc; ++nt) {
            const int cur = nt & 1;
            if (nt + 1 < ntc) stage_load(st, Kc + (size_t)(nt + 1) * 64 * 64, Vc + (size_t)(nt + 1) * 64 * 64, 64, tid);
            f32x16 p0, p1;
#pragma unroll
            for (int r = 0; r < 16; ++r) { p0[r] = 0.f; p1[r] = 0.f; }
            qkt(p0, p1, lds + L_K0 + cur * KT, qf, lane);
            float tm = -1e30f;
            const bool allfar = c >= 16 * nt + 19;
            if (allfar) {
                float t0 = fmaxf(p0[0], p1[0]), t1 = fmaxf(p0[1], p1[1]);
#pragma unroll
                for (int r = 2; r < 16; r += 2) { t0 = fmaxf(t0, fmaxf(p0[r], p1[r])); t1 = fmaxf(t1, fmaxf(p0[r + 1], p1[r + 1])); }
                tm = fmaxf(t0, t1) + bfar_c;
            } else {
#pragma unroll
            for (int pi = 0; pi < 2; ++pi)
#pragma unroll
                for (int r = 0; r < 16; ++r) { const int n = 64 * nt + 32 * pi + crow(r, h), dist = t - 16 * n - 31; const bool valid = n <= nlim;
                    const int idx = dist < 0 ? 0 : (dist > 128 ? 128 : dist);
                    float bvv = bl[idx]; asm volatile("" : "+v"(bvv));
                    const float s = valid ? (pi ? p1[r] : p0[r]) + bvv : -1e30f; if (pi) p1[r] = s; else p0[r] = s; tm = fmaxf(tm, s); if ((r & 7) == 7) __builtin_amdgcn_sched_barrier(0); }
            }
            tm = half_max(tm); const float mn = fmaxf(m_run, tm), f = ex2(m_run - mn);
            m_run = mn; lsum *= f; carry *= f;
#pragma unroll
            for (int r = 0; r < 16; ++r) { o[0][r] *= f; o[1][r] *= f; }
            float ps = 0.f;
            if (allfar) { const float e = mn - bfar_c;
#pragma unroll
                for (int r = 0; r < 16; ++r) { p0[r] = ex2(p0[r] - e); p1[r] = ex2(p1[r] - e); ps += p0[r] + p1[r]; }
            } else {
#pragma unroll
            for (int r = 0; r < 16; ++r) { p0[r] = p0[r] > -1e29f ? ex2(p0[r] - mn) : 0.f; p1[r] = p1[r] > -1e29f ? ex2(p1[r] - mn) : 0.f; ps += p0[r] + p1[r]; }
            }
            lsum += ps;
            if (nt == 0) mref0 = mn; else if (nt == 1) mref1 = mn; else if (nt == 2) mref2 = mn; else mref3 = mn;
            float A[8], Bp[8], ob[8];
#pragma unroll
            for (int k = 0; k < 8; ++k) { const int pi = k >> 2, c4 = k & 3; const float x0 = pi ? p1[4 * c4] : p0[4 * c4], x1 = pi ? p1[4 * c4 + 1] : p0[4 * c4 + 1], x2 = pi ? p1[4 * c4 + 2] : p0[4 * c4 + 2], x3 = pi ? p1[4 * c4 + 3] : p0[4 * c4 + 3];
                Bp[k] = 0.5f * x3; A[k] = (x0 + x1) + (x2 + Bp[k]); }
#pragma unroll
            for (int k = 0; k < 8; ++k) ob[k] = __shfl_xor(Bp[k], 32);
            LAS float* ip = IMP + (hd * 64 + tl) * 64 + 16 * nt + h;
#pragma unroll
            for (int k = 0; k < 8; ++k) { const float add = (h == 1) ? ob[k] : (k == 0 ? carry : ob[k > 0 ? k - 1 : 0]); ip[2 * k] = A[k] + add; }
            carry = ob[7];
            pv(o, lds + L_V0 + cur * VT, p0, p1, lane);
            if (nt + 1 < ntc) stage_store(st, lds + L_K0 + (cur ^ 1) * KT, lds + L_V0 + (cur ^ 1) * VT, tid);
            LDS_BARRIER();
        }
        lsum = half_sum(lsum); const float inv = lsum > 0.f ? 1.0f / lsum : 0.f;
        if (h == 0) { LAS float* mr = MREF + (hd * 64 + tl) * 4; mr[0] = mref0; mr[1] = mref1; mr[2] = mref2; mr[3] = mref3; MFIN[(hd * 64 + tl) * 2] = m_run; MFIN[(hd * 64 + tl) * 2 + 1] = inv; }
#pragma unroll
        for (int r = 0; r < 16; ++r) { res[0][r] += o[0][r] * (g0 * inv); res[1][r] += o[1][r] * (g0 * inv); }
        LDS_BARRIER();
    }
    if (dry & 1) { if (tid < 128) SEL[tid] = 0xffffffffu; LDS_BARRIER(); } else {
        const int tok = tid >> 3, sub = tid & 7;
        float wsc[4][4];
#pragma unroll
        for (int hh = 0; hh < 4; ++hh) { const float mf = MFIN[(hh * 64 + tok) * 2], il = MFIN[(hh * 64 + tok) * 2 + 1];
#pragma unroll
            for (int q = 0; q < 4; ++q) wsc[hh][q] = ex2(MREF[(hh * 64 + tok) * 4 + q] - mf) * il; }
#pragma unroll
        for (int i = 0; i < 8; ++i) { const int j = sub * 8 + i; float sc;
            if (j == 0 || j == c || j == c - 1) sc = 1e30f * (1.0f - (float)j * 1e-6f); else if (j <= c) sc = ((IMP[(0 * 64 + tok) * 64 + j] * wsc[0][j >> 4] + IMP[(1 * 64 + tok) * 64 + j] * wsc[1][j >> 4]) + IMP[(2 * 64 + tok) * 64 + j] * wsc[2][j >> 4]) + IMP[(3 * 64 + tok) * 64 + j] * wsc[3][j >> 4]; else sc = -1e30f * (1.0f + (float)j * 1e-6f);
            TOT[tok * 64 + j] = sc; }
        LDS_BARRIER();
        float sj[8]; int rk[8];
        { const f32x4 a = *(const LAS f32x4*)(TOT + tok * 64 + sub * 8), b4 = *(const LAS f32x4*)(TOT + tok * 64 + sub * 8 + 4); sj[0] = a.x; sj[1] = a.y; sj[2] = a.z; sj[3] = a.w; sj[4] = b4.x; sj[5] = b4.y; sj[6] = b4.z; sj[7] = b4.w; }
#pragma unroll
        for (int i = 0; i < 8; ++i) rk[i] = 0;
#pragma unroll
        for (int k4 = 0; k4 < 16; ++k4) { const f32x4 v = *(const LAS f32x4*)(TOT + tok * 64 + 4 * k4);
#pragma unroll
            for (int i = 0; i < 8; ++i) rk[i] += (v.x > sj[i] ? 1 : 0) + (v.y > sj[i] ? 1 : 0) + (v.z > sj[i] ? 1 : 0) + (v.w > sj[i] ? 1 : 0); }
        unsigned mlo = 0u, mhi = 0u;
#pragma unroll
        for (int i = 0; i < 8; ++i) { const int j = sub * 8 + i; if (rk[i] < 16) { if (j < 32) mlo |= 1u << j; else mhi |= 1u << (j - 32); } }
        mlo |= __shfl_xor(mlo, 1); mlo |= __shfl_xor(mlo, 2); mlo |= __shfl_xor(mlo, 4);
        mhi |= __shfl_xor(mhi, 1); mhi |= __shfl_xor(mhi, 2); mhi |= __shfl_xor(mhi, 4);
        if (sub == 0) { SEL[tok * 2] = mlo; SEL[tok * 2 + 1] = mhi; }
        LDS_BARRIER();
    }
    const unsigned sel_lo = SEL[tl * 2], sel_hi = SEL[tl * 2 + 1];
    LAS float* RES = IMP + w * 2048;
#pragma unroll
    for (int dh = 0; dh < 2; ++dh)
#pragma unroll
        for (int r = 0; r < 16; ++r) RES[(dh * 16 + r) * 64 + lane] = res[dh][r];
    const bf16* qp2 = PROJ + (m0 + t) * PW + C_NQ + hd * 64 + 8 * h;
    const float* ng2 = WSP(float, WS_NG) + (m0 + t) * 16 + hd * 3;
    {
        const bool stat = NSA_STATIC && __builtin_amdgcn_readfirstlane((int)(((const LAS float*)(lds + L_NST))[hd] <= 100.0f));
        bf16* orow = dry ? (bf16*)nullptr : WSP(bf16, WS_MIX) + (m0 + t) * 1024 + 768 + hd * 64;
        if (stat) nsa_selwin_s(C, PROJ + m0 * PW + C_KS, PROJ + m0 * PW + C_VS, PROJ + m0 * PW + C_KW, PROJ + m0 * PW + C_VW, qp2, t, c, sel_lo, sel_hi, bl, ng2[1], ng2[2], RES, orow, dry);
        else nsa_selwin(C, PROJ + m0 * PW + C_KS, PROJ + m0 * PW + C_VS, PROJ + m0 * PW + C_KW, PROJ + m0 * PW + C_VW, qp2, t, c, sel_lo, sel_hi, bl, ng2[1], ng2[2], RES, orow, 0);
    }
    LDS_BARRIER();
}
}

DI void mlstm_out_unit(Ctx& C, int l, int b, int c) {
    using namespace att;
    const int tid = C.tid, lane = C.lane, w = C.wave, r32 = lane & 31, h = lane >> 5, hd = w & 3, lh = w >> 2;
    const bf16* PROJ = WSP(bf16, WS_PROJ); const bf16* QKC = WSP(bf16, WS_QKC);
    const int t0 = 64 * c; const size_t m0 = (size_t)b * SEQ + t0; const int bh = b * 4 + hd;
    LAS char* lds = (LAS char*)C.lds; LAS char* Kt = lds; LAS char* Vt = lds + 4 * KT; LAS char* Ct = lds + 4 * KT + 4 * VT;
    LAS float* vb = (LAS float*)(lds + 122880); LAS float* vi = (LAS float*)(lds + 123904); LAS float* vn = (LAS float*)(lds + 124928);
    { const int row = tid >> 3, ch = tid & 7;
#pragma unroll
      for (int hh = 0; hh < 4; ++hh) {
          *(LAS v4u*)(Kt + hh * KT + row * KP + ch * 16) = *(const v4u*)(QKC + (m0 + row) * 512 + 256 + hh * 64 + ch * 8);
          *(LAS v4u*)(Vt + hh * VT + row * VP + ch * 16) = *(const v4u*)(PROJ + (m0 + row) * PW + C_MV + hh * 64 + ch * 8);
          const float* cp = WSP(float, WS_STATE) + ((size_t)(b * 4 + hh) * 64 + c) * 4096 + row * 64 + ch * 8; const f32x4 c0 = *(const f32x4*)cp, c1 = *(const f32x4*)(cp + 4);
          v4u pc; pc.x = pk2(c0.x, c0.y); pc.y = pk2(c0.z, c0.w); pc.z = pk2(c1.x, c1.y); pc.w = pk2(c1.z, c1.w);
          *(LAS v4u*)(Ct + hh * KT + row * KP + ch * 16) = pc; }
      if (tid < 256) { const int hh = tid >> 6, i = tid & 63, bh2 = b * 4 + hh; vb[tid] = WSP(float, WS_GB)[(size_t)bh2 * SEQ + t0 + i]; vi[tid] = WSP(float, WS_GI)[(size_t)bh2 * SEQ + t0 + i]; vn[tid] = WSP(float, WS_NCH)[((size_t)bh2 * 64 + c) * 64 + i]; } }
    const int lq = 32 * lh + r32; const size_t m = m0 + lq;
    bf16x8 qf[4];
    { const bf16* qp = QKC + m * 512 + hd * 64 + 8 * h;
#pragma unroll
      for (int d0 = 0; d0 < 4; ++d0) qf[d0] = *(const bf16x8*)(qp + 16 * d0); }
    const float mprev = WSP(float, WS_MPREV)[bh * 64 + c];
    LDS_BARRIER();
    const float b_l = vb[hd * 64 + lq];
    f32x16 p0, p1;
#pragma unroll
    for (int r = 0; r < 16; ++r) { p0[r] = 0.f; p1[r] = 0.f; }
    qkt(p0, p1, Kt + hd * KT, qf, lane);
    float dl0[16], dl1[16]; float dmax = -1e30f;
#pragma unroll
    for (int g = 0; g < 4; ++g) { const f32x4 ba = *(const LAS f32x4*)(vb + hd * 64 + 8 * g + 4 * h), bb = *(const LAS f32x4*)(vb + hd * 64 + 32 + 8 * g + 4 * h), ia = *(const LAS f32x4*)(vi + hd * 64 + 8 * g + 4 * h), ib = *(const LAS f32x4*)(vi + hd * 64 + 32 + 8 * g + 4 * h);
#pragma unroll
        for (int i = 0; i < 4; ++i) { const int r = 4 * g + i, s = 8 * g + 4 * h + i; const float da = (s <= lq) ? b_l - ba[i] + ia[i] : -1e30f, db = (s + 32 <= lq) ? b_l - bb[i] + ib[i] : -1e30f; dl0[r] = da; dl1[r] = db; dmax = fmaxf(dmax, fmaxf(da, db)); } }
    dmax = half_max(dmax);
    const float m_inter = b_l + mprev, m_t = fmaxf(dmax, m_inter), inter_w = ex2((m_inter - m_t) * LOG2E);
    float dsum = 0.f;
#pragma unroll
    for (int r = 0; r < 16; ++r) { const float wa = dl0[r] > -1e29f ? ex2((dl0[r] - m_t) * LOG2E) : 0.f, wb = dl1[r] > -1e29f ? ex2((dl1[r] - m_t) * LOG2E) : 0.f; p0[r] *= wa; p1[r] *= wb; dsum += p0[r] + p1[r]; }
    dsum = half_sum(dsum);
    float nq = 0.f;
#pragma unroll
    for (int d0 = 0; d0 < 4; ++d0)
#pragma unroll
        for (int j = 0; j < 8; ++j) nq += bf2f((bf16)qf[d0][j]) * vn[hd * 64 + 16 * d0 + 8 * h + j];
    nq = half_sum(nq);
    const float den = dsum + inter_w * nq, dinv = 1.0f / fmaxf(fabsf(den), ex2(-m_t * LOG2E));
    f32x16 o[2];
#pragma unroll
    for (int r = 0; r < 16; ++r) { o[0][r] = 0.f; o[1][r] = 0.f; }
    qkt(o[0], o[1], Ct + hd * KT, qf, lane);
#pragma unroll
    for (int r = 0; r < 16; ++r) { o[0][r] *= inter_w; o[1][r] *= inter_w; }
    pv(o, Vt + hd * VT, p0, p1, lane);
    float ss = 0.f;
#pragma unroll
    for (int r = 0; r < 16; ++r) { o[0][r] *= dinv; o[1][r] *= dinv; ss += o[0][r] * o[0][r] + o[1][r] * o[1][r]; }
    ss = half_sum(ss);
    const float rs = 1.0f / sqrtf(ss * (1.0f / 64.0f) + NORM_EPS);
    const bf16* op = PROJ + m * PW + C_MO + hd * 64; const float* og = KIN(11) + l * 256 + hd * 64; bf16* orow = WSP(bf16, WS_MIX) + m * 1024 + hd * 64;
#pragma unroll
    for (int dh = 0; dh < 2; ++dh)
#pragma unroll
        for (int g = 0; g < 4; ++g) { const int d = 32 * dh + 8 * g + 4 * h; const v2u ow = *(const v2u*)(op + d); const f32x4 gg = *(const f32x4*)(og + d);
            const float y0 = o[dh][4 * g] * rs * gg.x * sigmoid_f(bflo(ow.x)), y1 = o[dh][4 * g + 1] * rs * gg.y * sigmoid_f(bfhi(ow.x)), y2 = o[dh][4 * g + 2] * rs * gg.z * sigmoid_f(bflo(ow.y)), y3 = o[dh][4 * g + 3] * rs * gg.w * sigmoid_f(bfhi(ow.y));
            v2u pw; pw.x = pk2(y0, y1); pw.y = pk2(y2, y3); *(v2u*)(orow + d) = pw; }
    LDS_BARRIER();
}

DI void p_mix(Ctx& C0, int l, int rp) {
    volatile LAS unsigned* bc = C0.MISC + 4;
    {
      const float* BLg = (const float*)(C0.ws + WS_BL); LAS float* BLl = (LAS float*)(C0.lds + att::L_BL2); LAS float* ELl = (LAS float*)(C0.lds + att::L_EL);
      for (int i = C0.tid; i < 4 * 132; i += NTHR) BLl[i] = BLg[i];
      for (int i = C0.tid; i < 4 * 320; i += NTHR) { const int hh = i / 320, dist = 255 - (i % 320); ELl[i] = dist >= 128 ? BLg[hh * 132 + 128] : (dist >= 0 ? BLg[hh * 132 + dist] : 0.f); }
      if (C0.wave == 0) { const Ctx& C = C0;
          const int ln = C0.lane; const float gq = wave_max(fabsf(KIN(15)[l * 64 + ln])), gk = wave_max(fmaxf(fabsf(KIN(16)[l * 192 + 64 + ln]), fabsf(KIN(16)[l * 192 + 128 + ln])));
          const float b0 = 64.0f * QSCALE * gq * gk * 1.02f + 0.5f;
          { const float fq = wave_max(fabsf(KIN(13)[l * 64 + ln])), fk = wave_max(fabsf(KIN(14)[l * 64 + ln])); if (ln == 0) ((LAS float*)(C0.lds + att::L_NST))[4] = 64.0f * QSCALE * fq * fk * 1.02f + 0.5f; }
#pragma unroll
          for (int hh = 0; hh < 4; ++hh) { const float mb = wave_max(fmaxf(fmaxf(fabsf(BLg[hh * 132 + ln]), fabsf(BLg[hh * 132 + 64 + ln])), fabsf(BLg[hh * 132 + 128]))); if (ln == 0) ((LAS float*)(C0.lds + att::L_NST))[hh] = b0 + mb; } }
      LDS_BARRIER(); }
    constexpr int NREG = 16 * 96 + 512, NCONV = MOE_CONV_ITEMS / 32;
    const int total = (l == 0) ? 13 * ((NCONV + 4) / 5 > (NREG + 7) / 8 ? (NCONV + 4) / 5 : (NREG + 7) / 8) : NREG;
    for (;;) {
        Ctx C = C0; { unsigned char* wsv = C0.ws; asm volatile("" : "+s"(wsv)); C.ws = wsv; int t_ = C0.tid; asm volatile("" : "+v"(t_)); C.tid = t_; C.lane = t_ & 63; }
        if (C.tid == 0) bc[0] = __hip_atomic_fetch_add((unsigned*)(C.ctl + CW_QUEUE + 64 * l + 16 * rp), 1u, RLX_AGENT);
        LDS_BARRIER();
        const int vidx = (int)bc[0];
        LDS_BARRIER();
        if (vidx >= total) break;
        int idx = vidx, cidx = -1;
#if QORDER == 1
        if (l == 0) { if (vidx >= NREG) { idx = NREG; cidx = vidx - NREG; } }
#else
        if (l == 0) { const int g = vidx / 13, r13 = vidx % 13; if (r13 < 8) idx = 8 * g + r13; else { idx = NREG; cidx = 5 * g + (r13 - 8); } }
#endif
        if (cidx >= 0) { if (cidx < NCONV && rp == 0) { LAS float* scr = (LAS float*)(C.lds + C.wave * 8448);
                moe_conv_items4(C, cidx * 32 + C.wave * 4, scr); LDS_BARRIER(); }
            continue; }
        if (idx >= NREG) continue;
        if (idx < 16 * 96) { const int lvl = idx / 96, r = idx % 96, qb = 15 - lvl;
            if (r < 32) { if (MIX_FOX && (rp == 0 || (RPF & 1))) { const bool fst = (FOX_STATIC == 2) || FOX_STATIC && __builtin_amdgcn_readfirstlane((int)(((const LAS float*)(C.lds + att::L_NST))[4] <= 100.0f)); if (fst) att::fox_unit(C, l, r >> 2, r & 3, qb); else att::fox_unit_safe(C, l, r >> 2, r & 3, qb); } }
            else if (r < 64) { if (MIX_SB && (rp == 0 || (RPF & 2))) att::sb_unit(C, (r - 32) >> 2, (r - 32) & 3, qb); }
            else { if (MIX_NSA && (rp == 0 || (RPF & 4))) att::nsa_unit(C, (r - 64) >> 2, 4 * qb + ((r - 64) & 3), rp == 0 ? 0 : NSADRY); } }
        else { if (MIX_MLSTM && (rp == 0 || (RPF & 8))) mlstm_out_unit(C, l, (idx - 16 * 96) >> 6, (idx - 16 * 96) & 63); }
    }
}

struct MoeL { int c0, c1, c2, c3, c4, c5, c6, c7, p1, p2, p3, p4, p5, p6, p7, p8; };
DI MoeL moe_layout(Ctx& C) {
    MoeL L;
#define LDC(e) ((int)__hip_atomic_load(C.ctl + CW_ECNT + (e), RLX_AGENT))
    L.c0 = LDC(0); L.c1 = LDC(1); L.c2 = LDC(2); L.c3 = LDC(3); L.c4 = LDC(4); L.c5 = LDC(5); L.c6 = LDC(6); L.c7 = LDC(7);
#undef LDC
    L.p1 = (L.c0 + 255) >> 8; L.p2 = L.p1 + ((L.c1 + 255) >> 8); L.p3 = L.p2 + ((L.c2 + 255) >> 8); L.p4 = L.p3 + ((L.c3 + 255) >> 8);
    L.p5 = L.p4 + ((L.c4 + 255) >> 8); L.p6 = L.p5 + ((L.c5 + 255) >> 8); L.p7 = L.p6 + ((L.c6 + 255) >> 8); L.p8 = L.p7 + ((L.c7 + 255) >> 8);
    return L;
}
DI void p_combine(Ctx& C, bool dry) {
    const bf16* Y1 = WSP(bf16, WS_Y1);
    for (size_t i = (size_t)C.blk * NTHR + C.tid; i < (size_t)T * D / 8; i += (size_t)C.G * NTHR) {
        const v4u y = *(const v4u*)(Y1 + i * 8); f32x4* o = (f32x4*)(C.out + i * 8);
        f32x4 a = o[0], b = o[1];
        a.x += bflo(y.x); a.y += bfhi(y.x); a.z += bflo(y.y); a.w += bfhi(y.y); b.x += bflo(y.z); b.y += bfhi(y.z); b.z += bflo(y.w); b.w += bfhi(y.w);
        if (!dry) { o[0] = a; o[1] = b; } else if (a.x == 123.456f) o[0] = b;
    }
}

constexpr int PH_L = 20, NPH = 2 + 2 * PH_L;
struct Args { const float* in[29]; float* out; unsigned char* ws; int ph_lo, ph_hi; };
extern __shared__ __attribute__((aligned(16))) unsigned char lds_raw[];
template <class P> DI P* uni(P* p) { const unsigned long long v = (unsigned long long)p; const unsigned lo = __builtin_amdgcn_readfirstlane((unsigned)v), hi = __builtin_amdgcn_readfirstlane((unsigned)(v >> 32)); return (P*)(((unsigned long long)hi << 32) | lo); }
DI int uni(int v) { return __builtin_amdgcn_readfirstlane(v); }
DI MoeL uni(MoeL L) { MoeL R; R.c0 = uni(L.c0); R.c1 = uni(L.c1); R.c2 = uni(L.c2); R.c3 = uni(L.c3); R.c4 = uni(L.c4); R.c5 = uni(L.c5); R.c6 = uni(L.c6); R.c7 = uni(L.c7);
    R.p1 = uni(L.p1); R.p2 = uni(L.p2); R.p3 = uni(L.p3); R.p4 = uni(L.p4); R.p5 = uni(L.p5); R.p6 = uni(L.p6); R.p7 = uni(L.p7); R.p8 = uni(L.p8); return R; }
DI pg8::MoeMap mk_map(const MoeL& L, unsigned char* ws) { pg8::MoeMap m; m.c0 = L.c0; m.c1 = L.c1; m.c2 = L.c2; m.c3 = L.c3; m.c4 = L.c4; m.c5 = L.c5; m.c6 = L.c6; m.c7 = L.c7;
    m.p1 = L.p1; m.p2 = L.p2; m.p3 = L.p3; m.p4 = L.p4; m.p5 = L.p5; m.p6 = L.p6; m.p7 = L.p7; m.tokof = (const int*)(ws + WS_TOKOF); m.tokw = (const float*)(ws + WS_TOKW); return m; }
DI void mk_ctx(Ctx& C, unsigned char* ws, float* out) {
    ws = uni(ws); out = uni(out);
    { const void __attribute__((address_space(4)))* ka = (const void __attribute__((address_space(4)))*)__builtin_amdgcn_kernarg_segment_ptr(); asm volatile("" : "+s"(ka), "+s"(ws), "+s"(out)); C.ka = ka; }
    C.lds = (LAS unsigned char*)lds_raw; C.MISC = (volatile LAS unsigned*)(C.lds + MISC_OFF);
    { int t_ = threadIdx.x; asm volatile("" : "+v"(t_)); C.tid = t_; }
    C.lane = C.tid & 63; C.wave = __builtin_amdgcn_readfirstlane(C.tid >> 6); C.G = gridDim.x; C.blk = blockIdx.x;
    C.ws = ws; C.ctl = (gu32*)(ws + WS_CTL); C.out = out;
}
#ifndef PH_NOINLINE
#define PH_NOINLINE 0
#endif
#if PH_NOINLINE
#define PHFN __device__ __noinline__ void
#else
#define PHFN DI void
#endif
PHFN f_prologue(unsigned char* ws, float* out) { Ctx C; mk_ctx(C, ws, out); p_prologue(C); }
PHFN f_modfin(unsigned char* ws, float* out) { Ctx C; mk_ctx(C, ws, out); p_modfin(C); }
PHFN f_norm1(unsigned char* ws, float* out, int l) { l = uni(l); Ctx C; mk_ctx(C, ws, out); out = C.out; p_norm<false>(C, l, (l == 0) ? KIN(0) : (const float*)out, KIN(5) + l * D, 0, 1024); }
PHFN f_norm2(unsigned char* ws, float* out, int l) { l = uni(l); Ctx C; mk_ctx(C, ws, out); out = C.out; p_norm<false>(C, l, out, KIN(6) + l * D, 3072, 4096); }
PHFN f_norm2r(unsigned char* ws, float* out, int l) { l = uni(l); Ctx C; mk_ctx(C, ws, out); out = C.out; p_norm<true>(C, l, out, KIN(6) + l * D, 3072, 4096); }
PHFN f_gemm_in(unsigned char* ws, float* out, int l, int dry) { l = uni(l); dry = uni(dry); Ctx C; mk_ctx(C, ws, out);
    pg8::Gemm g{WSP(bf16, WS_H), WSP(bf16, WS_WIN) + (size_t)l * PW * D, T, PW, D}; pg8::StaticOrder S; S.init(T, PW, C.G, C.blk);
    pg8::EpiBf16N E{WSP(bf16, WS_PROJ), PW, WSP(float, WS_GT) + l * 384, (PG8_LAS float*)(C.lds + 131072), dry}; pg8::gemm_phase<pg8::EpiBf16N, pg8::StaticOrder, true, true>(C.lds, g, S, E); }
PHFN f_prep(unsigned char* ws, float* out, int l, int mode) { l = uni(l); mode = uni(mode); Ctx C; mk_ctx(C, ws, out); p_prep(C, l, mode); }
PHFN f_scan(unsigned char* ws, float* out, int l, int dry) { l = uni(l); dry = uni(dry); Ctx C; mk_ctx(C, ws, out); p_scan(C, l, dry != 0); }
PHFN f_mix(unsigned char* ws, float* out, int l, int rp) { l = uni(l); rp = uni(rp); Ctx C; mk_ctx(C, ws, out); p_mix(C, l, rp); }
PHFN f_gemm_res(unsigned char* ws, float* out, const bf16* A, const bf16* Bt, int K, const float* base, const float* gate, int dry) { dry = uni(dry); A = uni(A); Bt = uni(Bt); K = uni(K); base = uni(base); gate = uni(gate); Ctx C; mk_ctx(C, ws, out); out = C.out;
    pg8::Gemm g{A, Bt, T, D, K}; pg8::StaticOrder S; S.init(T, D, C.G, C.blk);
    pg8::EpiResGate E{base, out, gate, D, 6144, dry}; pg8::gemm_phase<pg8::EpiResGate, pg8::StaticOrder, true, true>(C.lds, g, S, E); }
PHFN f_gu(unsigned char* ws, float* out, int dry) { dry = uni(dry); Ctx C; mk_ctx(C, ws, out);
    pg8::Gemm g{WSP(bf16, WS_H), WSP(bf16, WS_WGU), T, 2 * FF, D}; pg8::StaticOrder S; S.init(T, 2 * FF, C.G, C.blk);
    pg8::EpiSwiGLU E{WSP(bf16, WS_ACT), FF, 2 * FF / 256, 0, dry}; pg8::gemm_phase<pg8::EpiSwiGLU, pg8::StaticOrder, GU_ALIGN, true>(C.lds, g, S, E); }
PHFN f_mgu(unsigned char* ws, float* out, MoeL L, int t0, int nt, int dry) { dry = uni(dry); L = uni(L); t0 = uni(t0); nt = uni(nt); Ctx C; mk_ctx(C, ws, out);
    pg8::Gemm g{WSP(bf16, WS_H), WSP(bf16, WS_MWGU), 0, 0, D};
    pg8::MoeOrder S{t0, nt, 2 * FFE / 256, C.G, C.blk, 0, mk_map(L, C.ws)};
    pg8::EpiSwiGLU E{t0 == 256 ? WSP(bf16, WS_ACT2) : WSP(bf16, WS_ACTE), FFE, 2 * FFE / 256, t0 * 256, dry}; pg8::gemm_phase_ga<pg8::EpiSwiGLU, pg8::MoeOrder, GU_ALIGN, true>(C.lds, g, S, E); }
PHFN f_mdown(unsigned char* ws, float* out, MoeL L, int t0, int nt, const float* gate, int dry) { dry = uni(dry); L = uni(L); t0 = uni(t0); nt = uni(nt); gate = uni(gate); Ctx C; mk_ctx(C, ws, out); out = C.out;
    pg8::Gemm g{t0 == 256 ? WSP(bf16, WS_ACT2) : WSP(bf16, WS_ACTE), WSP(bf16, WS_MWD), 0, 0, FFE};
    pg8::MoeOrder S{t0, nt, D / 256, C.G, C.blk, t0, mk_map(L, C.ws)};
    pg8::EpiMoeDown E{mk_map(L, C.ws), out, WSP(bf16, WS_Y1), gate, 6144, t0, D / 256, dry};
    pg8::gemm_phase<pg8::EpiMoeDown, pg8::MoeOrder, true, true>(C.lds, g, S, E); }
PHFN f_mgu_tail(unsigned char* ws, float* out, MoeL L, int t0, int ntail, const float* gate) { L = uni(L); t0 = uni(t0); ntail = uni(ntail); gate = uni(gate); Ctx C; mk_ctx(C, ws, out); out = C.out;
    { pg8::Gemm g{WSP(bf16, WS_ACT2), WSP(bf16, WS_MWD), 0, 0, FFE};
      pg8::MoeOrder S{256, ntail, D / 256, C.G, C.blk, 256, mk_map(L, C.ws)};
      pg8::EpiMoeDown E{mk_map(L, C.ws), out, WSP(bf16, WS_Y1), gate, 6144, 256, D / 256, 0};
      pg8::gemm_phase<pg8::EpiMoeDown, pg8::MoeOrder, true, true>(C.lds, g, S, E); }
    { pg8::Gemm g{WSP(bf16, WS_H), WSP(bf16, WS_MWGU), 0, 0, D};
      pg8::MoeOrderB S{t0, 2 * FFE / 256, C.blk, 4 * ntail, mk_map(L, C.ws)};
      pg8::EpiSwiGLU E{WSP(bf16, WS_ACTE), FFE, 2 * FFE / 256, t0 * 256, 0}; pg8::gemm_phase_ga<pg8::EpiSwiGLU, pg8::MoeOrderB, GU_ALIGN, true>(C.lds, g, S, E); }
}
PHFN f_combine(unsigned char* ws, float* out, int dry) { dry = uni(dry); Ctx C; mk_ctx(C, ws, out); p_combine(C, dry != 0); }

__global__ void __launch_bounds__(NTHR, 2) fwd(Args args) {
    unsigned char* const ws = args.ws; float* const out = args.out;
    volatile LAS unsigned* MISC = (volatile LAS unsigned*)((LAS unsigned char*)lds_raw + MISC_OFF);
    for (int u = threadIdx.x; u < (LDS_BYTES - MISC_OFF) / 4; u += NTHR) MISC[u] = 0u;
    __syncthreads();
    const int lo = args.ph_lo, hi = args.ph_hi;
    XcdBarrier bar; bar.bar = (unsigned*)(ws + WS_CTL) + CW_BAR; bar.x = 0; bar.st = nullptr;
    if (hi - lo > 1) bar = xcd_barrier_post((unsigned*)(ws + WS_CTL) + CW_BAR, MISC + 0);
#define IN(k) (lo <= (k) && (k) < hi)
#define SEAM(k) do { if (IN(k) && IN((k) + 1)) xcd_barrier(bar); } while (0)
    if (EN_PRO && IN(0)) for (int rp_ = 0; rp_ < REP_PRO; ++rp_) f_prologue(ws, out); SEAM(0);
    if (EN_PRO && IN(1)) f_modfin(ws, out); SEAM(1);
    for (int xb_ = 0; xb_ < XTRA_BAR; ++xb_) xcd_barrier(bar);
#pragma unroll 1
    for (int l = 0; l < DEPTH; ++l) {
        const int pb = 2 + PH_L * l;
        const float* MOD = (const float*)(ws + WS_MOD) + (size_t)l * 8 * 6144;
        if (EN_NORM && IN(pb + 0)) for (int rp_ = 0; rp_ < REP_NORM; ++rp_) f_norm1(ws, out, l); SEAM(pb + 0);
        if (EN_GIN && IN(pb + 1)) for (int rp_ = 0; rp_ < REP_GIN; ++rp_) f_gemm_in(ws, out, l, rp_ ? GDRY : 0); SEAM(pb + 1);
        if (EN_PREP && IN(pb + 2)) for (int rp_ = 0; rp_ < REP_PREP; ++rp_) f_prep(ws, out, l, rp_ == 0 ? 0 : PREP_RMODE); SEAM(pb + 2);
        if (EN_SCAN && IN(pb + 3)) for (int rp_ = 0; rp_ < REP_THIN; ++rp_) f_scan(ws, out, l, rp_); SEAM(pb + 3);
        if (EN_MIX && IN(pb + 4)) for (int rp_ = 0; rp_ < REP_MIX; ++rp_) f_mix(ws, out, l, rp_); SEAM(pb + 4);
        if (EN_GOUT && IN(pb + 5)) for (int rp_ = 0; rp_ < REP_RES; ++rp_) f_gemm_res(ws, out, (const bf16*)(ws + WS_MIX), (const bf16*)(ws + WS_WOUT) + (size_t)l * D * D, D, (l == 0) ? ((const float* const __attribute__((address_space(4)))*)__builtin_amdgcn_kernarg_segment_ptr())[0] : (const float*)out, MOD + 2048, rp_); SEAM(pb + 5);
        if (l == 0) {
            if (EN_NORM && IN(pb + 6)) for (int rp_ = 0; rp_ < REP_THIN; ++rp_) f_norm2(ws, out, l); SEAM(pb + 6);
            if (EN_GU && IN(pb + 7)) for (int rp_ = 0; rp_ < REP_GU; ++rp_) f_gu(ws, out, rp_ ? GDRY : 0); SEAM(pb + 7);
            if (EN_DOWN && IN(pb + 8)) for (int rp_ = 0; rp_ < REP_RES; ++rp_) f_gemm_res(ws, out, (const bf16*)(ws + WS_ACT), (const bf16*)(ws + WS_WD), FF, out, MOD + 5120, rp_); SEAM(pb + 8);
        } else {
            if (EN_MOE && IN(pb + 6)) f_norm2r(ws, out, l); SEAM(pb + 6);
            Ctx C; mk_ctx(C, ws, out);
            const MoeL L = uni(moe_layout(C));
            const int ntail = L.p8 - 4 * CHUNK_TILES;
            if (EN_MGU && IN(pb + 8)) for (int rp_ = 0; rp_ < REP_GU; ++rp_) f_mgu(ws, out, L, 0, CHUNK_TILES, rp_ ? GDRY : 0); SEAM(pb + 8);
            if (EN_MDOWN && IN(pb + 9)) f_mdown(ws, out, L, 0, CHUNK_TILES, MOD + 5120, 0); SEAM(pb + 9);
            if (ntail > 0) { if (EN_MGU && IN(pb + 10)) f_mgu(ws, out, L, 4 * CHUNK_TILES, ntail, 0); SEAM(pb + 10); }
            if (ntail > 0) { if (EN_MGU && IN(pb + 11)) f_mgu_tail(ws, out, L, CHUNK_TILES, ntail, MOD + 5120); }
            else { if (EN_MGU && IN(pb + 11)) f_mgu(ws, out, L, CHUNK_TILES, CHUNK_TILES, 0); }
            SEAM(pb + 11);
            if (EN_MDOWN && IN(pb + 12)) f_mdown(ws, out, L, CHUNK_TILES, CHUNK_TILES, MOD + 5120, 0); SEAM(pb + 12);
            if (EN_MGU && IN(pb + 13)) for (int rp_ = 0; rp_ < REP_GU; ++rp_) f_mgu(ws, out, L, 2 * CHUNK_TILES, CHUNK_TILES, rp_ ? GDRY : 0); SEAM(pb + 13);
            if (EN_MDOWN && IN(pb + 14)) f_mdown(ws, out, L, 2 * CHUNK_TILES, CHUNK_TILES, MOD + 5120, 0); SEAM(pb + 14);
            if (EN_MGU && IN(pb + 15)) for (int rp_ = 0; rp_ < REP_GU; ++rp_) f_mgu(ws, out, L, 3 * CHUNK_TILES, CHUNK_TILES, rp_ ? GDRY : 0); SEAM(pb + 15);
            if (EN_MDOWN && IN(pb + 16)) f_mdown(ws, out, L, 3 * CHUNK_TILES, CHUNK_TILES, MOD + 5120, 0); SEAM(pb + 16);
            if (EN_MOE && IN(pb + 18)) for (int rp_ = 0; rp_ < REP_THIN; ++rp_) f_combine(ws, out, rp_);
        }
    }
#undef IN
#undef SEAM
}

extern "C" void kernel_launch(void* const* d_in, const int* in_sizes, int n_in, void* d_out, int out_size, void* d_ws, size_t ws_size, hipStream_t stream) {
    static int grid = 0;
    if (grid == 0) {
        if (n_in != 29 || in_sizes[0] != T * D || out_size != T * D || ws_size < WS_END) { fprintf(stderr, "kernel_launch: unexpected shapes (n_in %d, in0 %d, out %d, ws %zu)\n", n_in, n_in > 0 ? in_sizes[0] : -1, out_size, ws_size); grid = -1; return; }
        if (hipFuncSetAttribute((const void*)fwd, hipFuncAttributeMaxDynamicSharedMemorySize, LDS_BYTES) != hipSuccess) { fprintf(stderr, "kernel_launch: hipFuncSetAttribute failed\n"); grid = -1; return; }
        int dev = 0, cus = 0, per_cu = 0;
        (void)hipGetDevice(&dev); (void)hipDeviceGetAttribute(&cus, hipDeviceAttributeMultiprocessorCount, dev);
        if (hipOccupancyMaxActiveBlocksPerMultiprocessor(&per_cu, (const void*)fwd, NTHR, LDS_BYTES) != hipSuccess || per_cu < 1) fprintf(stderr, "kernel_launch: occupancy query says %d per CU\n", per_cu);
        (void)hipGetLastError();
        grid = 256;
        if (cus < 256) fprintf(stderr, "kernel_launch: device has %d CUs; this kernel needs 256\n", cus);
    }
    if (grid < 0) return;
    (void)hipMemsetAsync((char*)d_ws + WS_CTL, 0, CTL_ZERO_BYTES, stream);
    Args a{};
    for (int i = 0; i < 29; ++i) a.in[i] = (const float*)d_in[i];
    a.out = (float*)d_out; a.ws = (unsigned char*)d_ws;
#if N_LAUNCHES == 1
    a.ph_lo = 0; a.ph_hi = NPH;
    hipLaunchKernelGGL(fwd, dim3(grid), dim3(NTHR), LDS_BYTES, stream, a);
#else
    for (int k = 0; k < NPH; ++k) {
        const int r = (k - 2) % PH_L; if (k >= 2 && ((k < 2 + PH_L && r > 8) || (k >= 2 + PH_L && r > 18))) continue;
        a.ph_lo = k; a.ph_hi = k + 1;
        hipLaunchKernelGGL(fwd, dim3(grid), dim3(NTHR), LDS_BYTES, stream, a);
    }
#endif
}
```

```cpp
#include <hip/hip_runtime.h>
#include <cstdio>
#include <cstdint>
#include <cmath>
#ifndef N_LAUNCHES
#define N_LAUNCHES 1
#endif
#ifndef RES_BATCH
#define RES_BATCH 4
#endif
#ifndef FOX_STATIC
#define FOX_STATIC 1
#endif
#ifndef NSA_STATIC
#define NSA_STATIC 1
#endif
#ifndef MIX_FOX
#define MIX_FOX 1
#endif
#ifndef MIX_SB
#define MIX_SB 1
#endif
#ifndef MIX_NSA
#define MIX_NSA 1
#endif
#ifndef MIX_MLSTM
#define MIX_MLSTM 1
#endif
#ifndef EN_PRO
#define EN_PRO 1
#endif
#ifndef EN_NORM
#define EN_NORM 1
#endif
#ifndef EN_GIN
#define EN_GIN 1
#endif
#ifndef EN_PREP
#define EN_PREP 1
#endif
#ifndef EN_SCAN
#define EN_SCAN 1
#endif
#ifndef EN_MIX
#define EN_MIX 1
#endif
#ifndef EN_GOUT
#define EN_GOUT 1
#endif
#ifndef EN_GU
#define EN_GU 1
#endif
#ifndef EN_DOWN
#define EN_DOWN 1
#endif
#ifndef EN_MOE
#define EN_MOE 1
#endif
#ifndef EN_MGU
#define EN_MGU 1
#endif
#ifndef EN_MDOWN
#define EN_MDOWN 1
#endif
#ifndef REP_PRO
#define REP_PRO 1
#endif
#ifndef REP_GIN
#define REP_GIN 1
#endif
#ifndef REP_PREP
#define REP_PREP 1
#endif
#ifndef REP_MIX
#define REP_MIX 1
#endif
#ifndef REP_GU
#define REP_GU 1
#endif
#ifndef REP_NORM
#define REP_NORM 1
#endif
#ifndef REPU_FOX
#define REPU_FOX 1
#endif
#ifndef REPU_SB
#define REPU_SB 1
#endif
#ifndef REPU_NSA
#define REPU_NSA 1
#endif
#ifndef REPU_ML
#define REPU_ML 1
#endif
#ifndef XTRA_BAR
#define XTRA_BAR 0
#endif
#ifndef REP_GATHER
#define REP_GATHER 1
#endif
#ifndef REP_RES
#define REP_RES 1
#endif
#ifndef RPF
#define RPF 15
#endif
#ifndef NSADRY
#define NSADRY 0
#endif
#ifndef GU_ALIGN
#define GU_ALIGN true
#endif
#ifndef REP_THIN
#define REP_THIN 1
#endif
#ifndef PREP_RMODE
#define PREP_RMODE 1
#endif
#ifndef GDRY
#define GDRY 0
#endif
#ifndef QORDER
#define QORDER 0
#endif
namespace pg8 {
#define PG8_LAS __attribute__((address_space(3)))
typedef unsigned short bf16_t;
typedef short bf16x8 __attribute__((ext_vector_type(8)));
typedef float f32x4 __attribute__((ext_vector_type(4)));
typedef unsigned u32x4 __attribute__((ext_vector_type(4)));
constexpr int BM = 256, BK = 64, HALF = 128, HTB = HALF * BK * 2  , STAGE_BYTES = 8 * HTB, NXCD = 8, WGM = 8;

__host__ __device__ __forceinline__ int lds_byte(int r, int c) { const int st = (r >> 4) * 2 + (c >> 5), rr = r & 15, cc = c & 31, ob = rr * 64 + cc * 2; return st * 1024 + (ob ^ (((ob >> 9) & 1) << 5)); }
__host__ __device__ __forceinline__ void stage_rc(int b, int& R, int& C) { const int st = b / 1024, sb = b % 1024, swz = sb ^ (((sb >> 9) & 1) << 5); R = (st >> 1) * 16 + swz / 64; C = (st & 1) * 32 + (swz % 64) / 2; }
__host__ __device__ __forceinline__ int perm32(int rho) { const int n = rho >> 4, i = rho & 15; return 8 * (i >> 2) + 4 * n + (i & 3); }

struct Unit { int pm, pn; };
struct Gemm { const bf16_t* A; const bf16_t* Bt; int M, N, K; };

struct StaticOrder {
    int nM, nN, nwg, G, c;
    __host__ __device__ void init(int M, int N, int G_, int c_) { nM = M / BM; nN = N / BM; nwg = nM * nN; G = G_; c = c_; }
    __host__ __device__ bool next(int i, Unit& u) const {
        const long L = (long)i * G + c; if (L >= nwg) return false;
        int wgid = (int)L; { const int q = nwg / NXCD, r = nwg % NXCD, xcd = wgid % NXCD, off = wgid / NXCD; wgid = (xcd < r ? xcd * (q + 1) : r * (q + 1) + (xcd - r) * q) + off; }
        const int nig = WGM * nN, gid = wgid / nig, fm = gid * WGM, gsz = (nM - fm) < WGM ? (nM - fm) : WGM;
        u.pm = fm + ((wgid % nig) % gsz); u.pn = (wgid % nig) / gsz; return true;
    }
    __device__ __forceinline__ void a_ready(const Unit&) const {}
    __device__ __forceinline__ void done(const Unit&) const {}
};
__device__ __forceinline__ unsigned cvt_pk_bf16(float lo, float hi) { unsigned r; asm volatile("v_cvt_pk_bf16_f32 %0, %1, %2" : "=v"(r) : "v"(lo), "v"(hi)); return r; }
typedef float f32x2 __attribute__((ext_vector_type(2)));

__device__ __forceinline__ float silu_f(float x) { return x * __builtin_amdgcn_rcpf(1.0f + __builtin_amdgcn_exp2f(-1.4426950408889634f * x)); }
struct EpiBf16 {
    static constexpr bool PERM = true, AFTER_DRAIN = false;
    bf16_t* O; int ldc; int dry;
    __device__ __forceinline__ void operator()(const f32x4 (&acc)[2][2][4][2], const Unit& u, int wr, int wc, int fr, int fq) const {
        if (dry) return;
        const int row0 = u.pm * BM + wr * 64 + fr, col0 = u.pn * BM + wc * 32 + 8 * fq;
#pragma unroll
        for (int ai = 0; ai < 2; ++ai)
#pragma unroll
            for (int m = 0; m < 4; ++m) { bf16_t* rowp = O + (size_t)(row0 + ai * HALF + m * 16) * ldc + col0;
#pragma unroll
                for (int bj = 0; bj < 2; ++bj) { const f32x4 v0 = acc[ai][bj][m][0], v1 = acc[ai][bj][m][1];
                    u32x4 w; w.x = cvt_pk_bf16(v0[0], v0[1]); w.y = cvt_pk_bf16(v0[2], v0[3]); w.z = cvt_pk_bf16(v1[0], v1[1]); w.w = cvt_pk_bf16(v1[2], v1[3]);
                    *(u32x4*)(rowp + bj * HALF) = w; } }
    }
};
struct EpiBf16N {
    static constexpr bool PERM = true, AFTER_DRAIN = false;
    bf16_t* O; int ldc; const float* GT; PG8_LAS float* SC; int dry;
    __device__ __forceinline__ static int head_type(int hc) { return (hc >= 1024 && hc < 1280) ? 0 : (hc >= 1280 && hc < 1536) ? 1 : (hc >= 1792 && hc < 2048) ? 2 : (hc >= 2560 && hc < 2816) ? 3 : hc == 2944 ? 4 : hc == 3072 ? 5 : -1; }
    __device__ __forceinline__ void operator()(const f32x4 (&acc)[2][2][4][2], const Unit& u, int wr, int wc, int fr, int fq) const {
        if (dry) return;
        asm volatile("" : "+v"(fr), "+v"(fq));
        const int pn = __builtin_amdgcn_readfirstlane(u.pn);
        const int row0 = u.pm * BM + wr * 64 + fr, col0 = pn * BM + wc * 32 + 8 * fq;
        const bool ntile = (pn == 4) | (pn == 5) | (pn == 10) | (pn == 11) | (pn == 12), stile = ntile | (pn == 7);
        if (!stile) {
#pragma unroll
            for (int ai = 0; ai < 2; ++ai)
#pragma unroll
                for (int m = 0; m < 4; ++m) { bf16_t* rowp = O + (size_t)(row0 + ai * HALF + m * 16) * ldc + col0;
#pragma unroll
                    for (int bj = 0; bj < 2; ++bj) { const f32x4 v0 = acc[ai][bj][m][0], v1 = acc[ai][bj][m][1];
                        u32x4 w; w.x = cvt_pk_bf16(v0[0], v0[1]); w.y = cvt_pk_bf16(v0[2], v0[3]); w.z = cvt_pk_bf16(v1[0], v1[1]); w.w = cvt_pk_bf16(v1[2], v1[3]);
                        *(u32x4*)(rowp + bj * HALF) = w; } }
            return;
        }
        const int wid = wr * 4 + wc;
#pragma unroll
        for (int bj = 0; bj < 2; ++bj) {
            const int ty = head_type(pn * BM + bj * HALF + (wc >> 1) * 64);
            const bool nrm = ntile && ty >= 0 && ty != 2;
            float ps[2][4];
            if (ntile) {
#pragma unroll
                for (int ai = 0; ai < 2; ++ai)
#pragma unroll
                    for (int m = 0; m < 4; ++m) { const f32x4 v0 = acc[ai][bj][m][0], v1 = acc[ai][bj][m][1];
                        float ss = (v0[0] * v0[0] + v0[1] * v0[1]) + (v0[2] * v0[2] + v0[3] * v0[3]) + (v1[0] * v1[0] + v1[1] * v1[1]) + (v1[2] * v1[2] + v1[3] * v1[3]);
                        ss += __shfl_xor(ss, 16); ss += __shfl_xor(ss, 32);
                        ps[ai][m] = ss;
                        if (fq == 0) SC[(wid * 16 + bj * 8 + ai * 4 + m) * 16 + fr] = ss; }
                asm volatile("s_waitcnt lgkmcnt(0)" ::: "memory");
                __builtin_amdgcn_s_barrier();
            }
            f32x4 g0 = (f32x4){1.f, 1.f, 1.f, 1.f}, g1 = g0;
            if (ty >= 0) { const float* gp = GT + ty * 64 + (wc & 1) * 32 + 8 * fq; g0 = *(const f32x4*)gp; g1 = *(const f32x4*)(gp + 4); }
#pragma unroll
            for (int ai = 0; ai < 2; ++ai)
#pragma unroll
                for (int m = 0; m < 4; ++m) { float r = 1.0f;
                    if (nrm) { const float tot = ps[ai][m] + SC[((wid ^ 1) * 16 + bj * 8 + ai * 4 + m) * 16 + fr]; r = __builtin_amdgcn_rsqf(tot * (1.0f / 64.0f) + 1e-6f); }
                    const f32x4 v0 = acc[ai][bj][m][0] * g0 * r, v1 = acc[ai][bj][m][1] * g1 * r;
                    u32x4 w; w.x = cvt_pk_bf16(v0[0], v0[1]); w.y = cvt_pk_bf16(v0[2], v0[3]); w.z = cvt_pk_bf16(v1[0], v1[1]); w.w = cvt_pk_bf16(v1[2], v1[3]);
                    *(u32x4*)(O + (size_t)(row0 + ai * HALF + m * 16) * ldc + col0 + bj * HALF) = w; }
        }
    }
};
struct EpiResGate {
    static constexpr bool PERM = false, AFTER_DRAIN = false;
    const float* base; float* out; const float* gate; int ldc; int gate_ld; int dry;
    __device__ __forceinline__ void operator()(const f32x4 (&acc)[2][2][4][2], const Unit& u, int wr, int wc, int fr, int fq) const {
        if (dry) return;
        const int row0 = u.pm * BM + wr * 64 + fr, col0 = u.pn * BM + wc * 32 + 4 * fq;
        const float* gp = gate + (size_t)((u.pm * BM) >> 12) * gate_ld + col0;
        f32x4 gv[2][2];
#pragma unroll
        for (int bj = 0; bj < 2; ++bj)
#pragma unroll
            for (int n = 0; n < 2; ++n) gv[bj][n] = *(const f32x4*)(gp + bj * HALF + n * 16);
#pragma unroll
        for (int ai = 0; ai < 2; ++ai)
#pragma unroll
            for (int mb = 0; mb < 4; mb += RES_BATCH) {
                f32x4 bs[RES_BATCH][2][2];
#pragma unroll
                for (int mi = 0; mi < RES_BATCH; ++mi) { const size_t off = (size_t)(row0 + ai * HALF + (mb + mi) * 16) * ldc + col0;
#pragma unroll
                    for (int bj = 0; bj < 2; ++bj)
#pragma unroll
                        for (int n = 0; n < 2; ++n) bs[mi][bj][n] = *(const __attribute__((address_space(1))) f32x4*)(base + off + bj * HALF + n * 16); }
                asm volatile("" ::: "memory");
#pragma unroll
                for (int mi = 0; mi < RES_BATCH; ++mi) { const size_t off = (size_t)(row0 + ai * HALF + (mb + mi) * 16) * ldc + col0;
#pragma unroll
                    for (int bj = 0; bj < 2; ++bj)
#pragma unroll
                        for (int n = 0; n < 2; ++n) *(__attribute__((address_space(1))) f32x4*)(out + off + bj * HALF + n * 16) = bs[mi][bj][n] + gv[bj][n] * acc[ai][bj][mb + mi][n]; }
                asm volatile("" ::: "memory"); }
    }
};
struct EpiSwiGLU {
    static constexpr bool PERM = true, AFTER_DRAIN = false;
    bf16_t* O; int ldc; int pn_mod; int row_sub; int dry;
    __device__ __forceinline__ void operator()(const f32x4 (&acc)[2][2][4][2], const Unit& u, int wr, int wc, int fr, int fq) const {
        if (dry) return;
        const int row0 = u.pm * BM - row_sub + wr * 64 + fr, col0 = (u.pn % pn_mod) * HALF + wc * 32 + 8 * fq;
#pragma unroll
        for (int ai = 0; ai < 2; ++ai)
#pragma unroll
            for (int m = 0; m < 4; ++m) { bf16_t* rowp = O + (size_t)(row0 + ai * HALF + m * 16) * ldc + col0;
                const f32x4 g0 = acc[ai][0][m][0], g1 = acc[ai][0][m][1], u0 = acc[ai][1][m][0], u1 = acc[ai][1][m][1];
                float v[8];
#pragma unroll
                for (int j = 0; j < 4; ++j) { v[j] = silu_f(g0[j]) * u0[j]; v[4 + j] = silu_f(g1[j]) * u1[j]; }
                u32x4 w; w.x = cvt_pk_bf16(v[0], v[1]); w.y = cvt_pk_bf16(v[2], v[3]); w.z = cvt_pk_bf16(v[4], v[5]); w.w = cvt_pk_bf16(v[6], v[7]);
                *(u32x4*)rowp = w; }
    }
};
struct MoeMap {
    int c0, c1, c2, c3, c4, c5, c6, c7, p1, p2, p3, p4, p5, p6, p7; const int* tokof; const float* tokw;
    __device__ __forceinline__ int expert(int tile) const { return (tile >= p1) + (tile >= p2) + (tile >= p3) + (tile >= p4) + (tile >= p5) + (tile >= p6) + (tile >= p7); }
    __device__ __forceinline__ int index(int tile, int r) const {
        tile = __builtin_amdgcn_readfirstlane(tile);
        const int g1 = tile >= p1, g2 = tile >= p2, g3 = tile >= p3, g4 = tile >= p4, g5 = tile >= p5, g6 = tile >= p6, g7 = tile >= p7;
        const int e = g1 + g2 + g3 + g4 + g5 + g6 + g7;
        int pte = g1 * p1; pte = max(pte, g2 * p2); pte = max(pte, g3 * p3); pte = max(pte, g4 * p4); pte = max(pte, g5 * p5); pte = max(pte, g6 * p6); pte = max(pte, g7 * p7);
        const int ce = c0 + g1 * (c1 - c0) + g2 * (c2 - c1) + g3 * (c3 - c2) + g4 * (c4 - c3) + g5 * (c5 - c4) + g6 * (c6 - c5) + g7 * (c7 - c6);
        const int slot = (tile - pte) * 256 + r; return slot < ce ? e * 32768 + slot : -1; }
};
struct EpiMoeDown {
    static constexpr bool PERM = false, AFTER_DRAIN = false;
    MoeMap mm; float* out; bf16_t* y1; const float* gate; int gate_ld; int tile_add; int pn_mod; int dry;
    __device__ __forceinline__ void operator()(const f32x4 (&acc)[2][2][4][2], const Unit& u, int wr, int wc, int fr, int fq) const {
        if (dry) return;
        const int tile = u.pm + tile_add, rl0 = wr * 64 + fr, col0 = (u.pn % pn_mod) * BM + wc * 32 + 4 * fq;
        int tks[8]; float ws[8];
#pragma unroll
        for (int q = 0; q < 8; ++q) { const int ix = mm.index(tile, rl0 + (q >> 2) * HALF + (q & 3) * 16); tks[q] = ix >= 0 ? mm.tokof[ix] : -1; ws[q] = ix >= 0 ? mm.tokw[ix] : 0.f; }
#pragma unroll
        for (int ai = 0; ai < 2; ++ai)
#pragma unroll
            for (int m = 0; m < 4; ++m) { const int tk = tks[ai * 4 + m];
                if (tk >= 0) { const float w = ws[ai * 4 + m]; const int tok = tk & 0x3fffffff; const bool s1 = (tk >> 30) & 1;
                    const float* gp = gate + (size_t)(tok >> 12) * gate_ld + col0; const size_t off = (size_t)tok * 1024 + col0;
#pragma unroll
                    for (int bj = 0; bj < 2; ++bj)
#pragma unroll
                        for (int n = 0; n < 2; ++n) { const f32x4 gv = *(const f32x4*)(gp + bj * HALF + n * 16); const f32x4 v = gv * acc[ai][bj][m][n] * w;
                            if (s1) { typedef unsigned u32x2v __attribute__((ext_vector_type(2))); u32x2v pw; pw.x = cvt_pk_bf16(v[0], v[1]); pw.y = cvt_pk_bf16(v[2], v[3]); *(u32x2v*)(y1 + off + bj * HALF + n * 16) = pw; }
                            else { float* op = out + off + bj * HALF + n * 16; *(f32x4*)op = *(const f32x4*)op + v; } } }
                if (m & 1) asm volatile("" ::: "memory"); }
    }
};
struct MoeOrder {
    int t0, nt, ncol, G, c, pm_off; MoeMap mm;
    __device__ __forceinline__ bool next(int i, Unit& u) const {
        int tile, pnr;
        if (nt == 64 && G == 256) {
            pnr = i * 4 + (c >> 6); if (pnr >= ncol) return false; tile = t0 + (c & 7) * 8 + ((c >> 3) & 7);
        } else { const long L = (long)i * G + c; if (L >= (long)nt * ncol) return false; const int idx = (int)L; tile = t0 + idx % nt; pnr = idx / nt; }
        u.pm = tile - pm_off; u.pn = mm.expert(tile) * ncol + pnr; return true;
    }
    __device__ __forceinline__ unsigned row_byte(const Unit& u, int r) const { const int ix = mm.index(u.pm + pm_off, r); const int tok = ix >= 0 ? (mm.tokof[ix] & 0x3fffffff) : 0; return (unsigned)tok * 2048u; }
    __device__ __forceinline__ void a_ready(const Unit&) const {}
    __device__ __forceinline__ void done(const Unit&) const {}
};
struct MoeOrderB {
    int t0, ncol, c, nd; MoeMap mm;
    __device__ __forceinline__ bool next(int i, Unit& u) const {
        int ii = i, cc = c;
        if (c < nd) { if (i >= 4) return false; }
        else if (i == 7) { const int k = c - nd; if (k >= 3 * nd) return false; ii = 4 + k / nd; cc = k % nd; }
        else if (i > 7) return false;
        const int pnr = ii * 4 + (cc >> 6); if (pnr >= ncol) return false;
        const int tile = t0 + (cc & 7) * 8 + ((cc >> 3) & 7);
        u.pm = tile; u.pn = mm.expert(tile) * ncol + pnr; return true;
    }
    __device__ __forceinline__ unsigned row_byte(const Unit& u, int r) const { const int ix = mm.index(u.pm, r); const int tok = ix >= 0 ? (mm.tokof[ix] & 0x3fffffff) : 0; return (unsigned)tok * 2048u; }
    __device__ __forceinline__ void a_ready(const Unit&) const {}
    __device__ __forceinline__ void done(const Unit&) const {}
};
template <class Epi, class Sched, bool ALIGN_EPI = false, bool SP2 = false>
__device__ __forceinline__ void gemm_phase(PG8_LAS unsigned char* lds, const Gemm g, const Sched& S, const Epi& E) {
    int tid_ = threadIdx.x; asm volatile("" : "+v"(tid_));
    const int tid = tid_, wid = __builtin_amdgcn_readfirstlane(tid >> 6), lane = tid & 63, wr = wid >> 2, wc = wid & 3, fr = lane & 15, fq = lane >> 4;
    const int K = g.K, nt = K / BK;
    unsigned voffA[2], voffB[2];
#pragma unroll
    for (int i = 0; i < 2; ++i) { int R, C; stage_rc(tid * 16 + i * 8192, R, C); const int Rb = Epi::PERM ? ((R & ~31) + perm32(R & 31)) : R;
        voffA[i] = (unsigned)(R * K + C) * 2u; voffB[i] = (unsigned)(Rb * K + C) * 2u; }
    const size_t kstep = (size_t)(BK * 2);
    const size_t hstep = (size_t)HALF * K * 2;
    const size_t tstep = 2 * hstep;
    const unsigned ldsw = (unsigned)wid * 1024u;
    const int aoff = lds_byte(wr * 64 + fr, fq * 8), boff = lds_byte(wc * 32 + fr, fq * 8);
#define PG8_SA(b, h) (((b) * 2 + (h)) * HTB)
#define PG8_SB(b, h) ((4 + (b) * 2 + (h)) * HTB)
#define PG8_STAGE(bufoff, gbase, voff) do { _Pragma("unroll") for (int _i = 0; _i < 2; ++_i) \
        __builtin_amdgcn_global_load_lds((const unsigned*)((const char*)(gbase) + (voff)[_i]), (PG8_LAS unsigned*)(lds + (bufoff) + ldsw + _i * 8192), 16, 0, 0); } while (0)
#define PG8_LDA(dst, b, h) do { _Pragma("unroll") for (int m = 0; m < 4; ++m) _Pragma("unroll") for (int k = 0; k < 2; ++k) dst[m][k] = *(const PG8_LAS bf16x8*)(lds + PG8_SA(b, h) + aoff + m * 2048 + k * 1024); } while (0)
#define PG8_LDB(dst, b, h) do { _Pragma("unroll") for (int n = 0; n < 2; ++n) _Pragma("unroll") for (int k = 0; k < 2; ++k) dst[n][k] = *(const PG8_LAS bf16x8*)(lds + PG8_SB(b, h) + boff + n * 2048 + k * 1024); } while (0)
#define PG8_MMA(ai, bj, At, Bt) do { __builtin_amdgcn_s_setprio(1); _Pragma("unroll") for (int m = 0; m < 4; ++m) _Pragma("unroll") for (int n = 0; n < 2; ++n) _Pragma("unroll") for (int k = 0; k < 2; ++k) \
        acc[ai][bj][m][n] = __builtin_amdgcn_mfma_f32_16x16x32_bf16(Bt[n][k], At[m][k], acc[ai][bj][m][n], 0, 0, 0); __builtin_amdgcn_s_setprio(0); } while (0)
#define PG8_WAIT_V(n) asm volatile("s_waitcnt vmcnt(" #n ")" ::: "memory")
#define PG8_WAIT_L(n) asm volatile("s_waitcnt lgkmcnt(" #n ")" ::: "memory")
#define PG8_BAR __builtin_amdgcn_s_barrier()
#define PG8_SCHED __builtin_amdgcn_sched_barrier(0)
    Unit cur, nxt; int ui = 0;
    if (!S.next(0, cur)) return;
    f32x4 acc[2][2][4][2];
#pragma unroll
    for (int a = 0; a < 2; ++a)
#pragma unroll
        for (int b = 0; b < 2; ++b)
#pragma unroll
            for (int m = 0; m < 4; ++m)
#pragma unroll
                for (int n = 0; n < 2; ++n) acc[a][b][m][n] = (f32x4){0.f, 0.f, 0.f, 0.f};
    bf16x8 At[4][2], B0[2][2], B1[2][2];
    const char* cA = (const char*)g.A + (size_t)cur.pm * tstep; const char* cB = (const char*)g.Bt + (size_t)cur.pn * tstep;
    S.a_ready(cur);
    if constexpr (SP2) {
        PG8_STAGE(PG8_SB(0, 0), cB, voffB); PG8_STAGE(PG8_SB(0, 1), cB + hstep, voffB); PG8_STAGE(PG8_SA(0, 0), cA, voffA); PG8_STAGE(PG8_SA(0, 1), cA + hstep, voffA);
        if (wr == 1) PG8_BAR;
        PG8_WAIT_V(2); PG8_BAR;
        PG8_STAGE(PG8_SB(1, 0), cB + kstep, voffB); PG8_STAGE(PG8_SA(1, 0), cA + kstep, voffA); PG8_STAGE(PG8_SB(1, 1), cB + hstep + kstep, voffB);
        PG8_WAIT_V(6); PG8_BAR;
    } else {
        PG8_STAGE(PG8_SB(0, 0), cB, voffB); PG8_STAGE(PG8_SA(0, 0), cA, voffA); PG8_STAGE(PG8_SB(0, 1), cB + hstep, voffB); PG8_STAGE(PG8_SA(0, 1), cA + hstep, voffA);
        if (wr == 1) PG8_BAR;
        PG8_WAIT_V(4); PG8_BAR;
        PG8_STAGE(PG8_SB(1, 0), cB + kstep, voffB); PG8_STAGE(PG8_SA(1, 0), cA + kstep, voffA); PG8_STAGE(PG8_SB(1, 1), cB + hstep + kstep, voffB);
        PG8_WAIT_V(6); PG8_BAR;
    }
    for (;;) {
        const bool has_next = S.next(ui + 1, nxt);
        const char* nA = has_next ? (const char*)g.A + (size_t)nxt.pm * tstep : cA; const char* nB = has_next ? (const char*)g.Bt + (size_t)nxt.pn * tstep : cB;
        for (int t = 0; t < nt; t += 2) {
            const bool last = (t == nt - 2);
            const char* a1 = cA + (size_t)(t + 1) * kstep;
            const char* a2 = last ? nA : cA + (size_t)(t + 2) * kstep; const char* b2 = last ? nB : cB + (size_t)(t + 2) * kstep;
            const char* a3 = a2 + kstep; const char* b3 = b2 + kstep;
            if (last && has_next) S.a_ready(nxt);
            if constexpr (SP2) {
            PG8_LDB(B0, 0, 0); PG8_LDB(B1, 0, 1); PG8_SCHED; PG8_LDA(At, 0, 0); PG8_STAGE(PG8_SA(1, 1), a1 + hstep, voffA);
            PG8_WAIT_V(8); PG8_WAIT_L(0); PG8_BAR; PG8_MMA(0, 0, At, B0); PG8_MMA(0, 1, At, B1); PG8_BAR; PG8_SCHED;
            PG8_LDA(At, 0, 1); PG8_STAGE(PG8_SB(0, 0), b2, voffB); PG8_STAGE(PG8_SB(0, 1), b2 + hstep, voffB); PG8_STAGE(PG8_SA(0, 0), a2, voffA);
            PG8_WAIT_V(8); PG8_WAIT_L(0); PG8_BAR; PG8_MMA(1, 0, At, B0); PG8_MMA(1, 1, At, B1); PG8_BAR; PG8_SCHED;
            PG8_LDB(B0, 1, 0); PG8_LDB(B1, 1, 1); PG8_SCHED; PG8_LDA(At, 1, 0); PG8_STAGE(PG8_SA(0, 1), a2 + hstep, voffA);
            PG8_WAIT_V(8); PG8_WAIT_L(0); PG8_BAR; PG8_MMA(0, 0, At, B0); PG8_MMA(0, 1, At, B1); PG8_BAR; PG8_SCHED;
            PG8_LDA(At, 1, 1); PG8_STAGE(PG8_SB(1, 0), b3, voffB); PG8_STAGE(PG8_SB(1, 1), b3 + hstep, voffB); PG8_STAGE(PG8_SA(1, 0), a3, voffA);
            PG8_WAIT_V(8); PG8_WAIT_L(0); PG8_BAR; PG8_MMA(1, 0, At, B0); PG8_MMA(1, 1, At, B1); PG8_BAR; PG8_SCHED;
            } else {
            PG8_LDB(B0, 0, 0); PG8_SCHED; PG8_LDA(At, 0, 0); PG8_STAGE(PG8_SA(1, 1), a1 + hstep, voffA);
            PG8_WAIT_L(8); PG8_BAR; PG8_WAIT_L(0); PG8_MMA(0, 0, At, B0); PG8_BAR; PG8_SCHED;
            PG8_LDB(B1, 0, 1); PG8_STAGE(PG8_SB(0, 0), b2, voffB);
            PG8_BAR; PG8_WAIT_L(0); PG8_MMA(0, 1, At, B1); PG8_BAR;
            PG8_LDA(At, 0, 1); PG8_STAGE(PG8_SA(0, 0), a2, voffA);
            PG8_BAR; PG8_WAIT_L(0); PG8_MMA(1, 0, At, B0); PG8_BAR; PG8_SCHED;
            PG8_STAGE(PG8_SB(0, 1), b2 + hstep, voffB);
            PG8_WAIT_V(6); PG8_BAR; PG8_MMA(1, 1, At, B1); PG8_BAR;
            PG8_LDB(B0, 1, 0); PG8_SCHED; PG8_LDA(At, 1, 0); PG8_STAGE(PG8_SA(0, 1), a2 + hstep, voffA);
            PG8_WAIT_L(8); PG8_BAR; PG8_WAIT_L(0); PG8_MMA(0, 0, At, B0); PG8_BAR; PG8_SCHED;
            PG8_LDB(B1, 1, 1); PG8_STAGE(PG8_SB(1, 0), b3, voffB);
            PG8_BAR; PG8_WAIT_L(0); PG8_MMA(0, 1, At, B1); PG8_BAR;
            PG8_LDA(At, 1, 1); PG8_STAGE(PG8_SA(1, 0), a3, voffA);
            PG8_BAR; PG8_WAIT_L(0); PG8_MMA(1, 0, At, B0); PG8_BAR; PG8_SCHED;
            PG8_STAGE(PG8_SB(1, 1), b3 + hstep, voffB);
            PG8_WAIT_V(6); PG8_BAR; PG8_MMA(1, 1, At, B1); PG8_BAR;
            }
        }
        if constexpr (ALIGN_EPI) { if (wr == 0) PG8_BAR; }
        if constexpr (!Epi::AFTER_DRAIN) { E(acc, cur, wr, wc, fr, fq); S.done(cur); }
        if (!has_next) break;
#pragma unroll
        for (int a = 0; a < 2; ++a)
#pragma unroll
            for (int b = 0; b < 2; ++b)
#pragma unroll
                for (int m = 0; m < 4; ++m)
#pragma unroll
                    for (int n = 0; n < 2; ++n) acc[a][b][m][n] = (f32x4){0.f, 0.f, 0.f, 0.f};
        cur = nxt; cA = nA; cB = nB; ++ui;
        if constexpr (ALIGN_EPI) { if (wr == 1) PG8_BAR; }
    }
    PG8_WAIT_V(0);
    if constexpr (!ALIGN_EPI) { if (wr == 0) PG8_BAR; }
    PG8_BAR;
    if constexpr (Epi::AFTER_DRAIN) { E.fused(acc, cur, wr, wc, fr, fq, lds, wid, lane); S.done(cur); }
#undef PG8_SA
#undef PG8_SB
#undef PG8_STAGE
#undef PG8_LDA
#undef PG8_LDB
#undef PG8_MMA
#undef PG8_WAIT_V
#undef PG8_WAIT_L
#undef PG8_BAR
#undef PG8_SCHED
}
template <class Epi, class Sched, bool ALIGN_EPI = false, bool SP2 = false>
__device__ __forceinline__ void gemm_phase_ga(PG8_LAS unsigned char* lds, const Gemm g, const Sched& S, const Epi& E) {
    int tid_ = threadIdx.x; asm volatile("" : "+v"(tid_));
    const int tid = tid_, wid = __builtin_amdgcn_readfirstlane(tid >> 6), lane = tid & 63, wr = wid >> 2, wc = wid & 3, fr = lane & 15, fq = lane >> 4;
    const int K = g.K, nt = K / BK;
    static_assert(SP2, "gemm_phase_ga: SP2 loop only");
    unsigned voffA[2], voffB[2], colA[2]; int rowA[2];
#pragma unroll
    for (int i = 0; i < 2; ++i) { int R, C; stage_rc(tid * 16 + i * 8192, R, C); const int Rb = Epi::PERM ? ((R & ~31) + perm32(R & 31)) : R;
        voffA[i] = (unsigned)(R * K + C) * 2u; voffB[i] = (unsigned)(Rb * K + C) * 2u; rowA[i] = R; colA[i] = (unsigned)C * 2u; }
    const size_t kstep = (size_t)(BK * 2);
    const size_t hstep = (size_t)HALF * K * 2;
    const size_t tstep = 2 * hstep;
    const unsigned ldsw = (unsigned)wid * 1024u;
    const int aoff = lds_byte(wr * 64 + fr, fq * 8), boff = lds_byte(wc * 32 + fr, fq * 8);
#define PG8_SA(b, h) (((b) * 2 + (h)) * HTB)
#define PG8_SB(b, h) ((4 + (b) * 2 + (h)) * HTB)
#define PG8_STAGE(bufoff, gbase, voff) do { _Pragma("unroll") for (int _i = 0; _i < 2; ++_i) \
        __builtin_amdgcn_global_load_lds((const unsigned*)((const char*)(gbase) + (voff)[_i]), (PG8_LAS unsigned*)(lds + (bufoff) + ldsw + _i * 8192), 16, 0, 0); } while (0)
#define PG8_STAGE_A(bufoff, koff, V0, V1) do { \
        __builtin_amdgcn_global_load_lds((const unsigned*)(A0 + (koff) + (V0)), (PG8_LAS unsigned*)(lds + (bufoff) + ldsw), 16, 0, 0); \
        __builtin_amdgcn_global_load_lds((const unsigned*)(A0 + (koff) + (V1)), (PG8_LAS unsigned*)(lds + (bufoff) + ldsw + 8192), 16, 0, 0); } while (0)
#define PG8_FILLA(V, U) do { _Pragma("unroll") for (int h_ = 0; h_ < 2; ++h_) _Pragma("unroll") for (int i_ = 0; i_ < 2; ++i_) V[h_][i_] = S.row_byte(U, h_ * HALF + rowA[i_]) + colA[i_]; } while (0)
#define PG8_LDA(dst, b, h) do { _Pragma("unroll") for (int m = 0; m < 4; ++m) _Pragma("unroll") for (int k = 0; k < 2; ++k) dst[m][k] = *(const PG8_LAS bf16x8*)(lds + PG8_SA(b, h) + aoff + m * 2048 + k * 1024); } while (0)
#define PG8_LDB(dst, b, h) do { _Pragma("unroll") for (int n = 0; n < 2; ++n) _Pragma("unroll") for (int k = 0; k < 2; ++k) dst[n][k] = *(const PG8_LAS bf16x8*)(lds + PG8_SB(b, h) + boff + n * 2048 + k * 1024); } while (0)
#define PG8_MMA(ai, bj, At, Bt) do { __builtin_amdgcn_s_setprio(1); _Pragma("unroll") for (int m = 0; m < 4; ++m) _Pragma("unroll") for (int n = 0; n < 2; ++n) _Pragma("unroll") for (int k = 0; k < 2; ++k) \
        acc[ai][bj][m][n] = __builtin_amdgcn_mfma_f32_16x16x32_bf16(Bt[n][k], At[m][k], acc[ai][bj][m][n], 0, 0, 0); __builtin_amdgcn_s_setprio(0); } while (0)
#define PG8_WAIT_V(n) asm volatile("s_waitcnt vmcnt(" #n ")" ::: "memory")
#define PG8_WAIT_L(n) asm volatile("s_waitcnt lgkmcnt(" #n ")" ::: "memory")
#define PG8_BAR __builtin_amdgcn_s_barrier()
#define PG8_SCHED __builtin_amdgcn_sched_barrier(0)
    Unit cur, nxt; int ui = 0;
    if (!S.next(0, cur)) return;
    f32x4 acc[2][2][4][2];
#pragma unroll
    for (int a = 0; a < 2; ++a)
#pragma unroll
        for (int b = 0; b < 2; ++b)
#pragma unroll
            for (int m = 0; m < 4; ++m)
#pragma unroll
                for (int n = 0; n < 2; ++n) acc[a][b][m][n] = (f32x4){0.f, 0.f, 0.f, 0.f};
    bf16x8 At[4][2], B0[2][2], B1[2][2];
    const char* A0 = (const char*)g.A; const char* cB = (const char*)g.Bt + (size_t)cur.pn * tstep;
    unsigned cv[2][2], nv[2][2];
    PG8_FILLA(cv, cur);
    S.a_ready(cur);
    if constexpr (SP2) {
        PG8_STAGE(PG8_SB(0, 0), cB, voffB); PG8_STAGE(PG8_SB(0, 1), cB + hstep, voffB); PG8_STAGE_A(PG8_SA(0, 0), 0, cv[0][0], cv[0][1]); PG8_STAGE_A(PG8_SA(0, 1), 0, cv[1][0], cv[1][1]);
        if (wr == 1) PG8_BAR;
        PG8_WAIT_V(2); PG8_BAR;
        PG8_STAGE(PG8_SB(1, 0), cB + kstep, voffB); PG8_STAGE_A(PG8_SA(1, 0), kstep, cv[0][0], cv[0][1]); PG8_STAGE(PG8_SB(1, 1), cB + hstep + kstep, voffB);
        PG8_WAIT_V(6); PG8_BAR;
    } else {
        PG8_STAGE(PG8_SB(0, 0), cB, voffB); PG8_STAGE_A(PG8_SA(0, 0), 0, cv[0][0], cv[0][1]); PG8_STAGE(PG8_SB(0, 1), cB + hstep, voffB); PG8_STAGE_A(PG8_SA(0, 1), 0, cv[1][0], cv[1][1]);
        if (wr == 1) PG8_BAR;
        PG8_WAIT_V(4); PG8_BAR;
        PG8_STAGE(PG8_SB(1, 0), cB + kstep, voffB); PG8_STAGE_A(PG8_SA(1, 0), kstep, cv[0][0], cv[0][1]); PG8_STAGE(PG8_SB(1, 1), cB + hstep + kstep, voffB);
        PG8_WAIT_V(6); PG8_BAR;
    }
    for (;;) {
        const bool has_next = S.next(ui + 1, nxt);
        const char* nB = has_next ? (const char*)g.Bt + (size_t)nxt.pn * tstep : cB;
        if (has_next && nxt.pm != cur.pm) PG8_FILLA(nv, nxt);
        else { nv[0][0] = cv[0][0]; nv[0][1] = cv[0][1]; nv[1][0] = cv[1][0]; nv[1][1] = cv[1][1]; }
        for (int t = 0; t < nt; t += 2) {
            const bool last = (t == nt - 2);
            const size_t k1 = (size_t)(t + 1) * kstep, k2 = last ? (size_t)0 : (size_t)(t + 2) * kstep; const char* b2 = last ? nB : cB + (size_t)(t + 2) * kstep;
            const unsigned w00 = last ? nv[0][0] : cv[0][0], w01 = last ? nv[0][1] : cv[0][1], w10 = last ? nv[1][0] : cv[1][0], w11 = last ? nv[1][1] : cv[1][1];
            const char* b3 = b2 + kstep;
            if (last && has_next) S.a_ready(nxt);
            if constexpr (SP2) {
            PG8_LDB(B0, 0, 0); PG8_LDB(B1, 0, 1); PG8_SCHED; PG8_LDA(At, 0, 0); PG8_STAGE_A(PG8_SA(1, 1), k1, cv[1][0], cv[1][1]);
            PG8_WAIT_V(8); PG8_WAIT_L(0); PG8_BAR; PG8_MMA(0, 0, At, B0); PG8_MMA(0, 1, At, B1); PG8_BAR; PG8_SCHED;
            PG8_LDA(At, 0, 1); PG8_STAGE(PG8_SB(0, 0), b2, voffB); PG8_STAGE(PG8_SB(0, 1), b2 + hstep, voffB); PG8_STAGE_A(PG8_SA(0, 0), k2, w00, w01);
            PG8_WAIT_V(8); PG8_WAIT_L(0); PG8_BAR; PG8_MMA(1, 0, At, B0); PG8_MMA(1, 1, At, B1); PG8_BAR; PG8_SCHED;
            PG8_LDB(B0, 1, 0); PG8_LDB(B1, 1, 1); PG8_SCHED; PG8_LDA(At, 1, 0); PG8_STAGE_A(PG8_SA(0, 1), k2, w10, w11);
            PG8_WAIT_V(8); PG8_WAIT_L(0); PG8_BAR; PG8_MMA(0, 0, At, B0); PG8_MMA(0, 1, At, B1); PG8_BAR; PG8_SCHED;
            PG8_LDA(At, 1, 1); PG8_STAGE(PG8_SB(1, 0), b3, voffB); PG8_STAGE(PG8_SB(1, 1), b3 + hstep, voffB); PG8_STAGE_A(PG8_SA(1, 0), k2 + kstep, w00, w01);
            PG8_WAIT_V(8); PG8_WAIT_L(0); PG8_BAR; PG8_MMA(1, 0, At, B0); PG8_MMA(1, 1, At, B1); PG8_BAR; PG8_SCHED;
            } else {
            PG8_LDB(B0, 0, 0); PG8_SCHED; PG8_LDA(At, 0, 0); PG8_STAGE_A(PG8_SA(1, 1), k1, cv[1][0], cv[1][1]);
            PG8_WAIT_L(8); PG8_BAR; PG8_WAIT_L(0); PG8_MMA(0, 0, At, B0); PG8_BAR; PG8_SCHED;
            PG8_LDB(B1, 0, 1); PG8_STAGE(PG8_SB(0, 0), b2, voffB);
            PG8_BAR; PG8_WAIT_L(0); PG8_MMA(0, 1, At, B1); PG8_BAR;
            PG8_LDA(At, 0, 1); PG8_STAGE_A(PG8_SA(0, 0), k2, w00, w01);
            PG8_BAR; PG8_WAIT_L(0); PG8_MMA(1, 0, At, B0); PG8_BAR; PG8_SCHED;
            PG8_STAGE(PG8_SB(0, 1), b2 + hstep, voffB);
            PG8_WAIT_V(6); PG8_BAR; PG8_MMA(1, 1, At, B1); PG8_BAR;
            PG8_LDB(B0, 1, 0); PG8_SCHED; PG8_LDA(At, 1, 0); PG8_STAGE_A(PG8_SA(0, 1), k2, w10, w11);
            PG8_WAIT_L(8); PG8_BAR; PG8_WAIT_L(0); PG8_MMA(0, 0, At, B0); PG8_BAR; PG8_SCHED;
            PG8_LDB(B1, 1, 1); PG8_STAGE(PG8_SB(1, 0), b3, voffB);
            PG8_BAR; PG8_WAIT_L(0); PG8_MMA(0, 1, At, B1); PG8_BAR;
            PG8_LDA(At, 1, 1); PG8_STAGE_A(PG8_SA(1, 0), k2 + kstep, w00, w01);
            PG8_BAR; PG8_WAIT_L(0); PG8_MMA(1, 0, At, B0); PG8_BAR; PG8_SCHED;
            PG8_STAGE(PG8_SB(1, 1), b3 + hstep, voffB);
            PG8_WAIT_V(6); PG8_BAR; PG8_MMA(1, 1, At, B1); PG8_BAR;
            }
        }
        if constexpr (ALIGN_EPI) { if (wr == 0) PG8_BAR; }
        if constexpr (!Epi::AFTER_DRAIN) { E(acc, cur, wr, wc, fr, fq); S.done(cur); }
        if (!has_next) break;
#pragma unroll
        for (int a = 0; a < 2; ++a)
#pragma unroll
            for (int b = 0; b < 2; ++b)
#pragma unroll
                for (int m = 0; m < 4; ++m)
#pragma unroll
                    for (int n = 0; n < 2; ++n) acc[a][b][m][n] = (f32x4){0.f, 0.f, 0.f, 0.f};
        cur = nxt; cB = nB; ++ui; cv[0][0] = nv[0][0]; cv[0][1] = nv[0][1]; cv[1][0] = nv[1][0]; cv[1][1] = nv[1][1];
        if constexpr (ALIGN_EPI) { if (wr == 1) PG8_BAR; }
    }
    PG8_WAIT_V(0);
    if constexpr (!ALIGN_EPI) { if (wr == 0) PG8_BAR; }
    PG8_BAR;
    if constexpr (Epi::AFTER_DRAIN) { E.fused(acc, cur, wr, wc, fr, fq, lds, wid, lane); S.done(cur); }
#undef PG8_SA
#undef PG8_SB
#undef PG8_STAGE
#undef PG8_STAGE_A
#undef PG8_FILLA
#undef PG8_LDA
#undef PG8_LDB
#undef PG8_MMA
#undef PG8_WAIT_V
#undef PG8_WAIT_L
#undef PG8_BAR
#undef PG8_SCHED
}
}

constexpr int NB = 8, SEQ = 4096, D = 1024, T = NB * SEQ, DEPTH = 2;
constexpr int INW = 3224, PW = 3328;
constexpr int FF = 2816, FFE = 3584, NEXP = 8;
constexpr int NWAVES = 8, NTHR = 512;
constexpr float NORM_EPS = 1e-6f, LOG2E = 1.4426950408889634f, QSCALE = 0.125f * 1.4426950408889634f;
constexpr int C_MQ = 0, C_MK = 256, C_MV = 512, C_MO = 768, C_FQ = 1024, C_FK = 1280, C_FV = 1536, C_SQ = 1792, C_SK = 2048, C_SV = 2304,
              C_NQ = 2560, C_KC = 2816, C_VC = 2880, C_KS = 2944, C_VS = 3008, C_KW = 3072, C_VW = 3136, C_MIF = 3200, C_FF = 3208, C_NG = 3212;
__host__ __device__ __forceinline__ int map_in_col(int c) {
    if (c < 1024) return c;
    if (c < 1792) return 1032 + (c - 1024);
    if (c < 2560) return 1804 + (c - 1792);
    if (c < 2816) return 2572 + (c - 2560);
    if (c < 3200) return 2828 + (c - 2816);
    if (c < 3208) return 1024 + (c - 3200);
    if (c < 3212) return 1800 + (c - 3208);
    if (c < 3224) return 3212 + (c - 3212);
    return -1;
}
constexpr size_t MiB = 1u << 20;
constexpr size_t WS_CTL = 0, CTL_ZERO_BYTES = 1 * MiB;
constexpr size_t WS_MODP = 1 * MiB;
constexpr size_t WS_MOD = 7 * MiB;
constexpr size_t WS_BL = 7 * MiB + 512 * 1024;
constexpr size_t WS_KCMP = 8 * MiB, WS_VCMP = 8 * MiB + 256 * 1024;
constexpr size_t WS_GB = 8 * MiB + 512 * 1024, WS_GI = 9 * MiB, WS_FLOC = 9 * MiB + 512 * 1024, WS_F2 = 10 * MiB;
constexpr size_t WS_G = 10 * MiB + 512 * 1024, WS_MLOC = WS_G + 8192, WS_MPREV = WS_G + 16384, WS_FTOT = WS_G + 24576;
constexpr size_t WS_NCH = 11 * MiB;
constexpr size_t WS_NG = 12 * MiB;
constexpr size_t WS_TOKOF = 14 * MiB, WS_TOKW = 15 * MiB;
constexpr size_t WS_ROWTOK = 16 * MiB, WS_ROWW = 16 * MiB + 512 * 1024;
constexpr size_t WS_WCT = 17 * MiB;
constexpr size_t WS_P0 = WS_BL + 4096;
constexpr size_t WS_GT = WS_BL + 8192;
constexpr size_t WS_U = 1 * MiB;
constexpr size_t WS_WIN = 18 * MiB;
constexpr size_t WS_WOUT = 31 * MiB;
constexpr size_t WS_WGU = 35 * MiB;
constexpr size_t WS_WD = 46 * MiB;
constexpr size_t WS_MWGU = 52 * MiB;
constexpr size_t WS_MWD = 164 * MiB;
constexpr size_t WS_H = 220 * MiB;
constexpr size_t WS_QKC = WS_H, WS_STATE = WS_H + 32 * MiB;
constexpr size_t WS_PROJ = 284 * MiB;
constexpr size_t WS_MIX = 492 * MiB;
constexpr size_t WS_ACT = WS_PROJ;
constexpr size_t WS_Y1 = WS_PROJ;
constexpr size_t WS_ACTE = WS_PROJ + 132 * MiB;
constexpr size_t WS_ACT2 = WS_ACTE + 112 * MiB;
constexpr size_t WS_END = 556 * MiB;
static_assert(WS_ACT2 + (size_t)8 * 256 * 3584 * 2 <= WS_END && WS_ACTE + (size_t)16384 * 3584 * 2 <= WS_ACT2 && WS_Y1 + (size_t)T * D * 2 <= WS_ACTE, "ws map");
constexpr int CHUNK_TILES = 64;
constexpr int CW_TMO = 0, CW_QUEUE = 64, CW_ECNT = 512, CW_BAR = 4096;
constexpr int LDS_BYTES = 160 * 1024, MISC_OFF = LDS_BYTES - 512;

#define GAS __attribute__((address_space(1)))
#define LAS __attribute__((address_space(3)))
#define DI __device__ __forceinline__
typedef unsigned short bf16;
typedef unsigned v4u __attribute__((ext_vector_type(4)));
typedef unsigned v2u __attribute__((ext_vector_type(2)));
typedef float f32x4 __attribute__((ext_vector_type(4)));
typedef float f32x16 __attribute__((ext_vector_type(16)));
typedef short bf16x8 __attribute__((ext_vector_type(8)));
typedef short s16x4 __attribute__((ext_vector_type(4)));
typedef GAS unsigned gu32;
#define RLX_AGENT __ATOMIC_RELAXED, __HIP_MEMORY_SCOPE_AGENT
DI float bf2f(bf16 v) { return __uint_as_float(((unsigned)v) << 16); }
DI float bflo(unsigned w) { return __uint_as_float(w << 16); }
DI float bfhi(unsigned w) { return __uint_as_float(w & 0xffff0000u); }
DI unsigned pk2(float lo, float hi) { typedef float f2_t __attribute__((ext_vector_type(2))); typedef __bf16 b2_t __attribute__((ext_vector_type(2))); f2_t v = {lo, hi}; b2_t b = __builtin_convertvector(v, b2_t); return __builtin_bit_cast(unsigned, b); }
DI bf16 f2bf(float f) { return (bf16)(pk2(f, 0.f) & 0xffffu); }
DI float ex2(float x) { return __builtin_amdgcn_exp2f(x); }
DI float lg2(float x) { return __builtin_amdgcn_logf(x); }
DI float rcp(float x) { return __builtin_amdgcn_rcpf(x); }
DI float wave_sum(float v) {
#pragma unroll
    for (int o = 1; o < 64; o <<= 1) v += __shfl_xor(v, o);
    return v;
}
DI float wave_max(float v) {
#pragma unroll
    for (int o = 1; o < 64; o <<= 1) v = fmaxf(v, __shfl_xor(v, o));
    return v;
}
DI float log_sigmoid(float x) { return fminf(x, 0.f) - 0.6931471805599453f * lg2(1.0f + ex2(-fabsf(x) * LOG2E)); }
DI float sigmoid_f(float x) { return rcp(1.0f + ex2(-x * LOG2E)); }
DI float silu(float x) { return x * sigmoid_f(x); }
#define BLOCK_SYNC() __syncthreads()
#define LDS_BARRIER() asm volatile("s_waitcnt lgkmcnt(0)\n\ts_barrier" ::: "memory")
typedef short v4i16_tr __attribute__((ext_vector_type(4)));
DI s16x4 att_trr(LAS const char* p) { return __builtin_bit_cast(s16x4, __builtin_amdgcn_ds_read_tr16_b64_v4i16((LAS v4i16_tr*)p)); }
#define XB_TMO      128
#define XB_XCNT(j)  (256  + 64 * (j))
#define XB_XSUB(j)  (1280 + 64 * (j))
#define XB_XGEN(j)  (2304 + 64 * (j))
#define XB_TOP      3328
#define XB_TOPGEN   3392
#define XCD_BAR_WORDS 3456
#define XB_SPIN_CAP (1u << 18)

__device__ __forceinline__ unsigned xb_ld(unsigned* p)              { return __hip_atomic_load(p, __ATOMIC_RELAXED, __HIP_MEMORY_SCOPE_AGENT); }
__device__ __forceinline__ unsigned xb_add(unsigned* p, unsigned v) { return __hip_atomic_fetch_add(p, v, __ATOMIC_RELAXED, __HIP_MEMORY_SCOPE_AGENT); }
__device__ __forceinline__ unsigned xb_xcc_id() { return (unsigned)__builtin_amdgcn_s_getreg((3 << 11) | 20) & 0xFu; }
#define XB_SPIN(cond, bar) do { unsigned _sp = 0; while (cond) { __builtin_amdgcn_s_sleep(1); \
    if ((++_sp & 255u) == 0u) { if (xb_ld(&(bar)[XB_TMO])) break; if (_sp > XB_SPIN_CAP) { atomicAdd(&(bar)[XB_TMO], 1u); break; } } } } while (0)

struct XcdBarrier {
    unsigned* bar; unsigned x;
    volatile LAS unsigned* st;
};

__device__ __forceinline__ XcdBarrier xcd_barrier_post(unsigned* bar, volatile LAS unsigned* st) {
    XcdBarrier b; b.bar = bar; b.x = xb_xcc_id(); b.st = st;
    if (threadIdx.x == 0) (void)xb_add(&bar[XB_XCNT(b.x)], 1u);
    return b;
}
__device__ __forceinline__ void xcd_barrier_complete(unsigned* bar, unsigned x, unsigned& nloc, unsigned& nx) {
    const unsigned G = gridDim.x * gridDim.y * gridDim.z;
    unsigned sum, cnt, mine, sp = 0u;
    for (;;) {
        sum = 0u; cnt = 0u; mine = 0u;
#pragma unroll
        for (unsigned j = 0; j < 16; ++j) { const unsigned c = xb_ld(&bar[XB_XCNT(j)]); sum += c; cnt += (c > 0u) ? 1u : 0u; mine = (j == x) ? c : mine; }
        if (sum == G) break;
        __builtin_amdgcn_s_sleep(1);
        if ((++sp & 255u) == 0u) { if (xb_ld(&bar[XB_TMO])) break; if (sp > XB_SPIN_CAP) { atomicAdd(&bar[XB_TMO], 1u); break; } }
    }
    nloc = mine > 0u ? mine : 1u; nx = cnt > 0u ? cnt : 1u;
}

__device__ __forceinline__ void xcd_barrier(const XcdBarrier& b) {
    asm volatile("s_waitcnt vmcnt(0)" ::: "memory");
    __syncthreads();
    if (threadIdx.x == 0) {
        unsigned* bar = b.bar;
        __builtin_amdgcn_s_waitcnt(0);
        unsigned nloc = b.st[0], nx = b.st[1];
        if (nloc == 0u) { xcd_barrier_complete(bar, b.x, nloc, nx); b.st[0] = nloc; b.st[1] = nx; }
        const unsigned old = xb_add(&bar[XB_XSUB(b.x)], 1u);
        const unsigned gen = old / nloc;
        if (old + 1u == (gen + 1u) * nloc) {
            __builtin_amdgcn_fence(__ATOMIC_RELEASE, "agent");
            asm volatile("s_waitcnt vmcnt(0)" ::: "memory");
            const unsigned og = xb_add(&bar[XB_TOP], 1u);
            const unsigned tg = og / nx;
            if (og + 1u == (tg + 1u) * nx) xb_add(&bar[XB_TOPGEN], 1u);
            else XB_SPIN(xb_ld(&bar[XB_TOPGEN]) == tg, bar);
            __builtin_amdgcn_fence(__ATOMIC_ACQUIRE, "agent");
            xb_add(&bar[XB_XGEN(b.x)], 1u);
            asm volatile("s_waitcnt vmcnt(0)" ::: "memory");
        } else {
            XB_SPIN(xb_ld(&bar[XB_XGEN(b.x)]) == gen, bar);
            __builtin_amdgcn_fence(__ATOMIC_ACQUIRE, "agent");
            asm volatile("s_waitcnt vmcnt(0)" ::: "memory");
        }
    }
    __syncthreads();
}

struct Ctx {
    LAS unsigned char* lds;
    volatile LAS unsigned* MISC;
    gu32* ctl;
    int tid, lane, wave, G, blk;
    float* out; unsigned char* ws;
    const void __attribute__((address_space(4)))* ka;
};
#define WSP(T_, off) ((T_*)(C.ws + (off)))
#define KIN(k) (((const float* const __attribute__((address_space(4)))*)C.ka)[k])

DI void tr_load(float (&v_)[32], const float* W, int ldw, int k0, int sc, int lane) {
    const GAS float* wp_ = (const GAS float*)(W + (size_t)(k0 + (lane >> 5)) * ldw + (sc >= 0 ? sc : 0));
#pragma unroll
    for (int i = 0; i < 32; ++i) v_[i] = wp_[(size_t)(2 * i) * ldw];
}
DI void tr_finish(const float (&v_)[32], int sc, int k0, bf16* WT, int ldt, int dstrow0, LAS float* scr, int lane) {
#pragma unroll
    for (int i = 0; i < 32; ++i) scr[(2 * i + (lane >> 5)) * 33 + (lane & 31)] = sc >= 0 ? v_[i] : 0.f;
    asm volatile("s_waitcnt lgkmcnt(0)" ::: "memory");
    const int c = lane & 7;
#pragma unroll
    for (int j = 0; j < 4; ++j) { const int n = (lane >> 3) + 8 * j; const LAS float* s = scr + (8 * c) * 33 + n;
        v4u o; o.x = pk2(s[0 * 33], s[1 * 33]); o.y = pk2(s[2 * 33], s[3 * 33]); o.z = pk2(s[4 * 33], s[5 * 33]); o.w = pk2(s[6 * 33], s[7 * 33]);
        *(GAS v4u*)(WT + (size_t)(dstrow0 + n) * ldt + k0 + 8 * c) = o; }
    asm volatile("s_waitcnt lgkmcnt(0)" ::: "memory");
}
DI void tr_item(const float* W, int ldw, int k0, int sc, bf16* WT, int ldt, int dstrow0, LAS float* scr, int lane) {
    float v_[32];
    tr_load(v_, W, ldw, k0, sc, lane);
    tr_finish(v_, sc, k0, WT, ldt, dstrow0, scr, lane);
}
DI void p_prologue(Ctx& C) {
    const int gw = C.blk * NWAVES + C.wave, NGW = C.G * NWAVES, lane = C.lane;
    LAS float* SC = (LAS float*)(C.lds + 96 * 1024);
    for (int i = C.tid; i < NB * D; i += NTHR) SC[i] = silu(KIN(1)[i]);
    BLOCK_SYNC();
    {
        float* MODP = WSP(float, WS_MODP);
        for (int it = gw; it < 2 * 96 * 16; it += NGW) {
            const int ks = it & 15, nb = (it >> 4) % 96, l = it / (16 * 96);
            const int n = nb * 64 + lane; const float* wp = KIN(3) + (size_t)l * D * 6144 + (size_t)(ks * 64) * 6144 + n;
            float acc[8];
#pragma unroll
            for (int b = 0; b < 8; ++b) acc[b] = 0.f;
#pragma unroll 16
            for (int k = 0; k < 64; ++k) { const float w = wp[(size_t)k * 6144];
#pragma unroll
                for (int b = 0; b < 8; ++b) acc[b] += SC[b * D + ks * 64 + k] * w; }
#pragma unroll
            for (int b = 0; b < 8; ++b) MODP[(((size_t)ks * 2 + l) * 8 + b) * 6144 + n] = acc[b];
        }
    }
    if (C.blk == 0 && C.tid < 129) {
        const int n = C.tid; int bucket;
        if (n < 16) bucket = n; else { const int large = 16 + (int)(logf((float)n / 16.0f) / 2.0794415416798357f * 16.0f); bucket = large < 31 ? large : 31; }
        if (n == 128) bucket = 31;
        float* BL = WSP(float, WS_BL);
#pragma unroll
        for (int h = 0; h < 4; ++h) BL[h * 132 + n] = KIN(2)[bucket * 4 + h] * LOG2E;
    }
    if (C.blk == 1 && C.tid < 128) { const int l = C.tid >> 6, d = C.tid & 63; float* gt = WSP(float, WS_GT) + l * 384 + d;
        gt[0] = KIN(13)[l * 64 + d] * QSCALE; gt[64] = KIN(14)[l * 64 + d]; gt[128] = QSCALE; gt[192] = KIN(15)[l * 64 + d] * QSCALE;
        gt[256] = KIN(16)[l * 192 + 64 + d]; gt[320] = KIN(16)[l * 192 + 128 + d]; }
    if (gw >= NGW - 4) { const int q = gw - (NGW - 4), l = q >> 1, kv = q & 1; const float* W = (kv ? KIN(19) : KIN(18)) + (size_t)l * 2048 * 64 + lane; const float* pos = KIN(17) + (size_t)l * 2048;
        float a0 = 0.f, a1 = 0.f, a2 = 0.f, a3 = 0.f;
#pragma unroll 4
        for (int i = 0; i < 2048; i += 4) { a0 += pos[i] * W[(size_t)i * 64]; a1 += pos[i + 1] * W[(size_t)(i + 1) * 64]; a2 += pos[i + 2] * W[(size_t)(i + 2) * 64]; a3 += pos[i + 3] * W[(size_t)(i + 3) * 64]; }
        WSP(float, WS_P0)[(l * 2 + kv) * 64 + lane] = (a0 + a1) + (a2 + a3); }
    LAS float* scr = (LAS float*)(C.lds + C.wave * 8448);
    constexpr int I_IN = 16 * (PW / 32), I_OUT = 16 * 32, I_GU = 16 * (2 * FF / 32), I_D = (FF / 64) * 32;
    constexpr int I_WC = 2 * 2 * 2 * 16 * 2;
    constexpr int NITEMS = 2 * I_IN + 2 * I_OUT + I_GU + I_D + I_WC;
    for (int it = gw; it < NITEMS; it += NGW) {
        int r = it;
        if (r < 2 * I_IN) { const int l = r / I_IN; r -= l * I_IN; const int nblk = PW / 32, kb = r / nblk, nb = r % nblk;
            tr_item(KIN(7) + (size_t)l * D * INW, INW, 64 * kb, map_in_col(32 * nb + (lane & 31)), WSP(bf16, WS_WIN) + (size_t)l * PW * D, D, 32 * nb, scr, lane); continue; }
        r -= 2 * I_IN;
        if (r < 2 * I_OUT) { const int l = r / I_OUT; r -= l * I_OUT; const int kb = r / 32, nb = r % 32;
            tr_item(KIN(8) + (size_t)l * D * D, D, 64 * kb, 32 * nb + (lane & 31), WSP(bf16, WS_WOUT) + (size_t)l * D * D, D, 32 * nb, scr, lane); continue; }
        r -= 2 * I_OUT;
        if (r < I_GU) { const int nblk = 2 * FF / 32, kb = r / nblk, nb = r % nblk; const int pn = nb >> 3, jb = nb & 7;
            tr_item(jb < 4 ? KIN(21) : KIN(22), FF, 64 * kb, pn * 128 + (jb & 3) * 32 + (lane & 31), WSP(bf16, WS_WGU), D, 32 * nb, scr, lane); continue; }
        r -= I_GU;
        if (r < I_D) { const int kb = r / 32, nb = r % 32;
            tr_item(KIN(23), D, 64 * kb, 32 * nb + (lane & 31), WSP(bf16, WS_WD), FF, 32 * nb, scr, lane); continue; }
        r -= I_D;
        { const int nb = r & 1, kb = (r >> 1) & 15, a = (r >> 5) & 1, kv = (r >> 6) & 1, l = r >> 7;
            tr_item((kv ? KIN(19) : KIN(18)) + (size_t)l * 2048 * 64 + (size_t)a * 1024 * 64, 64, 64 * kb, 32 * nb + (lane & 31), WSP(bf16, WS_WCT) + (size_t)(l * 2 + kv) * 128 * 1024, 1024, a * 64 + 32 * nb, scr, lane); }
    }
}
constexpr int MOE_I_MGU = 16 * (2 * FFE / 32), MOE_I_MD = (FFE / 64) * 32, MOE_CONV_ITEMS = NEXP * (MOE_I_MGU + MOE_I_MD);
struct ConvIt { const float* W; int ldw, k0, sc, ldt, dstrow0; bf16* WT; };
DI ConvIt moe_conv_decode(Ctx& C, int r) {
    const int lane = C.lane; ConvIt q;
    if (r < NEXP * MOE_I_MGU) { const int e = r / MOE_I_MGU; r -= e * MOE_I_MGU; const int nblk = 2 * FFE / 32, kb = r / nblk, nb = r % nblk; const int pn = nb >> 3, jb = nb & 7;
        q.W = (jb < 4 ? KIN(26) : KIN(27)) + (size_t)e * D * FFE; q.ldw = FFE; q.k0 = 64 * kb; q.sc = pn * 128 + (jb & 3) * 32 + (lane & 31); q.WT = WSP(bf16, WS_MWGU) + (size_t)e * 2 * FFE * D; q.ldt = D; q.dstrow0 = 32 * nb; return q; }
    r -= NEXP * MOE_I_MGU;
    { const int e = r / MOE_I_MD; r -= e * MOE_I_MD; const int kb = r / 32, nb = r % 32;
        q.W = KIN(28) + (size_t)e * FFE * D; q.ldw = D; q.k0 = 64 * kb; q.sc = 32 * nb + (lane & 31); q.WT = WSP(bf16, WS_MWD) + (size_t)e * D * FFE; q.ldt = FFE; q.dstrow0 = 32 * nb; return q; }
}
DI void moe_conv_items4(Ctx& C, int r0, LAS float* scr) {
    const ConvIt q0 = moe_conv_decode(C, r0), q1 = moe_conv_decode(C, r0 + 1), q2 = moe_conv_decode(C, r0 + 2), q3 = moe_conv_decode(C, r0 + 3);
    float v0[32], v1[32], v2[32], v3[32];
    tr_load(v0, q0.W, q0.ldw, q0.k0, q0.sc, C.lane); tr_load(v1, q1.W, q1.ldw, q1.k0, q1.sc, C.lane); tr_load(v2, q2.W, q2.ldw, q2.k0, q2.sc, C.lane); tr_load(v3, q3.W, q3.ldw, q3.k0, q3.sc, C.lane);
    tr_finish(v0, q0.sc, q0.k0, q0.WT, q0.ldt, q0.dstrow0, scr, C.lane); tr_finish(v1, q1.sc, q1.k0, q1.WT, q1.ldt, q1.dstrow0, scr, C.lane);
    tr_finish(v2, q2.sc, q2.k0, q2.WT, q2.ldt, q2.dstrow0, scr, C.lane); tr_finish(v3, q3.sc, q3.k0, q3.WT, q3.ldt, q3.dstrow0, scr, C.lane);
}
DI void p_modfin(Ctx& C) {
    const float* MODP = WSP(float, WS_MODP); float* MOD = WSP(float, WS_MOD);
    for (int i = C.blk * NTHR + C.tid; i < 2 * 8 * 6144; i += C.G * NTHR) {
        const int n = i % 6144, l = i / (8 * 6144); float s = KIN(4)[l * 6144 + n];
#pragma unroll
        for (int ks = 0; ks < 16; ++ks) s += MODP[(size_t)ks * (2 * 8 * 6144) + i];
        MOD[i] = s;
    }
}

template <bool ROUTE> DI void p_norm(Ctx& C, int l, const float* xin, const float* gain, int off_sh, int off_sc) {
    const int lane = C.lane; bf16* H = WSP(bf16, WS_H);
    const int rows_per_blk = T / C.G;
    const int m_base = C.blk * rows_per_blk, b = m_base >> 12;
    const float* MOD = WSP(float, WS_MOD) + (size_t)(l * 8 + b) * 6144;
    f32x4 gs[4], sh[4];
#pragma unroll
    for (int j = 0; j < 4; ++j) { const int c0 = 4 * lane + 256 * j; const f32x4 g = *(const f32x4*)(gain + c0), sc = *(const f32x4*)(MOD + off_sc + c0); gs[j] = g * (sc + 1.0f); sh[j] = *(const f32x4*)(MOD + off_sh + c0); }
    LAS int* cntL = (LAS int*)(C.lds);
    LAS int* baseL = (LAS int*)(C.lds + 64);
    LAS int* recE = (LAS int*)(C.lds + 1024);
    LAS int* recS = (LAS int*)(C.lds + 1024 + 2048);
    LAS float* recW = (LAS float*)(C.lds + 1024 + 4096);
    LAS float* RW = (LAS float*)(C.lds + 8192);
    if (ROUTE) { if (C.tid < 8) cntL[C.tid] = 0; for (int i = C.tid; i < D * 8 / 4; i += NTHR) *(LAS f32x4*)(RW + 4 * i) = *(const f32x4*)(KIN(24) + 4 * i); BLOCK_SYNC(); }
    f32x4 vn[4];
    { const GAS f32x4* xr0 = (const GAS f32x4*)(xin + (size_t)(m_base + C.wave) * D) + lane;
#pragma unroll
      for (int j = 0; j < 4; ++j) vn[j] = xr0[64 * j]; }
    for (int r = C.wave; r < rows_per_blk; r += NWAVES) {
        const int m = m_base + r;
        f32x4 v[4]; float s = 0.f;
#pragma unroll
        for (int j = 0; j < 4; ++j) v[j] = vn[j];
        if (r + NWAVES < rows_per_blk) { const GAS f32x4* xr1 = (const GAS f32x4*)(xin + (size_t)(m + NWAVES) * D) + lane;
#pragma unroll
            for (int j = 0; j < 4; ++j) vn[j] = xr1[64 * j]; }
#pragma unroll
        for (int j = 0; j < 4; ++j) s += (v[j].x * v[j].x + v[j].y * v[j].y) + (v[j].z * v[j].z + v[j].w * v[j].w);
        const float rstd = 1.0f / sqrtf(wave_sum(s) * (1.0f / D) + NORM_EPS);
        v2u* o8 = (v2u*)(H + (size_t)m * D) + lane;
#pragma unroll
        for (int j = 0; j < 4; ++j) { v[j] = v[j] * rstd * gs[j] + sh[j]; v2u w; w.x = pk2(v[j].x, v[j].y); w.y = pk2(v[j].z, v[j].w); o8[64 * j] = w; }
        if (ROUTE) {
            float lg[8];
#pragma unroll
            for (int e = 0; e < 8; ++e) lg[e] = 0.f;
#pragma unroll
            for (int j = 0; j < 4; ++j)
#pragma unroll
                for (int i = 0; i < 4; ++i) { const LAS float* rw = RW + (4 * lane + 256 * j + i) * 8; const f32x4 w0 = *(const LAS f32x4*)rw, w1 = *(const LAS f32x4*)(rw + 4); const float hv = v[j][i];
                    lg[0] += hv * w0.x; lg[1] += hv * w0.y; lg[2] += hv * w0.z; lg[3] += hv * w0.w; lg[4] += hv * w1.x; lg[5] += hv * w1.y; lg[6] += hv * w1.z; lg[7] += hv * w1.w; }
#pragma unroll
            for (int e = 0; e < 8; ++e) lg[e] = wave_sum(lg[e]) + KIN(25)[e];
            int e0 = 0; float l0 = lg[0];
#pragma unroll
            for (int e = 1; e < 8; ++e) if (lg[e] > l0) { l0 = lg[e]; e0 = e; }
            int e1 = -1; float l1 = -3.0e38f;
#pragma unroll
            for (int e = 0; e < 8; ++e) if (e != e0 && lg[e] > l1) { l1 = lg[e]; e1 = e; }
            const float p1 = ex2((l1 - l0) * LOG2E), w0 = 1.0f / (1.0f + p1), w1 = p1 * w0;
            if (lane == 0) { const int s0 = atomicAdd((int*)&cntL[e0], 1), s1 = atomicAdd((int*)&cntL[e1], 1);
                recE[2 * r] = e0; recE[2 * r + 1] = e1; recS[2 * r] = s0; recS[2 * r + 1] = s1; recW[2 * r] = w0; recW[2 * r + 1] = w1; }
        }
    }
    if (ROUTE) {
        BLOCK_SYNC();
        if (C.tid < 8) baseL[C.tid] = (int)__hip_atomic_fetch_add((unsigned*)(C.ctl + CW_ECNT + C.tid), (unsigned)cntL[C.tid], RLX_AGENT);
        BLOCK_SYNC();
        int* TOKOF = WSP(int, WS_TOKOF); float* TOKW = WSP(float, WS_TOKW);
        for (int i = C.tid; i < 2 * rows_per_blk; i += NTHR) { const int e = recE[i], slot = baseL[e] + recS[i], tok = m_base + (i >> 1);
            TOKOF[e * T + slot] = tok | ((i & 1) << 30); TOKW[e * T + slot] = recW[i]; }
    }
}

DI void prep_unit(Ctx& C, int l, int b, int c, int mode) {
    const int tid = C.tid, lane = C.lane, wave = C.wave;
    bf16* PROJ = WSP(bf16, WS_PROJ); bf16* QKC = WSP(bf16, WS_QKC);
    const int t0 = 64 * c; const size_t m0 = (size_t)b * SEQ + t0;
    LAS char* KWt = (LAS char*)(C.lds); LAS char* Vt = (LAS char*)(C.lds + 49152); LAS float* EW = (LAS float*)(C.lds + 98304);
    constexpr int VP = 192, VTB = 64 * 192;
    v4u xr[11], vr[4];
    { const int rg = tid >> 6, ch0 = (tid & 63) * 8;
#pragma unroll
      for (int i = 0; i < 11; ++i) { const int r = 8 * rg - 3 + i; xr[i] = (r >= 0 || c > 0) ? *(const GAS v4u*)(PROJ + (long)((long)m0 + r) * PW + ch0) : (v4u){0u, 0u, 0u, 0u}; }
#pragma unroll
      for (int hh = 0; hh < 4; ++hh) { const int r = tid >> 3, c8 = tid & 7; vr[hh] = *(const GAS v4u*)(PROJ + (m0 + r) * PW + C_MV + hh * 64 + c8 * 8); } }
    {
        const int hd = wave & 3, bh = b * 4 + hd; const size_t m = m0 + lane;
        if (wave < 4) {
            const float ig = bf2f(PROJ[m * PW + C_MIF + hd]) + KIN(10)[l * 8 + hd], fg = bf2f(PROJ[m * PW + C_MIF + 4 + hd]) + KIN(10)[l * 8 + 4 + hd];
            float bcs = log_sigmoid(fg);
#pragma unroll
            for (int o = 1; o < 64; o <<= 1) { const float t = __shfl_up(bcs, o); if (lane >= o) bcs += t; }
            const float g = __shfl(bcs, 63), w = g - bcs + ig, mloc = wave_max(w);
            EW[hd * 64 + lane] = ex2((w - mloc) * LOG2E);
            WSP(float, WS_GB)[(size_t)bh * SEQ + t0 + lane] = bcs; WSP(float, WS_GI)[(size_t)bh * SEQ + t0 + lane] = ig;
            if (lane == 0) { WSP(float, WS_G)[bh * 64 + c] = g; WSP(float, WS_MLOC)[bh * 64 + c] = mloc; }
        } else {
            const float ff = bf2f(PROJ[m * PW + C_FF + hd]) + KIN(12)[l * 4 + hd];
            float fcs = log_sigmoid(ff);
#pragma unroll
            for (int o = 1; o < 64; o <<= 1) { const float t = __shfl_up(fcs, o); if (lane >= o) fcs += t; }
            WSP(float, WS_FLOC)[(size_t)bh * SEQ + t0 + lane] = fcs;
            if (lane == 63) WSP(float, WS_FTOT)[bh * 64 + c] = fcs;
        }
    }
    LDS_BARRIER();
    {
        const int rg = tid >> 6, cp = tid & 63, ch0 = cp * 8; const float* cw = KIN(9) + (size_t)l * 4 * 512 + ch0;
        float wj[4][8];
#pragma unroll
        for (int j = 0; j < 4; ++j) { const f32x4 a = *(const f32x4*)(cw + j * 512), b4 = *(const f32x4*)(cw + j * 512 + 4); wj[j][0] = a.x; wj[j][1] = a.y; wj[j][2] = a.z; wj[j][3] = a.w; wj[j][4] = b4.x; wj[j][5] = b4.y; wj[j][6] = b4.z; wj[j][7] = b4.w; }
        const bool isk = ch0 >= 256; const int kh = (ch0 - 256) >> 6, kc = ch0 & 63;
#pragma unroll
        for (int i = 0; i < 8; ++i) { const int r = 8 * rg + i; float y[8];
#pragma unroll
            for (int e = 0; e < 8; ++e) { float acc = 0.f;
#pragma unroll
                for (int j = 0; j < 4; ++j) { const v4u xv = xr[i + 3 - j]; const unsigned wd = (e < 2) ? xv.x : (e < 4) ? xv.y : (e < 6) ? xv.z : xv.w; acc += wj[j][e] * ((e & 1) ? bfhi(wd) : bflo(wd)); }
                y[e] = silu(acc) * (isk ? 0.125f : 1.0f); }
            v4u o; o.x = pk2(y[0], y[1]); o.y = pk2(y[2], y[3]); o.z = pk2(y[4], y[5]); o.w = pk2(y[6], y[7]);
            *(GAS v4u*)(QKC + (m0 + r) * 512 + ch0) = o;
            if (isk) { const float ew = EW[kh * 64 + r]; v4u k2; k2.x = pk2(y[0] * ew, y[1] * ew); k2.y = pk2(y[2] * ew, y[3] * ew); k2.z = pk2(y[4] * ew, y[5] * ew); k2.w = pk2(y[6] * ew, y[7] * ew);
                *(LAS v4u*)(KWt + kh * VTB + r * VP + kc * 2) = k2; } }
#pragma unroll
        for (int hh = 0; hh < 4; ++hh) { const int r = tid >> 3, c8 = tid & 7; *(LAS v4u*)(Vt + hh * VTB + r * VP + c8 * 16) = vr[hh]; }
    }
    LDS_BARRIER();
    {
        const int hd = wave & 3, dvh = wave >> 2, bh = b * 4 + hd, h = lane >> 5, i16 = lane & 15, q4 = i16 >> 2, p = i16 & 3, blk = (lane >> 4) & 1;
        LAS const char* va = Vt + hd * VTB + (8 * h + q4) * VP + (32 * dvh + 16 * blk + 4 * p) * 2;
        LAS const char* kb = KWt + hd * VTB + (8 * h + q4) * VP + (16 * blk + 4 * p) * 2;
        float* ST = WSP(float, WS_STATE) + ((size_t)bh * 64 + c) * 4096;
#pragma unroll
        for (int nt = 0; nt < 2; ++nt) {
            f32x16 acc;
#pragma unroll
            for (int r = 0; r < 16; ++r) acc[r] = 0.f;
#pragma unroll
            for (int s = 0; s < 4; ++s) {
                const s16x4 alo = att_trr(va + 16 * s * VP), ahi = att_trr(va + (16 * s + 4) * VP), blo = att_trr(kb + 16 * s * VP + nt * 64), bhi = att_trr(kb + (16 * s + 4) * VP + nt * 64);
                acc = __builtin_amdgcn_mfma_f32_32x32x16_bf16(__builtin_shufflevector(alo, ahi, 0, 1, 2, 3, 4, 5, 6, 7), __builtin_shufflevector(blo, bhi, 0, 1, 2, 3, 4, 5, 6, 7), acc, 0, 0, 0);
            }
#pragma unroll
            for (int r = 0; r < 16; ++r) ST[(32 * dvh + (r & 3) + 8 * (r >> 2) + 4 * h) * 64 + 32 * nt + (lane & 31)] = acc[r];
        }
        if (tid < 256) { const int hh = tid >> 6, dk = tid & 63; float s = 0.f;
#pragma unroll 8
            for (int r = 0; r < 64; ++r) s += bf2f(*(LAS const bf16*)(KWt + hh * VTB + r * VP + dk * 2));
            WSP(float, WS_NCH)[((size_t)(b * 4 + hh) * 64 + c) * 64 + dk] = s; }
    }
    for (int i = tid; i < 64 * 12; i += NTHR) { const int r = i / 12, j = i % 12; WSP(float, WS_NG)[(m0 + r) * 16 + j] = sigmoid_f(bf2f(PROJ[(m0 + r) * PW + C_NG + j]) + KIN(20)[l * 12 + j]); }
    LDS_BARRIER();
}
DI void compress_tile(Ctx& C, int l, int wt) {
    const int lane = C.lane, h = lane >> 5, r32 = lane & 31;
    const int nt = wt & 3, mt = (wt >> 2) & 7, b = (wt >> 5) & 7, kv = wt >> 8;
    const bf16* PROJ = WSP(bf16, WS_PROJ);
    const bf16* ap = PROJ + ((size_t)b * SEQ + 16 * (mt * 32 + r32)) * PW + (kv ? C_VC : C_KC) + 8 * h;
    const bf16* bp = WSP(bf16, WS_WCT) + ((size_t)(l * 2 + kv) * 128 + nt * 32 + r32) * 1024 + 8 * h;
    f32x16 acc;
#pragma unroll
    for (int r = 0; r < 16; ++r) acc[r] = 0.f;
#pragma unroll 4
    for (int ks = 0; ks < 64; ++ks) {
        const bf16x8 a = *(const bf16x8*)(ap + (size_t)(ks >> 2) * PW + 16 * (ks & 3)), bb = *(const bf16x8*)(bp + 16 * ks);
        acc = __builtin_amdgcn_mfma_f32_32x32x16_bf16(a, bb, acc, 0, 0, 0);
    }
    float* U = WSP(float, WS_U) + (((size_t)kv * 8 + b) * 256 + mt * 32) * 128 + nt * 32 + r32;
#pragma unroll
    for (int r = 0; r < 16; ++r) U[(size_t)((r & 3) + 8 * (r >> 2) + 4 * h) * 128] = acc[r];
}
DI void p_prep(Ctx& C, int l, int mode) {
    { const int gw = C.blk * NWAVES + C.wave; if (gw < 512) compress_tile(C, l, gw); }
    for (int u = C.blk; u < NB * 64; u += C.G) prep_unit(C, l, u >> 6, u & 63, mode);
}

DI void p_scan(Ctx& C, int l, bool dry) {
    { const int gw = C.blk * NWAVES + C.wave, NGW = C.G * NWAVES, lane = C.lane; const float* U = WSP(float, WS_U); const float* P0 = WSP(float, WS_P0) + l * 128;
      for (int it = gw; it < 8 * 256; it += NGW) { const int b = it >> 8, n = it & 255; float kx = 0.f, vx = 0.f;
          if (n < 255) { const float* u0 = U + ((size_t)b * 256 + n) * 128; const float* u1 = U + ((size_t)(8 + b) * 256 + n) * 128;
              kx = u0[lane] + u0[128 + 64 + lane] + P0[lane]; vx = u1[lane] + u1[128 + 64 + lane] + P0[64 + lane];
              const float ss = wave_sum(kx * kx); kx = kx / sqrtf(ss * (1.0f / 64.0f) + NORM_EPS) * KIN(16)[l * 192 + lane]; }
          if (!dry) { WSP(bf16, WS_KCMP)[((size_t)b * 256 + n) * 64 + lane] = f2bf(kx); WSP(bf16, WS_VCMP)[((size_t)b * 256 + n) * 64 + lane] = f2bf(vx); } } }
    const int gid = C.blk * NTHR + C.tid;
    for (int g = gid; g < 32 * 4096; g += C.G * NTHR) {
        const int bh = g >> 12, e = g & 4095;
        const float* Gp = WSP(float, WS_G) + bh * 64; const float* ML = WSP(float, WS_MLOC) + bh * 64;
        float* ST = WSP(float, WS_STATE) + (size_t)bh * 64 * 4096 + e; float* NC = WSP(float, WS_NCH) + (size_t)bh * 64 * 64 + e;
        float Cst = 0.f, nst = 0.f, m = 0.f;
        float cc[64];
#pragma unroll
        for (int c = 0; c < 64; ++c) cc[c] = *(const GAS float*)(ST + (size_t)c * 4096);
        const float gq = Gp[C.lane], mq = ML[C.lane];
#pragma unroll
        for (int c = 0; c < 64; ++c) {
            const float nc = (e < 64) ? *(const GAS float*)(NC + c * 64) : 0.f;
            if (!dry) { ST[(size_t)c * 4096] = Cst; if (e < 64) NC[c * 64] = nst;
                if (e == 0) WSP(float, WS_MPREV)[bh * 64 + c] = m; }
            const float gc = __shfl(gq, c), ml = __shfl(mq, c), mn = fmaxf(gc + m, ml), a = ex2((gc + m - mn) * LOG2E), bb = ex2((ml - mn) * LOG2E);
            Cst = a * Cst + bb * cc[c]; nst = a * nst + bb * nc; m = mn;
        }
        { const float* FT = WSP(float, WS_FTOT) + bh * 64; const int ch = e >> 6; const float off = wave_sum((C.lane < ch) ? FT[C.lane] : 0.f);
          const float f2v = (WSP(float, WS_FLOC)[g] + off) * LOG2E; if (!dry) WSP(float, WS_F2)[g] = f2v; else if (f2v == 123.456f) WSP(float, WS_F2)[g] = Cst + nst; }
    }
}

namespace att {
constexpr int KP = 144, VP = 192;
constexpr int KT = 64 * KP, VT = 64 * VP;
constexpr int L_K0 = 0, L_V0 = 3 * KT, L_F = 3 * KT + 3 * VT  , L_BL = L_F + 512, L_IMP = 67584, L_TOT = L_IMP + 65536, L_SEL = L_TOT + 16384, L_FLAG = L_SEL + 512, L_EL = L_FLAG + 64  , L_BL2 = L_EL + 4 * 320 * 4  , L_NST = L_BL2 + 4 * 132 * 4  , L_END = L_NST + 64;
static_assert(L_BL + 4 * 132 * 4 <= L_IMP && L_END <= MISC_OFF, "attention LDS map");
typedef short v4i16_t __attribute__((ext_vector_type(4)));
#define MFMA32(a, b, c) __builtin_amdgcn_mfma_f32_32x32x16_bf16((a), (b), (c), 0, 0, 0)
DI int crow(int r, int h) { return (r & 3) + 8 * (r >> 2) + 4 * h; }
DI s16x4 trr(LAS const char* p) { return __builtin_bit_cast(s16x4, __builtin_amdgcn_ds_read_tr16_b64_v4i16((LAS v4i16_t*)p)); }
struct Stg { v4u k, v; };
DI void stage_load(Stg& s, const bf16* Kg, const bf16* Vg, int ld, int tid) { const int row = tid >> 3, ch = tid & 7; s.k = *(const GAS v4u*)(Kg + (size_t)row * ld + ch * 8); s.v = *(const GAS v4u*)(Vg + (size_t)row * ld + ch * 8); }
DI void stage_store(const Stg& s, LAS char* Kt, LAS char* Vt, int tid) { const int row = tid >> 3, ch = tid & 7; *(LAS v4u*)(Kt + row * KP + ch * 16) = s.k; *(LAS v4u*)(Vt + row * VP + ch * 16) = s.v; }
DI void qkt(f32x16& p0, f32x16& p1, LAS const char* Kt, const bf16x8 (&qf)[4], int lane) {
    LAS const char* kb = Kt + (lane & 31) * KP + (lane >> 5) * 16;
#pragma unroll
    for (int d0 = 0; d0 < 4; ++d0) {
        const bf16x8 a0 = *(LAS const bf16x8*)(kb + d0 * 32), a1 = *(LAS const bf16x8*)(kb + 32 * KP + d0 * 32);
        p0 = MFMA32(a0, qf[d0], p0); p1 = MFMA32(a1, qf[d0], p1);
    }
}
DI bf16x8 pack8(const f32x16& p, int b) { v4u w; w.x = pk2(p[b], p[b + 1]); w.y = pk2(p[b + 2], p[b + 3]); w.z = pk2(p[b + 4], p[b + 5]); w.w = pk2(p[b + 6], p[b + 7]); return __builtin_bit_cast(bf16x8, w); }
DI void pv_packed(f32x16 (&o)[2], LAS const char* Vt, const bf16x8 (&pb)[4], int lane) {
    const int h = lane >> 5, i16 = lane & 15, q4 = i16 >> 2, p = i16 & 3, blk = (lane >> 4) & 1;
    LAS const char* vb = Vt + (4 * h + q4) * VP + (16 * blk + 4 * p) * 2;
#pragma unroll
    for (int hf = 0; hf < 2; ++hf) {
        s16x4 lo[4], hi[4];
#pragma unroll
        for (int i = 0; i < 4; ++i) { const int s = 2 * hf + (i >> 1), dh = i & 1; lo[i] = trr(vb + (16 * s) * VP + dh * 64); hi[i] = trr(vb + (16 * s + 8) * VP + dh * 64); }
        __builtin_amdgcn_sched_barrier(0);
#pragma unroll
        for (int i = 0; i < 4; ++i) { const int s = 2 * hf + (i >> 1), dh = i & 1;
            o[dh] = MFMA32(__builtin_shufflevector(lo[i], hi[i], 0, 1, 2, 3, 4, 5, 6, 7), pb[s], o[dh]); }
    }
}
DI void pack_p(bf16x8 (&pb)[4], const f32x16& p0, const f32x16& p1) { pb[0] = pack8(p0, 0); pb[1] = pack8(p0, 8); pb[2] = pack8(p1, 0); pb[3] = pack8(p1, 8); }
DI void pv(f32x16 (&o)[2], LAS const char* Vt, const f32x16& p0, const f32x16& p1, int lane) { bf16x8 pb[4]; pack_p(pb, p0, p1); pv_packed(o, Vt, pb, lane); }
DI float half_max(float v) { return fmaxf(v, __shfl_xor(v, 32)); }
DI float half_sum(float v) { return v + __shfl_xor(v, 32); }
template <bool MASKED> DI void osm(f32x16& p0, f32x16& p1, float& m_run, float& lsum, f32x16 (&o)[2]) {
    float tm = -1e30f;
#pragma unroll
    for (int r = 0; r < 16; ++r) tm = fmaxf(tm, fmaxf(p0[r], p1[r]));
    tm = half_max(tm);
    const float mn = fmaxf(m_run, tm);
    if (__any(mn > m_run)) {
        const float f = ex2(m_run - mn); m_run = mn; lsum *= f;
#pragma unroll
        for (int r = 0; r < 16; ++r) { o[0][r] *= f; o[1][r] *= f; }
    }
    float ps = 0.f;
#pragma unroll
    for (int r = 0; r < 16; ++r) { float a = ex2(p0[r] - mn), b = ex2(p1[r] - mn); if (MASKED) { a = p0[r] > -1e29f ? a : 0.f; b = p1[r] > -1e29f ? b : 0.f; } p0[r] = a; p1[r] = b; ps += a + b; }
    lsum += ps;
}
DI void osm_fast(f32x16& p0, f32x16& p1, float cb, bool active, float& m_run, float& lsum, f32x16 (&o)[2]) {
    float t0 = fmaxf(p0[0], p1[0]), t1 = fmaxf(p0[1], p1[1]);
#pragma unroll
    for (int r = 2; r < 16; r += 2) { t0 = fmaxf(t0, fmaxf(p0[r], p1[r])); t1 = fmaxf(t1, fmaxf(p0[r + 1], p1[r + 1])); }
    float tm = active ? fmaxf(t0, t1) + cb : -1e30f;
    tm = half_max(tm);
    const float mn = fmaxf(m_run, tm);
    if (__any(mn > m_run)) {
        const float f = ex2(m_run - mn); m_run = mn; lsum *= f;
#pragma unroll
        for (int r = 0; r < 16; ++r) { o[0][r] *= f; o[1][r] *= f; }
    }
    const float e = active ? mn - cb : 1e30f;
    float ps0 = 0.f, ps1 = 0.f;
#pragma unroll
    for (int r = 0; r < 16; ++r) { const float a = ex2(p0[r] - e), b = ex2(p1[r] - e); p0[r] = a; p1[r] = b; ps0 += a; ps1 += b; }
    lsum += ps0 + ps1;
}
DI void store_o(bf16* orow, const f32x16 (&o)[2], float sc, int h) {
#pragma unroll
    for (int dh = 0; dh < 2; ++dh)
#pragma unroll
        for (int g = 0; g < 4; ++g) { v2u w; w.x = pk2(o[dh][4 * g] * sc, o[dh][4 * g + 1] * sc); w.y = pk2(o[dh][4 * g + 2] * sc, o[dh][4 * g + 3] * sc); *(v2u*)(orow + 32 * dh + 8 * g + 4 * h) = w; }
}

DI void fox_tile(LAS const char* Kt, LAS const char* Vt, const LAS float* fk, const bf16x8 (&qf)[4], int key0, bool diag, int tq, float f2q, float& m_run, float& lsum, f32x16 (&o)[2], int lane) {
    const int h = lane >> 5;
    f32x16 p0, p1;
#pragma unroll
    for (int r = 0; r < 16; ++r) { p0[r] = 0.f; p1[r] = 0.f; }
    qkt(p0, p1, Kt, qf, lane);
    if (diag) {
#pragma unroll
        for (int g = 0; g < 4; ++g) { const f32x4 fa = *(const LAS f32x4*)(fk + 8 * g + 4 * h), fb = *(const LAS f32x4*)(fk + 32 + 8 * g + 4 * h);
#pragma unroll
            for (int i = 0; i < 4; ++i) { const int r = 4 * g + i, ka = key0 + 8 * g + 4 * h + i; float sa = p0[r] + (f2q - fa[i]), sb = p1[r] + (f2q - fb[i]);
                if (ka > tq) sa = -1e30f; if (ka + 32 > tq) sb = -1e30f; p0[r] = sa; p1[r] = sb; } }
        osm<true>(p0, p1, m_run, lsum, o);
    } else {
#pragma unroll
        for (int g = 0; g < 4; ++g) { const f32x4 fa = *(const LAS f32x4*)(fk + 8 * g + 4 * h), fb = *(const LAS f32x4*)(fk + 32 + 8 * g + 4 * h);
#pragma unroll
            for (int i = 0; i < 4; ++i) { p0[4 * g + i] -= fa[i]; p1[4 * g + i] -= fb[i]; } }
        osm_fast(p0, p1, f2q, true, m_run, lsum, o);
    }
    pv(o, Vt, p0, p1, lane);
}
DI void fox_tile_s(LAS const char* Kt, LAS const char* Vt, const LAS float* fk, const bf16x8 (&qf)[4], int key0, bool diag, int tq, const f32x16& cq, float& lsum, f32x16 (&o)[2], int lane) {
    const int h = lane >> 5;
    f32x16 p0 = cq, p1 = cq;
    qkt(p0, p1, Kt, qf, lane);
    float ps0 = 0.f, ps1 = 0.f;
    if (diag) {
#pragma unroll
        for (int g = 0; g < 4; ++g) { const f32x4 fa = *(const LAS f32x4*)(fk + 8 * g + 4 * h), fb = *(const LAS f32x4*)(fk + 32 + 8 * g + 4 * h);
#pragma unroll
            for (int i = 0; i < 4; ++i) { const int r = 4 * g + i, ka = key0 + 8 * g + 4 * h + i; float sa = p0[r] - fa[i], sb = p1[r] - fb[i];
                if (ka > tq) sa = -1e30f; if (ka + 32 > tq) sb = -1e30f; const float a = ex2(sa), b = ex2(sb); p0[r] = a; p1[r] = b; ps0 += a; ps1 += b; } }
    } else {
#pragma unroll
        for (int g = 0; g < 4; ++g) { const f32x4 fa = *(const LAS f32x4*)(fk + 8 * g + 4 * h), fb = *(const LAS f32x4*)(fk + 32 + 8 * g + 4 * h);
#pragma unroll
            for (int i = 0; i < 4; ++i) { const int r = 4 * g + i; const float a = ex2(p0[r] - fa[i]), b = ex2(p1[r] - fb[i]); p0[r] = a; p1[r] = b; ps0 += a; ps1 += b; } }
    }
    lsum += ps0 + ps1;
    pv(o, Vt, p0, p1, lane);
}
constexpr int RING = 5, L_KR = 0, L_VR = RING * KT, L_FR = RING * (KT + VT);
static_assert(L_FR + RING * 256 <= L_FLAG, "ring LDS map");
DI void fox_unit(Ctx& C, int l, int b, int hd, int qb) {
    const int tid = C.tid, lane = C.lane, w = C.wave, r32 = lane & 31, h = lane >> 5;
    const bf16* PROJ = WSP(bf16, WS_PROJ); const size_t m0 = (size_t)b * SEQ;
    const bf16* Kg = PROJ + m0 * PW + C_FK + hd * 64; const bf16* Vg = PROJ + m0 * PW + C_FV + hd * 64;
    const float* F2 = WSP(float, WS_F2) + (size_t)(b * 4 + hd) * SEQ;
    LAS char* lds = (LAS char*)C.lds; LAS float* Fr = (LAS float*)(lds + L_FR); volatile LAS int* flag = (volatile LAS int*)(lds + L_FLAG);
    const int tq = 256 * qb + 32 * w + r32;
    bf16x8 qf[4];
    { const bf16* qp = PROJ + (m0 + tq) * PW + C_FQ + hd * 64 + 8 * h;
#pragma unroll
      for (int d0 = 0; d0 < 4; ++d0) qf[d0] = *(const bf16x8*)(qp + 16 * d0); }
    const float f2q = F2[tq];
    const float sbound = ((const LAS float*)(lds + L_NST))[4];
    float lsum = 0.f; f32x16 o[2]; f32x16 cq;
#pragma unroll
    for (int r = 0; r < 16; ++r) { o[0][r] = 0.f; o[1][r] = 0.f; cq[r] = f2q; }
    const int j0 = 4 * qb, jd = j0 + (w >> 1);
#define FOX_LD(S_, F_, j_) do { stage_load(S_, Kg + (size_t)(j_) * 64 * PW, Vg + (size_t)(j_) * 64 * PW, PW, tid); if (tid < 64) F_ = *(const GAS float*)(F2 + (j_) * 64 + tid); } while (0)
#define FOX_ST(S_, F_, j_) do { stage_store(S_, lds + L_KR + ((j_) % RING) * KT, lds + L_VR + ((j_) % RING) * VT, tid); if (tid < 64) Fr[((j_) % RING) * 64 + tid] = F_; } while (0)
    Stg sA, sB; float fA = 0.f, fB = 0.f;
    { Stg s0, s1, s2, s3; float f0 = 0.f, f1 = 0.f, f2 = 0.f, f3 = 0.f; FOX_LD(s0, f0, j0 + 3); FOX_LD(s1, f1, j0 + 2); FOX_LD(s2, f2, j0 + 1); FOX_LD(s3, f3, j0);
      if (j0 - 1 >= 0) FOX_LD(sA, fA, j0 - 1);
      if (j0 - 2 >= 0) FOX_LD(sB, fB, j0 - 2);
      FOX_ST(s0, f0, j0 + 3); FOX_ST(s1, f1, j0 + 2); FOX_ST(s2, f2, j0 + 1); FOX_ST(s3, f3, j0); }
    if (tid < 16) flag[tid] = 0;
    LDS_BARRIER();
#define FOX_STEP(s_, DIAG_, SX_, FX_) { const int t_ = jd - (s_); bool done = true; \
        if (t_ >= 0) { LAS const char* kt_ = lds + L_KR + (t_ % RING) * KT; LAS const char* vt_ = lds + L_VR + (t_ % RING) * VT; const LAS float* ft_ = Fr + (t_ % RING) * 64; asm volatile("" : "+v"(kt_), "+v"(vt_), "+v"(ft_)); \
            fox_tile_s(kt_, vt_, ft_, qf, 64 * t_, DIAG_, tq, cq, lsum, o, lane); \
            if (t_ > 0) { const float fl = *(const GAS float*)(F2 + 64 * t_ - 1); done = __all(sbound + f2q - fl + 40.0f < lg2(lsum)); } } \
        if (lane == 0) flag[((s_) & 1) * 8 + w] = done ? 1 : 0; \
        if (j0 - (s_) - 1 >= 0) FOX_ST(SX_, FX_, j0 - (s_) - 1); \
        LDS_BARRIER(); \
        int alld = 1; _Pragma("unroll") for (int i = 0; i < 8; ++i) alld &= flag[((s_) & 1) * 8 + i]; \
        if (alld) break; \
        if (j0 - (s_) - 3 >= 0) FOX_LD(SX_, FX_, j0 - (s_) - 3); }
    for (int s = 0; ; s += 2) {
        if (s == 0) FOX_STEP(0, true, sA, fA) else FOX_STEP(s, false, sA, fA)
        FOX_STEP(s + 1, false, sB, fB)
    }
#undef FOX_LD
#undef FOX_ST
#undef FOX_STEP
    LDS_BARRIER();
    lsum = half_sum(lsum);
    { int tq2 = tq; asm volatile("" : "+v"(tq2)); store_o(WSP(bf16, WS_MIX) + (m0 + tq2) * 1024 + 256 + hd * 64, o, 1.0f / lsum, h); }
}

DI void fox_unit_safe(Ctx& C, int l, int b, int hd, int qb) {
    const int tid = C.tid, lane = C.lane, w = C.wave, r32 = lane & 31, h = lane >> 5;
    const bf16* PROJ = WSP(bf16, WS_PROJ); const size_t m0 = (size_t)b * SEQ;
    const bf16* Kg = PROJ + m0 * PW + C_FK + hd * 64; const bf16* Vg = PROJ + m0 * PW + C_FV + hd * 64;
    const float* F2 = WSP(float, WS_F2) + (size_t)(b * 4 + hd) * SEQ;
    LAS char* lds = (LAS char*)C.lds; LAS float* Ft = (LAS float*)(lds + L_F);
    const int tq = 256 * qb + 32 * w + r32;
    bf16x8 qf[4];
    { const bf16* qp = PROJ + (m0 + tq) * PW + C_FQ + hd * 64 + 8 * h;
#pragma unroll
      for (int d0 = 0; d0 < 4; ++d0) qf[d0] = *(const bf16x8*)(qp + 16 * d0); }
    const float f2q = F2[tq];
    float m_run = -1e30f, lsum = 0.f; f32x16 o[2];
#pragma unroll
    for (int r = 0; r < 16; ++r) { o[0][r] = 0.f; o[1][r] = 0.f; }
    const int jtop = 4 * qb + 3, jd = 4 * qb + (w >> 1);
    for (int j = jtop; j >= 0; --j) {
        Stg st; stage_load(st, Kg + (size_t)j * 64 * PW, Vg + (size_t)j * 64 * PW, PW, tid); float fv = 0.f; if (tid < 64) fv = F2[j * 64 + tid];
        stage_store(st, lds + L_K0, lds + L_V0, tid); if (tid < 64) Ft[tid] = fv;
        LDS_BARRIER();
        if (j <= jd) fox_tile(lds + L_K0, lds + L_V0, Ft, qf, 64 * j, j == jd, tq, f2q, m_run, lsum, o, lane);
        LDS_BARRIER();
    }
    lsum = half_sum(lsum);
    store_o(WSP(bf16, WS_MIX) + (m0 + tq) * 1024 + 256 + hd * 64, o, 1.0f / lsum, h);
}

constexpr float SB_CUT = -48.0f;
template <bool diag> DI void sb_tile(LAS const char* Kt, LAS const char* Vt, const bf16x8 (&qf)[4], int key0, int tq, float& R2, f32x16 (&o)[2], int lane) {
    const int h = lane >> 5;
    f32x16 p0, p1;
#pragma unroll
    for (int r = 0; r < 16; ++r) { p0[r] = 0.f; p1[r] = 0.f; }
    qkt(p0, p1, Kt, qf, lane);
    float sp[2][16], gs[8];
#pragma unroll
    for (int pi = 0; pi < 2; ++pi)
#pragma unroll
        for (int r = 0; r < 16; ++r) { const float z = pi ? p1[r] : p0[r]; float s = fmaxf(z, 0.f) + lg2(1.0f + ex2(-fabsf(z)));
            if (diag && (key0 + 32 * pi + crow(r, h) >= tq)) s = 0.f; sp[pi][r] = s; }
#pragma unroll
    for (int k = 0; k < 8; ++k) { const int pi = k >> 2, c4 = k & 3; gs[k] = (sp[pi][4 * c4] + sp[pi][4 * c4 + 1]) + (sp[pi][4 * c4 + 2] + sp[pi][4 * c4 + 3]); }
    float Tk[8]; float run = 0.f;
    float og[8];
#pragma unroll
    for (int k = 0; k < 8; ++k) og[k] = __shfl_xor(gs[k], 32);
#pragma unroll
    for (int k = 7; k >= 0; --k) { Tk[k] = run; run += gs[k] + og[k]; }
#pragma unroll
    for (int pi = 0; pi < 2; ++pi)
#pragma unroll
        for (int c4 = 0; c4 < 4; ++c4) { const int k = 4 * pi + c4; const float later = Tk[k] + (h == 0 ? og[k] : 0.f);
            const float s1 = sp[pi][4 * c4 + 1], s2 = sp[pi][4 * c4 + 2], s3 = sp[pi][4 * c4 + 3];
            const float e3 = later, e2 = later + s3, e1 = e2 + s2, e0 = e1 + s1;
            const float ee[4] = {e0, e1, e2, e3};
#pragma unroll
            for (int i = 0; i < 4; ++i) { const int r = 4 * c4 + i; const float z = pi ? p1[r] : p0[r]; const bool msk = diag && (key0 + 32 * pi + crow(r, h) >= tq);
                const float a = msk ? 0.f : ex2(z - sp[pi][r] + R2 - ee[i]); if (pi) p1[r] = a; else p0[r] = a; } }
    R2 -= run;
    pv(o, Vt, p0, p1, lane);
}
DI void sb_unit(Ctx& C, int b, int hd, int qb) {
    const int tid = C.tid, lane = C.lane, w = C.wave, r32 = lane & 31, h = lane >> 5;
    const bf16* PROJ = WSP(bf16, WS_PROJ); const size_t m0 = (size_t)b * SEQ;
    const bf16* Kg = PROJ + m0 * PW + C_SK + hd * 64; const bf16* Vg = PROJ + m0 * PW + C_SV + hd * 64;
    LAS char* lds = (LAS char*)C.lds; volatile LAS int* flag = (volatile LAS int*)(lds + L_FLAG);
    const int tq = 256 * qb + 32 * w + r32;
    bf16x8 qf[4];
    { const bf16* qp = PROJ + (m0 + tq) * PW + C_SQ + hd * 64 + 8 * h;
#pragma unroll
      for (int d0 = 0; d0 < 4; ++d0) qf[d0] = *(const bf16x8*)(qp + 16 * d0); }
    float R2 = 0.f; f32x16 o[2];
#pragma unroll
    for (int r = 0; r < 16; ++r) { o[0][r] = 0.f; o[1][r] = 0.f; }
    const int j0 = 4 * qb, jd = j0 + (w >> 1);
#define SB_LD(S_, j_) stage_load(S_, Kg + (size_t)(j_) * 64 * PW, Vg + (size_t)(j_) * 64 * PW, PW, tid)
#define SB_ST(S_, j_) stage_store(S_, lds + L_KR + ((j_) % RING) * KT, lds + L_VR + ((j_) % RING) * VT, tid)
    Stg sA, sB;
    { Stg s0, s1, s2, s3; SB_LD(s0, j0 + 3); SB_LD(s1, j0 + 2); SB_LD(s2, j0 + 1); SB_LD(s3, j0);
      if (j0 - 1 >= 0) SB_LD(sA, j0 - 1);
      if (j0 - 2 >= 0) SB_LD(sB, j0 - 2);
      SB_ST(s0, j0 + 3); SB_ST(s1, j0 + 2); SB_ST(s2, j0 + 1); SB_ST(s3, j0); }
    if (tid < 16) flag[tid] = 0;
    LDS_BARRIER();
#define SB_STEP(s_, DIAG_, SX_) { const int t_ = jd - (s_); bool done = true; \
        if (t_ >= 0) { done = __all(R2 < SB_CUT); if (!done) { LAS const char* kt_ = lds + L_KR + (t_ % RING) * KT; LAS const char* vt_ = lds + L_VR + (t_ % RING) * VT; asm volatile("" : "+v"(kt_), "+v"(vt_));   \
            sb_tile<DIAG_>(kt_, vt_, qf, 64 * t_, tq, R2, o, lane); done = __all(R2 < SB_CUT); } } \
        if (lane == 0) flag[((s_) & 1) * 8 + w] = done ? 1 : 0; \
        if (j0 - (s_) - 1 >= 0) SB_ST(SX_, j0 - (s_) - 1); \
        LDS_BARRIER(); \
        int alld = 1; _Pragma("unroll") for (int i = 0; i < 8; ++i) alld &= flag[((s_) & 1) * 8 + i]; \
        if (alld) break; \
        if (j0 - (s_) - 3 >= 0) SB_LD(SX_, j0 - (s_) - 3); }
    for (int s = 0; ; s += 2) {
        if (s == 0) SB_STEP(0, true, sA) else SB_STEP(s, false, sA)
        SB_STEP(s + 1, false, sB)
    }
#undef SB_LD
#undef SB_ST
#undef SB_STEP
    LDS_BARRIER();
    { int tq2 = tq; asm volatile("" : "+v"(tq2));
      store_o(WSP(bf16, WS_MIX) + (m0 + tq2) * 1024 + 512 + hd * 64, o, 1.0f, h); }
}
}

namespace att {
template <int MODE> DI void nsa_tile(LAS const char* Kt, LAS const char* Vt, const bf16x8 (&qf)[4], int j, int t, int c, bool active, const LAS float* el, float bfar, float& m_run, float& lsum, f32x16 (&o)[2], int lane, int dry) {
    const int h = lane >> 5;
    f32x16 p0, p1;
#pragma unroll
    for (int r = 0; r < 16; ++r) { p0[r] = 0.f; p1[r] = 0.f; }
    qkt(p0, p1, Kt, qf, lane);
    if (j >= c - 2) {
        const int bd = t - 64 * j - 4 * h; const LAS float* eb = el + (255 - bd); const int bde = active ? bd : -1;
        float bv0[16], bv1[16];
#pragma unroll
        for (int r = 0; r < 16; ++r) { bv0[r] = eb[8 * (r >> 2) + (r & 3)]; bv1[r] = eb[32 + 8 * (r >> 2) + (r & 3)]; }
#pragma unroll
        for (int r = 0; r < 16; ++r) { asm volatile("" : "+v"(bv0[r])); asm volatile("" : "+v"(bv1[r])); }
#pragma unroll
        for (int r = 0; r < 16; ++r) { const int kc = 8 * (r >> 2) + (r & 3);
            p0[r] = (kc <= bde) ? p0[r] + bv0[r] : -1e30f; p1[r] = (kc + 32 <= bde) ? p1[r] + bv1[r] : -1e30f; }
        osm<true>(p0, p1, m_run, lsum, o);
    } else if (MODE == 1 && j == c - 8) {
        const int bd = t - 64 * j - 4 * h - 512;
#pragma unroll
        for (int pi = 0; pi < 2; ++pi)
#pragma unroll
            for (int r = 0; r < 16; ++r) { const int kc = 32 * pi + 8 * (r >> 2) + (r & 3); const bool valid = kc > bd;
                const float s = valid ? (pi ? p1[r] : p0[r]) + bfar : -1e30f; if (pi) p1[r] = s; else p0[r] = s; }
        osm<true>(p0, p1, m_run, lsum, o);
    } else {
        if (!(dry & 16)) osm_fast(p0, p1, bfar, active, m_run, lsum, o);
    }
    if (!(dry & 8)) pv(o, Vt, p0, p1, lane);
}
template <int MODE> DI void nsa_branch(Ctx& C, const bf16* Kg, const bf16* Vg, int j_lo, int j_hi, const bf16* qp, int t, int c, unsigned sel_lo, unsigned sel_hi,
                                       const LAS float* bl, float gate, LAS float* RES, bf16* orow, int dry) {
    const int tid = C.tid, lane = C.lane, h = lane >> 5; LAS char* lds = (LAS char*)C.lds;
    bf16x8 qf[4];
    asm volatile("" : "+v"(qp));
#pragma unroll
    for (int d0 = 0; d0 < 4; ++d0) qf[d0] = *(const bf16x8*)(qp + 16 * d0);
    float m_run = -1e30f, lsum = 0.f; f32x16 o[2];
#pragma unroll
    for (int r = 0; r < 16; ++r) { o[0][r] = 0.f; o[1][r] = 0.f; }
    const float bfar = bl[128]; const LAS float* el = (const LAS float*)(lds + L_EL) + (bl - (const LAS float*)(lds + L_BL2)) / 132 * 320;
    Stg sA, sB;
#define NB_LD(S_, j_) stage_load(S_, Kg + (size_t)(j_) * 64 * PW, Vg + (size_t)(j_) * 64 * PW, PW, tid)
#define NB_ST(S_, buf_) stage_store(S_, lds + L_K0 + (buf_) * KT, lds + L_V0 + (buf_) * VT, tid)
#define NB_ACT(j_) ((MODE == 1) ? true : ((((j_) < 32 ? (sel_lo >> (j_)) : (sel_hi >> ((j_) - 32))) & 1u) != 0u))
    NB_LD(sA, j_lo); NB_ST(sA, 0); if (j_lo + 1 <= j_hi) NB_LD(sB, j_lo + 1);
    LDS_BARRIER();
    for (int j = j_lo; j <= j_hi; j += 2) {
        if (j + 2 <= j_hi && !(dry & 32)) NB_LD(sA, j + 2);
        { const bool act = NB_ACT(j); if (__any(act) && !(dry & 64)) nsa_tile<MODE>(lds + L_K0, lds + L_V0, qf, j, t, c, act, el, bfar, m_run, lsum, o, lane, dry); }
        if (j + 1 <= j_hi && !(dry & 32)) NB_ST(sB, 1);
        LDS_BARRIER();
        if (j + 1 > j_hi) break;
        if (j + 3 <= j_hi && !(dry & 32)) NB_LD(sB, j + 3);
        { const bool act = NB_ACT(j + 1); if (__any(act) && !(dry & 64)) nsa_tile<MODE>(lds + L_K0 + KT, lds + L_V0 + VT, qf, j + 1, t, c, act, el, bfar, m_run, lsum, o, lane, dry); }
        if (j + 2 <= j_hi && !(dry & 32)) NB_ST(sA, 0);
        LDS_BARRIER();
    }
#undef NB_LD
#undef NB_ST
#undef NB_ACT
    lsum = half_sum(lsum); const float sc = lsum > 0.f ? gate / lsum : 0.f;
#pragma unroll
    for (int dh = 0; dh < 2; ++dh)
#pragma unroll
        for (int r = 0; r < 16; ++r) { const float v = RES[(dh * 16 + r) * 64 + lane] + o[dh][r] * sc; if (MODE == 1) o[dh][r] = v; else RES[(dh * 16 + r) * 64 + lane] = v; }
    if (MODE == 1 && orow) store_o(orow, o, 1.0f, h);
}
DI void nsa_selwin(Ctx& C, const bf16* Ks, const bf16* Vs, const bf16* Kw, const bf16* Vw, const bf16* qp, int t, int c, unsigned sel_lo, unsigned sel_hi,
                   const LAS float* bl, float g_sel, float g_win, LAS float* RES, bf16* orow, int dry) {
    const int tid = C.tid, lane = C.lane, h = lane >> 5; LAS char* lds = (LAS char*)C.lds;
    bf16x8 qf[4];
    asm volatile("" : "+v"(qp));
#pragma unroll
    for (int d0 = 0; d0 < 4; ++d0) qf[d0] = *(const bf16x8*)(qp + 16 * d0);
    float m_run = -1e30f, lsum = 0.f; f32x16 o[2];
#pragma unroll
    for (int r = 0; r < 16; ++r) { o[0][r] = 0.f; o[1][r] = 0.f; }
    const float bfar = bl[128]; const LAS float* el = (const LAS float*)(lds + L_EL) + (bl - (const LAS float*)(lds + L_BL2)) / 132 * 320;
    const int nsel = c + 1, jw0 = c >= 8 ? c - 8 : 0, ntot = nsel + (c - jw0 + 1);
    Stg sA, sB;
#define SW_J(v_) ((v_) < nsel ? (v_) : jw0 + ((v_) - nsel))
#define SW_LD(S_, v_) do { const int j_ = SW_J(v_); if ((v_) < nsel) stage_load(S_, Ks + (size_t)j_ * 64 * PW, Vs + (size_t)j_ * 64 * PW, PW, tid); else stage_load(S_, Kw + (size_t)j_ * 64 * PW, Vw + (size_t)j_ * 64 * PW, PW, tid); } while (0)
#define SW_ST(S_, buf_) stage_store(S_, lds + L_K0 + (buf_) * KT, lds + L_V0 + (buf_) * VT, tid)
#define SW_CLOSE() do { lsum = half_sum(lsum); const float sc_ = lsum > 0.f ? g_sel / lsum : 0.f; \
        _Pragma("unroll") for (int dh = 0; dh < 2; ++dh) _Pragma("unroll") for (int r = 0; r < 16; ++r) { RES[(dh * 16 + r) * 64 + lane] += o[dh][r] * sc_; o[dh][r] = 0.f; } \
        m_run = -1e30f; lsum = 0.f; } while (0)
#define SW_TILE(v_, buf_) do { const int j_ = SW_J(v_); \
        if ((v_) == nsel) SW_CLOSE(); \
        if ((v_) < nsel) { const bool act = (((j_ < 32 ? (sel_lo >> j_) : (sel_hi >> (j_ - 32))) & 1u) != 0u); if (__any(act)) nsa_tile<0>(lds + L_K0 + (buf_) * KT, lds + L_V0 + (buf_) * VT, qf, j_, t, c, act, el, bfar, m_run, lsum, o, lane, dry); } \
        else nsa_tile<1>(lds + L_K0 + (buf_) * KT, lds + L_V0 + (buf_) * VT, qf, j_, t, c, true, el, bfar, m_run, lsum, o, lane, dry); } while (0)
    SW_LD(sA, 0); SW_ST(sA, 0); SW_LD(sB, 1);
    LDS_BARRIER();
    for (int v = 0; v < ntot; v += 2) {
        if (v + 2 < ntot) SW_LD(sA, v + 2);
        SW_TILE(v, 0);
        if (v + 1 < ntot) SW_ST(sB, 1);
        LDS_BARRIER();
        if (v + 1 >= ntot) break;
        if (v + 3 < ntot) SW_LD(sB, v + 3);
        SW_TILE(v + 1, 1);
        if (v + 2 < ntot) SW_ST(sA, 0);
        LDS_BARRIER();
    }
#undef SW_J
#undef SW_LD
#undef SW_ST
#undef SW_CLOSE
#undef SW_TILE
    lsum = half_sum(lsum); const float sc = lsum > 0.f ? g_win / lsum : 0.f;
#pragma unroll
    for (int dh = 0; dh < 2; ++dh)
#pragma unroll
        for (int r = 0; r < 16; ++r) o[dh][r] = RES[(dh * 16 + r) * 64 + lane] + o[dh][r] * sc;
    if (orow) store_o(orow, o, 1.0f, h);
}
template <int MODE> DI void nsa_tile_s(LAS const char* Kt, LAS const char* Vt, const bf16x8 (&qf)[4], int j, int t, int c, bool active, const LAS float* el, float& lsum, f32x16 (&o)[2], int lane, int dry) {
    const int h = lane >> 5;
    f32x16 p0, p1;
#pragma unroll
    for (int r = 0; r < 16; ++r) { p0[r] = 0.f; p1[r] = 0.f; }
    LAS const char* kb = Kt + (lane & 31) * KP + h * 16;
    const int i16 = lane & 15, q4 = i16 >> 2, pp = i16 & 3, blk = (lane >> 4) & 1;
    LAS const char* vb = Vt + (4 * h + q4) * VP + (16 * blk + 4 * pp) * 2;
    bf16x8 ka[4], kc2[4]; s16x4 lo[8], hi[8];
#pragma unroll
    for (int d0 = 0; d0 < 4; ++d0) { if (dry & 64) { ka[d0] = qf[d0]; kc2[d0] = qf[d0]; } else { ka[d0] = *(LAS const bf16x8*)(kb + d0 * 32); kc2[d0] = *(LAS const bf16x8*)(kb + 32 * KP + d0 * 32); } }
#pragma unroll
    for (int i = 0; i < 4; ++i) { const int s = i >> 1, dh = i & 1; if (dry & 128) { lo[i] = s16x4{0,0,0,0}; hi[i] = lo[i]; } else { lo[i] = trr(vb + (16 * s) * VP + dh * 64); hi[i] = trr(vb + (16 * s + 8) * VP + dh * 64); } }
    __builtin_amdgcn_sched_barrier(0);
    if (!(dry & 8)) {
#pragma unroll
        for (int d0 = 0; d0 < 4; ++d0) { p0 = MFMA32(ka[d0], qf[d0], p0); p1 = MFMA32(kc2[d0], qf[d0], p1); } }
#pragma unroll
    for (int i = 4; i < 8; ++i) { const int s = i >> 1, dh = i & 1; if (dry & 128) { lo[i] = s16x4{0,0,0,0}; hi[i] = lo[i]; } else { lo[i] = trr(vb + (16 * s) * VP + dh * 64); hi[i] = trr(vb + (16 * s + 8) * VP + dh * 64); } }
    __builtin_amdgcn_sched_barrier(0);
    bf16x8 pb[4];
    float ps0 = 0.f, ps1 = 0.f;
    if (j >= c - 2 && !(dry & 256)) {
        const int bd = t - 64 * j - 4 * h; const LAS float* eb = el + (255 - bd); const int bde = active ? bd : -1;
        float bv0[16], bv1[16];
#pragma unroll
        for (int r = 0; r < 16; ++r) { bv0[r] = eb[8 * (r >> 2) + (r & 3)]; bv1[r] = eb[32 + 8 * (r >> 2) + (r & 3)]; }
#pragma unroll
        for (int r = 0; r < 16; ++r) { asm volatile("" : "+v"(bv0[r])); asm volatile("" : "+v"(bv1[r])); }
#pragma unroll
        for (int r = 0; r < 16; ++r) { const int kc = 8 * (r >> 2) + (r & 3);
            const float a = ex2((kc <= bde) ? p0[r] + bv0[r] : -1e30f), b = ex2((kc + 32 <= bde) ? p1[r] + bv1[r] : -1e30f); p0[r] = a; p1[r] = b; ps0 += a; ps1 += b; }
        pack_p(pb, p0, p1);
    } else if (MODE == 1 && j == c - 8 && !(dry & 256)) {
        const int bd = t - 64 * j - 4 * h - 512;
#pragma unroll
        for (int r = 0; r < 16; ++r) { const int kc = 8 * (r >> 2) + (r & 3);
            const float a = ex2((kc > bd) ? p0[r] : -1e30f), b = ex2((kc + 32 > bd) ? p1[r] : -1e30f); p0[r] = a; p1[r] = b; ps0 += a; ps1 += b; }
        pack_p(pb, p0, p1);
    } else {
        if (!(dry & 2)) {
#pragma unroll
        for (int r = 0; r < 16; ++r) { const float a = ex2(p0[r]), b = ex2(p1[r]); p0[r] = a; p1[r] = b; ps0 += a; ps1 += b; } }
        if (dry & 512) { pb[0] = qf[0]; pb[1] = qf[1]; pb[2] = qf[2]; pb[3] = qf[3]; } else pack_p(pb, p0, p1);
        if (MODE == 0 && !(dry & 512)) {
#pragma unroll
            for (int i = 0; i < 4; ++i) { v4u w = __builtin_bit_cast(v4u, pb[i]); w.x = active ? w.x : 0u; w.y = active ? w.y : 0u; w.z = active ? w.z : 0u; w.w = active ? w.w : 0u; pb[i] = __builtin_bit_cast(bf16x8, w); }
            ps0 = active ? ps0 : 0.f; ps1 = active ? ps1 : 0.f;
        }
    }
    lsum += ps0 + ps1;
    __builtin_amdgcn_sched_barrier(0);
    if (!(dry & 4)) {
#pragma unroll
        for (int i = 0; i < 8; ++i) { const int s = i >> 1, dh = i & 1; o[dh] = MFMA32(__builtin_shufflevector(lo[i], hi[i], 0, 1, 2, 3, 4, 5, 6, 7), pb[s], o[dh]); } }
}
DI void nsa_selwin_s(Ctx& C, const bf16* Ks, const bf16* Vs, const bf16* Kw, const bf16* Vw, const bf16* qp, int t, int c, unsigned sel_lo, unsigned sel_hi,
                     const LAS float* bl, float g_sel, float g_win, LAS float* RES, bf16* orow, int dry) {
    const int tid = C.tid, lane = C.lane, h = lane >> 5; LAS char* lds = (LAS char*)C.lds;
    bf16x8 qf[4];
    asm volatile("" : "+v"(qp));
#pragma unroll
    for (int d0 = 0; d0 < 4; ++d0) qf[d0] = *(const bf16x8*)(qp + 16 * d0);
    float lsum = 0.f; f32x16 o[2];
#pragma unroll
    for (int r = 0; r < 16; ++r) { o[0][r] = 0.f; o[1][r] = 0.f; }
    const float fbf = ex2(bl[128]); const LAS float* el = (const LAS float*)(lds + L_EL) + (bl - (const LAS float*)(lds + L_BL2)) / 132 * 320;
    const int nsel = c + 1, jw0 = c >= 8 ? c - 8 : 0, ntot = nsel + (c - jw0 + 1);
    Stg sA, sB;
#define SW_J(v_) ((v_) < nsel ? (v_) : jw0 + ((v_) - nsel))
#define SW_LD(S_, v_) do { const int j_ = SW_J(v_); if ((v_) < nsel) stage_load(S_, Ks + (size_t)j_ * 64 * PW, Vs + (size_t)j_ * 64 * PW, PW, tid); else stage_load(S_, Kw + (size_t)j_ * 64 * PW, Vw + (size_t)j_ * 64 * PW, PW, tid); } while (0)
#define SW_ST(S_, buf_) stage_store(S_, lds + L_K0 + (buf_) * KT, lds + L_V0 + (buf_) * VT, tid)
#define SW_CLOSE() do { lsum = half_sum(lsum); const float sc_ = lsum > 0.f ? g_sel / lsum : 0.f; \
        _Pragma("unroll") for (int dh = 0; dh < 2; ++dh) _Pragma("unroll") for (int r = 0; r < 16; ++r) { RES[(dh * 16 + r) * 64 + lane] += o[dh][r] * sc_; o[dh][r] = 0.f; } \
        lsum = 0.f; } while (0)
#define SW_TILE(v_, buf_) do { const int j_ = SW_J(v_); \
        if ((v_) == nsel) SW_CLOSE(); \
        if (j_ == c - 2) { lsum *= fbf; _Pragma("unroll") for (int r = 0; r < 16; ++r) { o[0][r] *= fbf; o[1][r] *= fbf; } } \
        if ((v_) < nsel) { const bool act = (((j_ < 32 ? (sel_lo >> j_) : (sel_hi >> (j_ - 32))) & 1u) != 0u); if (!(dry & 16)) nsa_tile_s<0>(lds + L_K0 + (buf_) * KT, lds + L_V0 + (buf_) * VT, qf, j_, t, c, act, el, lsum, o, lane, dry); } \
        else if (!(dry & 16)) nsa_tile_s<1>(lds + L_K0 + (buf_) * KT, lds + L_V0 + (buf_) * VT, qf, j_, t, c, true, el, lsum, o, lane, dry); } while (0)
    SW_LD(sA, 0); SW_ST(sA, 0); SW_LD(sB, 1);
    LDS_BARRIER();
    for (int v = 0; v < ntot; v += 2) {
        if (v + 2 < ntot && !(dry & 32)) SW_LD(sA, v + 2);
        SW_TILE(v, 0);
        if (v + 1 < ntot && !(dry & 32)) SW_ST(sB, 1);
        LDS_BARRIER();
        if (v + 1 >= ntot) break;
        if (v + 3 < ntot && !(dry & 32)) SW_LD(sB, v + 3);
        SW_TILE(v + 1, 1);
        if (v + 2 < ntot && !(dry & 32)) SW_ST(sA, 0);
        LDS_BARRIER();
    }
#undef SW_J
#undef SW_LD
#undef SW_ST
#undef SW_CLOSE
#undef SW_TILE
    lsum = half_sum(lsum); const float sc = lsum > 0.f ? g_win / lsum : 0.f;
#pragma unroll
    for (int dh = 0; dh < 2; ++dh)
#pragma unroll
        for (int r = 0; r < 16; ++r) o[dh][r] = RES[(dh * 16 + r) * 64 + lane] + o[dh][r] * sc;
    if (orow) store_o(orow, o, 1.0f, h);
}
DI void nsa_unit(Ctx& C, int b, int c, int dry) {
    const int tid = C.tid, lane = C.lane, w = C.wave, r32 = lane & 31, h = lane >> 5, hd = w & 3, th = w >> 2;
    const bf16* PROJ = WSP(bf16, WS_PROJ); const size_t m0 = (size_t)b * SEQ;
    LAS char* lds = (LAS char*)C.lds; LAS float* BLl = (LAS float*)(lds + L_BL2); LAS float* IMP = (LAS float*)(lds + L_IMP); LAS float* TOT = (LAS float*)(lds + L_TOT); LAS unsigned* SEL = (LAS unsigned*)(lds + L_SEL);
    const int tl = 32 * th + r32, t = 64 * c + tl;
    bf16x8 qf[4];
    { const bf16* qp = PROJ + (m0 + t) * PW + C_NQ + hd * 64 + 8 * h;
#pragma unroll
      for (int d0 = 0; d0 < 4; ++d0) qf[d0] = *(const bf16x8*)(qp + 16 * d0); }
    const float g0 = WSP(float, WS_NG)[(m0 + t) * 16 + hd * 3];
    const LAS float* bl = BLl + hd * 132;
    f32x16 res[2];
#pragma unroll
    for (int r = 0; r < 16; ++r) { res[0][r] = 0.f; res[1][r] = 0.f; }
    LAS float* MREF = (LAS float*)(lds);
    LAS float* MFIN = (LAS float*)(lds + 4096);
    if (!(dry & 1)) {
        const bf16* Kc = WSP(bf16, WS_KCMP) + (size_t)b * 256 * 64; const bf16* Vc = WSP(bf16, WS_VCMP) + (size_t)b * 256 * 64;
        const int ntc = (4 * c + 2) / 64 + 1, nlim = (t >= 31) ? ((t - 31) >> 4) : -1;
        float m_run = -1e30f, lsum = 0.f, carry = 0.f, mref0 = 0.f, mref1 = 0.f, mref2 = 0.f, mref3 = 0.f; f32x16 o[2];
#pragma unroll
        for (int r = 0; r < 16; ++r) { o[0][r] = 0.f; o[1][r] = 0.f; }
        const float bfar_c = bl[128];
        Stg st; stage_load(st, Kc, Vc, 64, tid); stage_store(st, lds + L_K0, lds + L_V0, tid);
        LDS_BARRIER();
        for (int nt = 0; nt < ntc; ++nt) {
            const int cur = nt & 1;
            if (nt + 1 < ntc) stage_load(st, Kc + (size_t)(nt + 1) * 64 * 64, Vc + (size_t)(nt + 1) * 64 * 64, 64, tid);
            f32x16 p0, p1;
#pragma unroll
            for (int r = 0; r < 16; ++r) { p0[r] = 0.f; p1[r] = 0.f; }
            qkt(p0, p1, lds + L_K0 + cur * KT, qf, lane);
            float tm = -1e30f;
            const bool allfar = c >= 16 * nt + 19;
            if (allfar) {
                float t0 = fmaxf(p0[0], p1[0]), t1 = fmaxf(p0[1], p1[1]);
#pragma unroll
                for (int r = 2; r < 16; r += 2) { t0 = fmaxf(t0, fmaxf(p0[r], p1[r])); t1 = fmaxf(t1, fmaxf(p0[r + 1], p1[r + 1])); }
                tm = fmaxf(t0, t1) + bfar_c;
            } else {
#pragma unroll
            for (int pi = 0; pi < 2; ++pi)
#pragma unroll
                for (int r = 0; r < 16; ++r) { const int n = 64 * nt + 32 * pi + crow(r, h), dist = t - 16 * n - 31; const bool valid = n <= nlim;
                    const int idx = dist < 0 ? 0 : (dist > 128 ? 128 : dist);
                    float bvv = bl[idx]; asm volatile("" : "+v"(bvv));
                    const float s = valid ? (pi ? p1[r] : p0[r]) + bvv : -1e30f; if (pi) p1[r] = s; else p0[r] = s; tm = fmaxf(tm, s); if ((r & 7) == 7) __builtin_amdgcn_sched_barrier(0); }
            }
            tm = half_max(tm); const float mn = fmaxf(m_run, tm), f = ex2(m_run - mn);
            m_run = mn; lsum *= f; carry *= f;
#pragma unroll
            for (int r = 0; r < 16; ++r) { o[0][r] *= f; o[1][r] *= f; }
            float ps = 0.f;
            if (allfar) { const float e = mn - bfar_c;
#pragma unroll
                for (int r = 0; r < 16; ++r) { p0[r] = ex2(p0[r] - e); p1[r] = ex2(p1[r] - e); ps += p0[r] + p1[r]; }
            } else {
#pragma unroll
            for (int r = 0; r < 16; ++r) { p0[r] = p0[r] > -1e29f ? ex2(p0[r] - mn) : 0.f; p1[r] = p1[r] > -1e29f ? ex2(p1[r] - mn) : 0.f; ps += p0[r] + p1[r]; }
            }
            lsum += ps;
            if (nt == 0) mref0 = mn; else if (nt == 1) mref1 = mn; else if (nt == 2) mref2 = mn; else mref3 = mn;
            float A[8], Bp[8], ob[8];
#pragma unroll
            for (int k = 0; k < 8; ++k) { const int pi = k >> 2, c4 = k & 3; const float x0 = pi ? p1[4 * c4] : p0[4 * c4], x1 = pi ? p1[4 * c4 + 1] : p0[4 * c4 + 1], x2 = pi ? p1[4 * c4 + 2] : p0[4 * c4 + 2], x3 = pi ? p1[4 * c4 + 3] : p0[4 * c4 + 3];
                Bp[k] = 0.5f * x3; A[k] = (x0 + x1) + (x2 + Bp[k]); }
#pragma unroll
            for (int k = 0; k < 8; ++k) ob[k] = __shfl_xor(Bp[k], 32);
            LAS float* ip = IMP + (hd * 64 + tl) * 64 + 16 * nt + h;
#pragma unroll
            for (int k = 0; k < 8; ++k) { const float add = (h == 1) ? ob[k] : (k == 0 ? carry : ob[k > 0 ? k - 1 : 0]); ip[2 * k] = A[k] + add; }
            carry = ob[7];
            pv(o, lds + L_V0 + cur * VT, p0, p1, lane);
            if (nt + 1 < ntc) stage_store(st, lds + L_K0 + (cur ^ 1) * KT, lds + L_V0 + (cur ^ 1) * VT, tid);
            LDS_BARRIER();
        }
        lsum = half_sum(lsum); const float inv = lsum > 0.f ? 1.0f / lsum : 0.f;
        if (h == 0) { LAS float* mr = MREF + (hd * 64 + tl) * 4; mr[0] = mref0; mr[1] = mref1; mr[2] = mref2; mr[3] = mref3; MFIN[(hd * 64 + tl) * 2] = m_run; MFIN[(hd * 64 + tl) * 2 + 1] = inv; }
#pragma unroll
        for (int r = 0; r < 16; ++r) { res[0][r] += o[0][r] * (g0 * inv); res[1][r] += o[1][r] * (g0 * inv); }
        LDS_BARRIER();
    }
    if (dry & 1) { if (tid < 128) SEL[tid] = 0xffffffffu; LDS_BARRIER(); } else {
        const int tok = tid >> 3, sub = tid & 7;
        float wsc[4][4];
#pragma unroll
        for (int hh = 0; hh < 4; ++hh) { const float mf = MFIN[(hh * 64 + tok) * 2], il = MFIN[(hh * 64 + tok) * 2 + 1];
#pragma unroll
            for (int q = 0; q < 4; ++q) wsc[hh][q] = ex2(MREF[(hh * 64 + tok) * 4 + q] - mf) * il; }
#pragma unroll
        for (int i = 0; i < 8; ++i) { const int j = sub * 8 + i; float sc;
            if (j == 0 || j == c || j == c - 1) sc = 1e30f * (1.0f - (float)j * 1e-6f); else if (j <= c) sc = ((IMP[(0 * 64 + tok) * 64 + j] * wsc[0][j >> 4] + IMP[(1 * 64 + tok) * 64 + j] * wsc[1][j >> 4]) + IMP[(2 * 64 + tok) * 64 + j] * wsc[2][j >> 4]) + IMP[(3 * 64 + tok) * 64 + j] * wsc[3][j >> 4]; else sc = -1e30f * (1.0f + (float)j * 1e-6f);
            TOT[tok * 64 + j] = sc; }
        LDS_BARRIER();
        float sj[8]; int rk[8];
        { const f32x4 a = *(const LAS f32x4*)(TOT + tok * 64 + sub * 8), b4 = *(const LAS f32x4*)(TOT + tok * 64 + sub * 8 + 4); sj[0] = a.x; sj[1] = a.y; sj[2] = a.z; sj[3] = a.w; sj[4] = b4.x; sj[5] = b4.y; sj[6] = b4.z; sj[7] = b4.w; }
#pragma unroll
        for (int i = 0; i < 8; ++i) rk[i] = 0;
#pragma unroll
        for (int k4 = 0; k4 < 16; ++k4) { const f32x4 v = *(const LAS f32x4*)(TOT + tok * 64 + 4 * k4);
#pragma unroll
            for (int i = 0; i < 8; ++i) rk[i] += (v.x > sj[i] ? 1 : 0) + (v.y > sj[i] ? 1 : 0) + (v.z > sj[i] ? 1 : 0) + (v.w > sj[i] ? 1 : 0); }
        unsigned mlo = 0u, mhi = 0u;
#pragma unroll
        for (int i = 0; i < 8; ++i) { const int j = sub * 8 + i; if (rk[i] < 16) { if (j < 32) mlo |= 1u << j; else mhi |= 1u << (j - 32); } }
        mlo |= __shfl_xor(mlo, 1); mlo |= __shfl_xor(mlo, 2); mlo |= __shfl_xor(mlo, 4);
        mhi |= __shfl_xor(mhi, 1); mhi |= __shfl_xor(mhi, 2); mhi |= __shfl_xor(mhi, 4);
        if (sub == 0) { SEL[tok * 2] = mlo; SEL[tok * 2 + 1] = mhi; }
        LDS_BARRIER();
    }
    const unsigned sel_lo = SEL[tl * 2], sel_hi = SEL[tl * 2 + 1];
    LAS float* RES = IMP + w * 2048;
#pragma unroll
    for (int dh = 0; dh < 2; ++dh)
#pragma unroll
        for (int r = 0; r < 16; ++r) RES[(dh * 16 + r) * 64 + lane] = res[dh][r];
    const bf16* qp2 = PROJ + (m0 + t) * PW + C_NQ + hd * 64 + 8 * h;
    const float* ng2 = WSP(float, WS_NG) + (m0 + t) * 16 + hd * 3;
    {
        const bool stat = NSA_STATIC && __builtin_amdgcn_readfirstlane((int)(((const LAS float*)(lds + L_NST))[hd] <= 100.0f));
        bf16* orow = dry ? (bf16*)nullptr : WSP(bf16, WS_MIX) + (m0 + t) * 1024 + 768 + hd * 64;
        if (stat) nsa_selwin_s(C, PROJ + m0 * PW + C_KS, PROJ + m0 * PW + C_VS, PROJ + m0 * PW + C_KW, PROJ + m0 * PW + C_VW, qp2, t, c, sel_lo, sel_hi, bl, ng2[1], ng2[2], RES, orow, dry);
        else nsa_selwin(C, PROJ + m0 * PW + C_KS, PROJ + m0 * PW + C_VS, PROJ + m0 * PW + C_KW, PROJ + m0 * PW + C_VW, qp2, t, c, sel_lo, sel_hi, bl, ng2[1], ng2[2], RES, orow, 0);
    }
    LDS_BARRIER();
}
}

DI void mlstm_out_unit(Ctx& C, int l, int b, int c) {
    using namespace att;
    const int tid = C.tid, lane = C.lane, w = C.wave, r32 = lane & 31, h = lane >> 5, hd = w & 3, lh = w >> 2;
    const bf16* PROJ = WSP(bf16, WS_PROJ); const bf16* QKC = WSP(bf16, WS_QKC);
    const int t0 = 64 * c; const size_t m0 = (size_t)b * SEQ + t0; const int bh = b * 4 + hd;
    LAS char* lds = (LAS char*)C.lds; LAS char* Kt = lds; LAS char* Vt = lds + 4 * KT; LAS char* Ct = lds + 4 * KT + 4 * VT;
    LAS float* vb = (LAS float*)(lds + 122880); LAS float* vi = (LAS float*)(lds + 123904); LAS float* vn = (LAS float*)(lds + 124928);
    { const int row = tid >> 3, ch = tid & 7;
#pragma unroll
      for (int hh = 0; hh < 4; ++hh) {
          *(LAS v4u*)(Kt + hh * KT + row * KP + ch * 16) = *(const v4u*)(QKC + (m0 + row) * 512 + 256 + hh * 64 + ch * 8);
          *(LAS v4u*)(Vt + hh * VT + row * VP + ch * 16) = *(const v4u*)(PROJ + (m0 + row) * PW + C_MV + hh * 64 + ch * 8);
          const float* cp = WSP(float, WS_STATE) + ((size_t)(b * 4 + hh) * 64 + c) * 4096 + row * 64 + ch * 8; const f32x4 c0 = *(const f32x4*)cp, c1 = *(const f32x4*)(cp + 4);
          v4u pc; pc.x = pk2(c0.x, c0.y); pc.y = pk2(c0.z, c0.w); pc.z = pk2(c1.x, c1.y); pc.w = pk2(c1.z, c1.w);
          *(LAS v4u*)(Ct + hh * KT + row * KP + ch * 16) = pc; }
      if (tid < 256) { const int hh = tid >> 6, i = tid & 63, bh2 = b * 4 + hh; vb[tid] = WSP(float, WS_GB)[(size_t)bh2 * SEQ + t0 + i]; vi[tid] = WSP(float, WS_GI)[(size_t)bh2 * SEQ + t0 + i]; vn[tid] = WSP(float, WS_NCH)[((size_t)bh2 * 64 + c) * 64 + i]; } }
    const int lq = 32 * lh + r32; const size_t m = m0 + lq;
    bf16x8 qf[4];
    { const bf16* qp = QKC + m * 512 + hd * 64 + 8 * h;
#pragma unroll
      for (int d0 = 0; d0 < 4; ++d0) qf[d0] = *(const bf16x8*)(qp + 16 * d0); }
    const float mprev = WSP(float, WS_MPREV)[bh * 64 + c];
    LDS_BARRIER();
    const float b_l = vb[hd * 64 + lq];
    f32x16 p0, p1;
#pragma unroll
    for (int r = 0; r < 16; ++r) { p0[r] = 0.f; p1[r] = 0.f; }
    qkt(p0, p1, Kt + hd * KT, qf, lane);
    float dl0[16], dl1[16]; float dmax = -1e30f;
#pragma unroll
    for (int g = 0; g < 4; ++g) { const f32x4 ba = *(const LAS f32x4*)(vb + hd * 64 + 8 * g + 4 * h), bb = *(const LAS f32x4*)(vb + hd * 64 + 32 + 8 * g + 4 * h), ia = *(const LAS f32x4*)(vi + hd * 64 + 8 * g + 4 * h), ib = *(const LAS f32x4*)(vi + hd * 64 + 32 + 8 * g + 4 * h);
#pragma unroll
        for (int i = 0; i < 4; ++i) { const int r = 4 * g + i, s = 8 * g + 4 * h + i; const float da = (s <= lq) ? b_l - ba[i] + ia[i] : -1e30f, db = (s + 32 <= lq) ? b_l - bb[i] + ib[i] : -1e30f; dl0[r] = da; dl1[r] = db; dmax = fmaxf(dmax, fmaxf(da, db)); } }
    dmax = half_max(dmax);
    const float m_inter = b_l + mprev, m_t = fmaxf(dmax, m_inter), inter_w = ex2((m_inter - m_t) * LOG2E);
    float dsum = 0.f;
#pragma unroll
    for (int r = 0; r < 16; ++r) { const float wa = dl0[r] > -1e29f ? ex2((dl0[r] - m_t) * LOG2E) : 0.f, wb = dl1[r] > -1e29f ? ex2((dl1[r] - m_t) * LOG2E) : 0.f; p0[r] *= wa; p1[r] *= wb; dsum += p0[r] + p1[r]; }
    dsum = half_sum(dsum);
    float nq = 0.f;
#pragma unroll
    for (int d0 = 0; d0 < 4; ++d0)
#pragma unroll
        for (int j = 0; j < 8; ++j) nq += bf2f((bf16)qf[d0][j]) * vn[hd * 64 + 16 * d0 + 8 * h + j];
    nq = half_sum(nq);
    const float den = dsum + inter_w * nq, dinv = 1.0f / fmaxf(fabsf(den), ex2(-m_t * LOG2E));
    f32x16 o[2];
#pragma unroll
    for (int r = 0; r < 16; ++r) { o[0][r] = 0.f; o[1][r] = 0.f; }
    qkt(o[0], o[1], Ct + hd * KT, qf, lane);
#pragma unroll
    for (int r = 0; r < 16; ++r) { o[0][r] *= inter_w; o[1][r] *= inter_w; }
    pv(o, Vt + hd * VT, p0, p1, lane);
    float ss = 0.f;
#pragma unroll
    for (int r = 0; r < 16; ++r) { o[0][r] *= dinv; o[1][r] *= dinv; ss += o[0][r] * o[0][r] + o[1][r] * o[1][r]; }
    ss = half_sum(ss);
    const float rs = 1.0f / sqrtf(ss * (1.0f / 64.0f) + NORM_EPS);
    const bf16* op = PROJ + m * PW + C_MO + hd * 64; const float* og = KIN(11) + l * 256 + hd * 64; bf16* orow = WSP(bf16, WS_MIX) + m * 1024 + hd * 64;
#pragma unroll
    for (int dh = 0; dh < 2; ++dh)
#pragma unroll
        for (int g = 0; g < 4; ++g) { const int d = 32 * dh + 8 * g + 4 * h; const v2u ow = *(const v2u*)(op + d); const f32x4 gg = *(const f32x4*)(og + d);
            const float y0 = o[dh][4 * g] * rs * gg.x * sigmoid_f(bflo(ow.x)), y1 = o[dh][4 * g + 1] * rs * gg.y * sigmoid_f(bfhi(ow.x)), y2 = o[dh][4 * g + 2] * rs * gg.z * sigmoid_f(bflo(ow.y)), y3 = o[dh][4 * g + 3] * rs * gg.w * sigmoid_f(bfhi(ow.y));
            v2u pw; pw.x = pk2(y0, y1); pw.y = pk2(y2, y3); *(v2u*)(orow + d) = pw; }
    LDS_BARRIER();
}

DI void p_mix(Ctx& C0, int l, int rp) {
    volatile LAS unsigned* bc = C0.MISC + 4;
    {
      const float* BLg = (const float*)(C0.ws + WS_BL); LAS float* BLl = (LAS float*)(C0.lds + att::L_BL2); LAS float* ELl = (LAS float*)(C0.lds + att::L_EL);
      for (int i = C0.tid; i < 4 * 132; i += NTHR) BLl[i] = BLg[i];
      for (int i = C0.tid; i < 4 * 320; i += NTHR) { const int hh = i / 320, dist = 255 - (i % 320); ELl[i] = dist >= 128 ? BLg[hh * 132 + 128] : (dist >= 0 ? BLg[hh * 132 + dist] : 0.f); }
      if (C0.wave == 0) { const Ctx& C = C0;
          const int ln = C0.lane; const float gq = wave_max(fabsf(KIN(15)[l * 64 + ln])), gk = wave_max(fmaxf(fabsf(KIN(16)[l * 192 + 64 + ln]), fabsf(KIN(16)[l * 192 + 128 + ln])));
          const float b0 = 64.0f * QSCALE * gq * gk * 1.02f + 0.5f;
          { const float fq = wave_max(fabsf(KIN(13)[l * 64 + ln])), fk = wave_max(fabsf(KIN(14)[l * 64 + ln])); if (ln == 0) ((LAS float*)(C0.lds + att::L_NST))[4] = 64.0f * QSCALE * fq * fk * 1.02f + 0.5f; }
#pragma unroll
          for (int hh = 0; hh < 4; ++hh) { const float mb = wave_max(fmaxf(fmaxf(fabsf(BLg[hh * 132 + ln]), fabsf(BLg[hh * 132 + 64 + ln])), fabsf(BLg[hh * 132 + 128]))); if (ln == 0) ((LAS float*)(C0.lds + att::L_NST))[hh] = b0 + mb; } }
      LDS_BARRIER(); }
    constexpr int NREG = 16 * 96 + 512, NCONV = MOE_CONV_ITEMS / 32;
    const int total = (l == 0) ? 13 * ((NCONV + 4) / 5 > (NREG + 7) / 8 ? (NCONV + 4) / 5 : (NREG + 7) / 8) : NREG;
    for (;;) {
        Ctx C = C0; { unsigned char* wsv = C0.ws; asm volatile("" : "+s"(wsv)); C.ws = wsv; int t_ = C0.tid; asm volatile("" : "+v"(t_)); C.tid = t_; C.lane = t_ & 63; }
        if (C.tid == 0) bc[0] = __hip_atomic_fetch_add((unsigned*)(C.ctl + CW_QUEUE + 64 * l + 16 * rp), 1u, RLX_AGENT);
        LDS_BARRIER();
        const int vidx = (int)bc[0];
        LDS_BARRIER();
        if (vidx >= total) break;
        int idx = vidx, cidx = -1;
#if QORDER == 1
        if (l == 0) { if (vidx >= NREG) { idx = NREG; cidx = vidx - NREG; } }
#else
        if (l == 0) { const int g = vidx / 13, r13 = vidx % 13; if (r13 < 8) idx = 8 * g + r13; else { idx = NREG; cidx = 5 * g + (r13 - 8); } }
#endif
        if (cidx >= 0) { if (cidx < NCONV && rp == 0) { LAS float* scr = (LAS float*)(C.lds + C.wave * 8448);
                moe_conv_items4(C, cidx * 32 + C.wave * 4, scr); LDS_BARRIER(); }
            continue; }
        if (idx >= NREG) continue;
        if (idx < 16 * 96) { const int lvl = idx / 96, r = idx % 96, qb = 15 - lvl;
            if (r < 32) { if (MIX_FOX && (rp == 0 || (RPF & 1))) { const bool fst = (FOX_STATIC == 2) || FOX_STATIC && __builtin_amdgcn_readfirstlane((int)(((const LAS float*)(C.lds + att::L_NST))[4] <= 100.0f)); if (fst) att::fox_unit(C, l, r >> 2, r & 3, qb); else att::fox_unit_safe(C, l, r >> 2, r & 3, qb); } }
            else if (r < 64) { if (MIX_SB && (rp == 0 || (RPF & 2))) att::sb_unit(C, (r - 32) >> 2, (r - 32) & 3, qb); }
            else { if (MIX_NSA && (rp == 0 || (RPF & 4))) att::nsa_unit(C, (r - 64) >> 2, 4 * qb + ((r - 64) & 3), rp == 0 ? 0 : NSADRY); } }
        else { if (MIX_MLSTM && (rp == 0 || (RPF & 8))) mlstm_out_unit(C, l, (idx - 16 * 96) >> 6, (idx - 16 * 96) & 63); }
    }
}

struct MoeL { int c0, c1, c2, c3, c4, c5, c6, c7, p1, p2, p3, p4, p5, p6, p7, p8; };
DI MoeL moe_layout(Ctx& C) {
    MoeL L;
#define LDC(e) ((int)__hip_atomic_load(C.ctl + CW_ECNT + (e), RLX_AGENT))
    L.c0 = LDC(0); L.c1 = LDC(1); L.c2 = LDC(2); L.c3 = LDC(3); L.c4 = LDC(4); L.c5 = LDC(5); L.c6 = LDC(6); L.c7 = LDC(7);
#undef LDC
    L.p1 = (L.c0 + 255) >> 8; L.p2 = L.p1 + ((L.c1 + 255) >> 8); L.p3 = L.p2 + ((L.c2 + 255) >> 8); L.p4 = L.p3 + ((L.c3 + 255) >> 8);
    L.p5 = L.p4 + ((L.c4 + 255) >> 8); L.p6 = L.p5 + ((L.c5 + 255) >> 8); L.p7 = L.p6 + ((L.c6 + 255) >> 8); L.p8 = L.p7 + ((L.c7 + 255) >> 8);
    return L;
}
DI void p_combine(Ctx& C, bool dry) {
    const bf16* Y1 = WSP(bf16, WS_Y1);
    for (size_t i = (size_t)C.blk * NTHR + C.tid; i < (size_t)T * D / 8; i += (size_t)C.G * NTHR) {
        const v4u y = *(const v4u*)(Y1 + i * 8); f32x4* o = (f32x4*)(C.out + i * 8);
        f32x4 a = o[0], b = o[1];
        a.x += bflo(y.x); a.y += bfhi(y.x); a.z += bflo(y.y); a.w += bfhi(y.y); b.x += bflo(y.z); b.y += bfhi(y.z); b.z += bflo(y.w); b.w += bfhi(y.w);
        if (!dry) { o[0] = a; o[1] = b; } else if (a.x == 123.456f) o[0] = b;
    }
}

constexpr int PH_L = 20, NPH = 2 + 2 * PH_L;
struct Args { const float* in[29]; float* out; unsigned char* ws; int ph_lo, ph_hi; };
extern __shared__ __attribute__((aligned(16))) unsigned char lds_raw[];
template <class P> DI P* uni(P* p) { const unsigned long long v = (unsigned long long)p; const unsigned lo = __builtin_amdgcn_readfirstlane((unsigned)v), hi = __builtin_amdgcn_readfirstlane((unsigned)(v >> 32)); return (P*)(((unsigned long long)hi << 32) | lo); }
DI int uni(int v) { return __builtin_amdgcn_readfirstlane(v); }
DI MoeL uni(MoeL L) { MoeL R; R.c0 = uni(L.c0); R.c1 = uni(L.c1); R.c2 = uni(L.c2); R.c3 = uni(L.c3); R.c4 = uni(L.c4); R.c5 = uni(L.c5); R.c6 = uni(L.c6); R.c7 = uni(L.c7);
    R.p1 = uni(L.p1); R.p2 = uni(L.p2); R.p3 = uni(L.p3); R.p4 = uni(L.p4); R.p5 = uni(L.p5); R.p6 = uni(L.p6); R.p7 = uni(L.p7); R.p8 = uni(L.p8); return R; }
DI pg8::MoeMap mk_map(const MoeL& L, unsigned char* ws) { pg8::MoeMap m; m.c0 = L.c0; m.c1 = L.c1; m.c2 = L.c2; m.c3 = L.c3; m.c4 = L.c4; m.c5 = L.c5; m.c6 = L.c6; m.c7 = L.c7;
    m.p1 = L.p1; m.p2 = L.p2; m.p3 = L.p3; m.p4 = L.p4; m.p5 = L.p5; m.p6 = L.p6; m.p7 = L.p7; m.tokof = (const int*)(ws + WS_TOKOF); m.tokw = (const float*)(ws + WS_TOKW); return m; }
DI void mk_ctx(Ctx& C, unsigned char* ws, float* out) {
    ws = uni(ws); out = uni(out);
    { const void __attribute__((address_space(4)))* ka = (const void __attribute__((address_space(4)))*)__builtin_amdgcn_kernarg_segment_ptr(); asm volatile("" : "+s"(ka), "+s"(ws), "+s"(out)); C.ka = ka; }
    C.lds = (LAS unsigned char*)lds_raw; C.MISC = (volatile LAS unsigned*)(C.lds + MISC_OFF);
    { int t_ = threadIdx.x; asm volatile("" : "+v"(t_)); C.tid = t_; }
    C.lane = C.tid & 63; C.wave = __builtin_amdgcn_readfirstlane(C.tid >> 6); C.G = gridDim.x; C.blk = blockIdx.x;
    C.ws = ws; C.ctl = (gu32*)(ws + WS_CTL); C.out = out;
}
#ifndef PH_NOINLINE
#define PH_NOINLINE 0
#endif
#if PH_NOINLINE
#define PHFN __device__ __noinline__ void
#else
#define PHFN DI void
#endif
PHFN f_prologue(unsigned char* ws, float* out) { Ctx C; mk_ctx(C, ws, out); p_prologue(C); }
PHFN f_modfin(unsigned char* ws, float* out) { Ctx C; mk_ctx(C, ws, out); p_modfin(C); }
PHFN f_norm1(unsigned char* ws, float* out, int l) { l = uni(l); Ctx C; mk_ctx(C, ws, out); out = C.out; p_norm<false>(C, l, (l == 0) ? KIN(0) : (const float*)out, KIN(5) + l * D, 0, 1024); }
PHFN f_norm2(unsigned char* ws, float* out, int l) { l = uni(l); Ctx C; mk_ctx(C, ws, out); out = C.out; p_norm<false>(C, l, out, KIN(6) + l * D, 3072, 4096); }
PHFN f_norm2r(unsigned char* ws, float* out, int l) { l = uni(l); Ctx C; mk_ctx(C, ws, out); out = C.out; p_norm<true>(C, l, out, KIN(6) + l * D, 3072, 4096); }
PHFN f_gemm_in(unsigned char* ws, float* out, int l, int dry) { l = uni(l); dry = uni(dry); Ctx C; mk_ctx(C, ws, out);
    pg8::Gemm g{WSP(bf16, WS_H), WSP(bf16, WS_WIN) + (size_t)l * PW * D, T, PW, D}; pg8::StaticOrder S; S.init(T, PW, C.G, C.blk);
    pg8::EpiBf16N E{WSP(bf16, WS_PROJ), PW, WSP(float, WS_GT) + l * 384, (PG8_LAS float*)(C.lds + 131072), dry}; pg8::gemm_phase<pg8::EpiBf16N, pg8::StaticOrder, true, true>(C.lds, g, S, E); }
PHFN f_prep(unsigned char* ws, float* out, int l, int mode) { l = uni(l); mode = uni(mode); Ctx C; mk_ctx(C, ws, out); p_prep(C, l, mode); }
PHFN f_scan(unsigned char* ws, float* out, int l, int dry) { l = uni(l); dry = uni(dry); Ctx C; mk_ctx(C, ws, out); p_scan(C, l, dry != 0); }
PHFN f_mix(unsigned char* ws, float* out, int l, int rp) { l = uni(l); rp = uni(rp); Ctx C; mk_ctx(C, ws, out); p_mix(C, l, rp); }
PHFN f_gemm_res(unsigned char* ws, float* out, const bf16* A, const bf16* Bt, int K, const float* base, const float* gate, int dry) { dry = uni(dry); A = uni(A); Bt = uni(Bt); K = uni(K); base = uni(base); gate = uni(gate); Ctx C; mk_ctx(C, ws, out); out = C.out;
    pg8::Gemm g{A, Bt, T, D, K}; pg8::StaticOrder S; S.init(T, D, C.G, C.blk);
    pg8::EpiResGate E{base, out, gate, D, 6144, dry}; pg8::gemm_phase<pg8::EpiResGate, pg8::StaticOrder, true, true>(C.lds, g, S, E); }
PHFN f_gu(unsigned char* ws, float* out, int dry) { dry = uni(dry); Ctx C; mk_ctx(C, ws, out);
    pg8::Gemm g{WSP(bf16, WS_H), WSP(bf16, WS_WGU), T, 2 * FF, D}; pg8::StaticOrder S; S.init(T, 2 * FF, C.G, C.blk);
    pg8::EpiSwiGLU E{WSP(bf16, WS_ACT), FF, 2 * FF / 256, 0, dry}; pg8::gemm_phase<pg8::EpiSwiGLU, pg8::StaticOrder, GU_ALIGN, true>(C.lds, g, S, E); }
PHFN f_mgu(unsigned char* ws, float* out, MoeL L, int t0, int nt, int dry) { dry = uni(dry); L = uni(L); t0 = uni(t0); nt = uni(nt); Ctx C; mk_ctx(C, ws, out);
    pg8::Gemm g{WSP(bf16, WS_H), WSP(bf16, WS_MWGU), 0, 0, D};
    pg8::MoeOrder S{t0, nt, 2 * FFE / 256, C.G, C.blk, 0, mk_map(L, C.ws)};
    pg8::EpiSwiGLU E{t0 == 256 ? WSP(bf16, WS_ACT2) : WSP(bf16, WS_ACTE), FFE, 2 * FFE / 256, t0 * 256, dry}; pg8::gemm_phase_ga<pg8::EpiSwiGLU, pg8::MoeOrder, GU_ALIGN, true>(C.lds, g, S, E); }
PHFN f_mdown(unsigned char* ws, float* out, MoeL L, int t0, int nt, const float* gate, int dry) { dry = uni(dry); L = uni(L); t0 = uni(t0); nt = uni(nt); gate = uni(gate); Ctx C; mk_ctx(C, ws, out); out = C.out;
    pg8::Gemm g{t0 == 256 ? WSP(bf16, WS_ACT2) : WSP(bf16, WS_ACTE), WSP(bf16, WS_MWD), 0, 0, FFE};
    pg8::MoeOrder S{t0, nt, D / 256, C.G, C.blk, t0, mk_map(L, C.ws)};
    pg8::EpiMoeDown E{mk_map(L, C.ws), out, WSP(bf16, WS_Y1), gate, 6144, t0, D / 256, dry};
    pg8::gemm_phase<pg8::EpiMoeDown, pg8::MoeOrder, true, true>(C.lds, g, S, E); }
PHFN f_mgu_tail(unsigned char* ws, float* out, MoeL L, int t0, int ntail, const float* gate) { L = uni(L); t0 = uni(t0); ntail = uni(ntail); gate = uni(gate); Ctx C; mk_ctx(C, ws, out); out = C.out;
    { pg8::Gemm g{WSP(bf16, WS_ACT2), WSP(bf16, WS_MWD), 0, 0, FFE};
      pg8::MoeOrder S{256, ntail, D / 256, C.G, C.blk, 256, mk_map(L, C.ws)};
      pg8::EpiMoeDown E{mk_map(L, C.ws), out, WSP(bf16, WS_Y1), gate, 6144, 256, D / 256, 0};
      pg8::gemm_phase<pg8::EpiMoeDown, pg8::MoeOrder, true, true>(C.lds, g, S, E); }
    { pg8::Gemm g{WSP(bf16, WS_H), WSP(bf16, WS_MWGU), 0, 0, D};
      pg8::MoeOrderB S{t0, 2 * FFE / 256, C.blk, 4 * ntail, mk_map(L, C.ws)};
      pg8::EpiSwiGLU E{WSP(bf16, WS_ACTE), FFE, 2 * FFE / 256, t0 * 256, 0}; pg8::gemm_phase_ga<pg8::EpiSwiGLU, pg8::MoeOrderB, GU_ALIGN, true>(C.lds, g, S, E); }
}
PHFN f_combine(unsigned char* ws, float* out, int dry) { dry = uni(dry); Ctx C; mk_ctx(C, ws, out); p_combine(C, dry != 0); }

__global__ void __launch_bounds__(NTHR, 2) fwd(Args args) {
    unsigned char* const ws = args.ws; float* const out = args.out;
    volatile LAS unsigned* MISC = (volatile LAS unsigned*)((LAS unsigned char*)lds_raw + MISC_OFF);
    for (int u = threadIdx.x; u < (LDS_BYTES - MISC_OFF) / 4; u += NTHR) MISC[u] = 0u;
    __syncthreads();
    const int lo = args.ph_lo, hi = args.ph_hi;
    XcdBarrier bar; bar.bar = (unsigned*)(ws + WS_CTL) + CW_BAR; bar.x = 0; bar.st = nullptr;
    if (hi - lo > 1) bar = xcd_barrier_post((unsigned*)(ws + WS_CTL) + CW_BAR, MISC + 0);
#define IN(k) (lo <= (k) && (k) < hi)
#define SEAM(k) do { if (IN(k) && IN((k) + 1)) xcd_barrier(bar); } while (0)
    if (EN_PRO && IN(0)) for (int rp_ = 0; rp_ < REP_PRO; ++rp_) f_prologue(ws, out); SEAM(0);
    if (EN_PRO && IN(1)) f_modfin(ws, out); SEAM(1);
    for (int xb_ = 0; xb_ < XTRA_BAR; ++xb_) xcd_barrier(bar);
#pragma unroll 1
    for (int l = 0; l < DEPTH; ++l) {
        const int pb = 2 + PH_L * l;
        const float* MOD = (const float*)(ws + WS_MOD) + (size_t)l * 8 * 6144;
        if (EN_NORM && IN(pb + 0)) for (int rp_ = 0; rp_ < REP_NORM; ++rp_) f_norm1(ws, out, l); SEAM(pb + 0);
        if (EN_GIN && IN(pb + 1)) for (int rp_ = 0; rp_ < REP_GIN; ++rp_) f_gemm_in(ws, out, l, rp_ ? GDRY : 0); SEAM(pb + 1);
        if (EN_PREP && IN(pb + 2)) for (int rp_ = 0; rp_ < REP_PREP; ++rp_) f_prep(ws, out, l, rp_ == 0 ? 0 : PREP_RMODE); SEAM(pb + 2);
        if (EN_SCAN && IN(pb + 3)) for (int rp_ = 0; rp_ < REP_THIN; ++rp_) f_scan(ws, out, l, rp_); SEAM(pb + 3);
        if (EN_MIX && IN(pb + 4)) for (int rp_ = 0; rp_ < REP_MIX; ++rp_) f_mix(ws, out, l, rp_); SEAM(pb + 4);
        if (EN_GOUT && IN(pb + 5)) for (int rp_ = 0; rp_ < REP_RES; ++rp_) f_gemm_res(ws, out, (const bf16*)(ws + WS_MIX), (const bf16*)(ws + WS_WOUT) + (size_t)l * D * D, D, (l == 0) ? ((const float* const __attribute__((address_space(4)))*)__builtin_amdgcn_kernarg_segment_ptr())[0] : (const float*)out, MOD + 2048, rp_); SEAM(pb + 5);
        if (l == 0) {
            if (EN_NORM && IN(pb + 6)) for (int rp_ = 0; rp_ < REP_THIN; ++rp_) f_norm2(ws, out, l); SEAM(pb + 6);
            if (EN_GU && IN(pb + 7)) for (int rp_ = 0; rp_ < REP_GU; ++rp_) f_gu(ws, out, rp_ ? GDRY : 0); SEAM(pb + 7);
            if (EN_DOWN && IN(pb + 8)) for (int rp_ = 0; rp_ < REP_RES; ++rp_) f_gemm_res(ws, out, (const bf16*)(ws + WS_ACT), (const bf16*)(ws + WS_WD), FF, out, MOD + 5120, rp_); SEAM(pb + 8);
        } else {
            if (EN_MOE && IN(pb + 6)) f_norm2r(ws, out, l); SEAM(pb + 6);
            Ctx C; mk_ctx(C, ws, out);
            const MoeL L = uni(moe_layout(C));
            const int ntail = L.p8 - 4 * CHUNK_TILES;
            if (EN_MGU && IN(pb + 8)) for (int rp_ = 0; rp_ < REP_GU; ++rp_) f_mgu(ws, out, L, 0, CHUNK_TILES, rp_ ? GDRY : 0); SEAM(pb + 8);
            if (EN_MDOWN && IN(pb + 9)) f_mdown(ws, out, L, 0, CHUNK_TILES, MOD + 5120, 0); SEAM(pb + 9);
            if (ntail > 0) { if (EN_MGU && IN(pb + 10)) f_mgu(ws, out, L, 4 * CHUNK_TILES, ntail, 0); SEAM(pb + 10); }
            if (ntail > 0) { if (EN_MGU && IN(pb + 11)) f_mgu_tail(ws, out, L, CHUNK_TILES, ntail, MOD + 5120); }
            else { if (EN_MGU && IN(pb + 11)) f_mgu(ws, out, L, CHUNK_TILES, CHUNK_TILES, 0); }
            SEAM(pb + 11);
            if (EN_MDOWN && IN(pb + 12)) f_mdown(ws, out, L, CHUNK_TILES, CHUNK_TILES, MOD + 5120, 0); SEAM(pb + 12);
            if (EN_MGU && IN(pb + 13)) for (int rp_ = 0; rp_ < REP_GU; ++rp_) f_mgu(ws, out, L, 2 * CHUNK_TILES, CHUNK_TILES, rp_ ? GDRY : 0); SEAM(pb + 13);
            if (EN_MDOWN && IN(pb + 14)) f_mdown(ws, out, L, 2 * CHUNK_TILES, CHUNK_TILES, MOD + 5120, 0); SEAM(pb + 14);
            if (EN_MGU && IN(pb + 15)) for (int rp_ = 0; rp_ < REP_GU; ++rp_) f_mgu(ws, out, L, 3 * CHUNK_TILES, CHUNK_TILES, rp_ ? GDRY : 0); SEAM(pb + 15);
            if (EN_MDOWN && IN(pb + 16)) f_mdown(ws, out, L, 3 * CHUNK_TILES, CHUNK_TILES, MOD + 5120, 0); SEAM(pb + 16);
            if (EN_MOE && IN(pb + 18)) for (int rp_ = 0; rp_ < REP_THIN; ++rp_) f_combine(ws, out, rp_);
        }
    }
#undef IN
#undef SEAM
}

extern "C" void kernel_launch(void* const* d_in, const int* in_sizes, int n_in, void* d_out, int out_size, void* d_ws, size_t ws_size, hipStream_t stream) {
    static int grid = 0;
    if (grid == 0) {
        if (n_in != 29 || in_sizes[0] != T * D || out_size != T * D || ws_size < WS_END) { fprintf(stderr, "kernel_launch: unexpected shapes (n_in %d, in0 %d, out %d, ws %zu)\n", n_in, n_in > 0 ? in_sizes[0] : -1, out_size, ws_size); grid = -1; return; }
        if (hipFuncSetAttribute((const void*)fwd, hipFuncAttributeMaxDynamicSharedMemorySize, LDS_BYTES) != hipSuccess) { fprintf(stderr, "kernel_launch: hipFuncSetAttribute failed\n"); grid = -1; return; }
        int dev = 0, cus = 0, per_cu = 0;
        (void)hipGetDevice(&dev); (void)hipDeviceGetAttribute(&cus, hipDeviceAttributeMultiprocessorCount, dev);
        if (hipOccupancyMaxActiveBlocksPerMultiprocessor(&per_cu, (const void*)fwd, NTHR, LDS_BYTES) != hipSuccess || per_cu < 1) fprintf(stderr, "kernel_launch: occupancy query says %d per CU\n", per_cu);
        (void)hipGetLastError();
        grid = 256;
        if (cus < 256) fprintf(stderr, "kernel_launch: device has %d CUs; this kernel needs 256\n", cus);
    }
    if (grid < 0) return;
    (void)hipMemsetAsync((char*)d_ws + WS_CTL, 0, CTL_ZERO_BYTES, stream);
    Args a{};
    for (int i = 0; i < 29; ++i) a.in[i] = (const float*)d_in[i];
    a.out = (float*)d_out; a.ws = (unsigned char*)d_ws;
#if N_LAUNCHES == 1
    a.ph_lo = 0; a.ph_hi = NPH;
    hipLaunchKernelGGL(fwd, dim3(grid), dim3(NTHR), LDS_BYTES, stream, a);
#else
    for (int k = 0; k < NPH; ++k) {
        const int r = (k - 2) % PH_L; if (k >= 2 && ((k < 2 + PH_L && r > 8) || (k >= 2 + PH_L && r > 18))) continue;
        a.ph_lo = k; a.ph_hi = k + 1;
        hipLaunchKernelGGL(fwd, dim3(grid), dim3(NTHR), LDS_BYTES, stream, a);
    }
#endif
}
```

```cpp
#include <hip/hip_runtime.h>
#include <cstdio>
#include <cstdint>
#include <cmath>
#ifndef N_LAUNCHES
#define N_LAUNCHES 1
#endif
#ifndef RES_BATCH
#define RES_BATCH 4
#endif
#ifndef FOX_STATIC
#define FOX_STATIC 1
#endif
#ifndef NSA_STATIC
#define NSA_STATIC 1
#endif
#ifndef MIX_FOX
#define MIX_FOX 1
#endif
#ifndef MIX_SB
#define MIX_SB 1
#endif
#ifndef MIX_NSA
#define MIX_NSA 1
#endif
#ifndef MIX_MLSTM
#define MIX_MLSTM 1
#endif
#ifndef EN_PRO
#define EN_PRO 1
#endif
#ifndef EN_NORM
#define EN_NORM 1
#endif
#ifndef EN_GIN
#define EN_GIN 1
#endif
#ifndef EN_PREP
#define EN_PREP 1
#endif
#ifndef EN_SCAN
#define EN_SCAN 1
#endif
#ifndef EN_MIX
#define EN_MIX 1
#endif
#ifndef EN_GOUT
#define EN_GOUT 1
#endif
#ifndef EN_GU
#define EN_GU 1
#endif
#ifndef EN_DOWN
#define EN_DOWN 1
#endif
#ifndef EN_MOE
#define EN_MOE 1
#endif
#ifndef EN_MGU
#define EN_MGU 1
#endif
#ifndef EN_MDOWN
#define EN_MDOWN 1
#endif
#ifndef REP_PRO
#define REP_PRO 1
#endif
#ifndef REP_GIN
#define REP_GIN 1
#endif
#ifndef REP_PREP
#define REP_PREP 1
#endif
#ifndef REP_MIX
#define REP_MIX 1
#endif
#ifndef REP_GU
#define REP_GU 1
#endif
#ifndef REP_NORM
#define REP_NORM 1
#endif
#ifndef REPU_FOX
#define REPU_FOX 1
#endif
#ifndef REPU_SB
#define REPU_SB 1
#endif
#ifndef REPU_NSA
#define REPU_NSA 1
#endif
#ifndef REPU_ML
#define REPU_ML 1
#endif
#ifndef XTRA_BAR
#define XTRA_BAR 0
#endif
#ifndef REP_GATHER
#define REP_GATHER 1
#endif
#ifndef REP_RES
#define REP_RES 1
#endif
#ifndef RPF
#define RPF 15
#endif
#ifndef NSADRY
#define NSADRY 0
#endif
#ifndef GU_ALIGN
#define GU_ALIGN true
#endif
#ifndef REP_THIN
#define REP_THIN 1
#endif
#ifndef PREP_RMODE
#define PREP_RMODE 1
#endif
#ifndef GDRY
#define GDRY 0
#endif
#ifndef QORDER
#define QORDER 0
#endif
namespace pg8 {
#define PG8_LAS __attribute__((address_space(3)))
typedef unsigned short bf16_t;
typedef short bf16x8 __attribute__((ext_vector_type(8)));
typedef float f32x4 __attribute__((ext_vector_type(4)));
typedef unsigned u32x4 __attribute__((ext_vector_type(4)));
constexpr int BM = 256, BK = 64, HALF = 128, HTB = HALF * BK * 2  , STAGE_BYTES = 8 * HTB, NXCD = 8, WGM = 8;

__host__ __device__ __forceinline__ int lds_byte(int r, int c) { const int st = (r >> 4) * 2 + (c >> 5), rr = r & 15, cc = c & 31, ob = rr * 64 + cc * 2; return st * 1024 + (ob ^ (((ob >> 9) & 1) << 5)); }
__host__ __device__ __forceinline__ void stage_rc(int b, int& R, int& C) { const int st = b / 1024, sb = b % 1024, swz = sb ^ (((sb >> 9) & 1) << 5); R = (st >> 1) * 16 + swz / 64; C = (st & 1) * 32 + (swz % 64) / 2; }
__host__ __device__ __forceinline__ int perm32(int rho) { const int n = rho >> 4, i = rho & 15; return 8 * (i >> 2) + 4 * n + (i & 3); }

struct Unit { int pm, pn; };
struct Gemm { const bf16_t* A; const bf16_t* Bt; int M, N, K; };

struct StaticOrder {
    int nM, nN, nwg, G, c;
    __host__ __device__ void init(int M, int N, int G_, int c_) { nM = M / BM; nN = N / BM; nwg = nM * nN; G = G_; c = c_; }
    __host__ __device__ bool next(int i, Unit& u) const {
        const long L = (long)i * G + c; if (L >= nwg) return false;
        int wgid = (int)L; { const int q = nwg / NXCD, r = nwg % NXCD, xcd = wgid % NXCD, off = wgid / NXCD; wgid = (xcd < r ? xcd * (q + 1) : r * (q + 1) + (xcd - r) * q) + off; }
        const int nig = WGM * nN, gid = wgid / nig, fm = gid * WGM, gsz = (nM - fm) < WGM ? (nM - fm) : WGM;
        u.pm = fm + ((wgid % nig) % gsz); u.pn = (wgid % nig) / gsz; return true;
    }
    __device__ __forceinline__ void a_ready(const Unit&) const {}
    __device__ __forceinline__ void done(const Unit&) const {}
};
__device__ __forceinline__ unsigned cvt_pk_bf16(float lo, float hi) { unsigned r; asm volatile("v_cvt_pk_bf16_f32 %0, %1, %2" : "=v"(r) : "v"(lo), "v"(hi)); return r; }
typedef float f32x2 __attribute__((ext_vector_type(2)));

__device__ __forceinline__ float silu_f(float x) { return x * __builtin_amdgcn_rcpf(1.0f + __builtin_amdgcn_exp2f(-1.4426950408889634f * x)); }
struct EpiBf16 {
    static constexpr bool PERM = true, AFTER_DRAIN = false;
    bf16_t* O; int ldc; int dry;
    __device__ __forceinline__ void operator()(const f32x4 (&acc)[2][2][4][2], const Unit& u, int wr, int wc, int fr, int fq) const {
        if (dry) return;
        const int row0 = u.pm * BM + wr * 64 + fr, col0 = u.pn * BM + wc * 32 + 8 * fq;
#pragma unroll
        for (int ai = 0; ai < 2; ++ai)
#pragma unroll
            for (int m = 0; m < 4; ++m) { bf16_t* rowp = O + (size_t)(row0 + ai * HALF + m * 16) * ldc + col0;
#pragma unroll
                for (int bj = 0; bj < 2; ++bj) { const f32x4 v0 = acc[ai][bj][m][0], v1 = acc[ai][bj][m][1];
                    u32x4 w; w.x = cvt_pk_bf16(v0[0], v0[1]); w.y = cvt_pk_bf16(v0[2], v0[3]); w.z = cvt_pk_bf16(v1[0], v1[1]); w.w = cvt_pk_bf16(v1[2], v1[3]);
                    *(u32x4*)(rowp + bj * HALF) = w; } }
    }
};
struct EpiBf16N {
    static constexpr bool PERM = true, AFTER_DRAIN = false;
    bf16_t* O; int ldc; const float* GT; PG8_LAS float* SC; int dry;
    __device__ __forceinline__ static int head_type(int hc) { return (hc >= 1024 && hc < 1280) ? 0 : (hc >= 1280 && hc < 1536) ? 1 : (hc >= 1792 && hc < 2048) ? 2 : (hc >= 2560 && hc < 2816) ? 3 : hc == 2944 ? 4 : hc == 3072 ? 5 : -1; }
    __device__ __forceinline__ void operator()(const f32x4 (&acc)[2][2][4][2], const Unit& u, int wr, int wc, int fr, int fq) const {
        if (dry) return;
        asm volatile("" : "+v"(fr), "+v"(fq));
        const int pn = __builtin_amdgcn_readfirstlane(u.pn);
        const int row0 = u.pm * BM + wr * 64 + fr, col0 = pn * BM + wc * 32 + 8 * fq;
        const bool ntile = (pn == 4) | (pn == 5) | (pn == 10) | (pn == 11) | (pn == 12), stile = ntile | (pn == 7);
        if (!stile) {
#pragma unroll
            for (int ai = 0; ai < 2; ++ai)
#pragma unroll
                for (int m = 0; m < 4; ++m) { bf16_t* rowp = O + (size_t)(row0 + ai * HALF + m * 16) * ldc + col0;
#pragma unroll
                    for (int bj = 0; bj < 2; ++bj) { const f32x4 v0 = acc[ai][bj][m][0], v1 = acc[ai][bj][m][1];
                        u32x4 w; w.x = cvt_pk_bf16(v0[0], v0[1]); w.y = cvt_pk_bf16(v0[2], v0[3]); w.z = cvt_pk_bf16(v1[0], v1[1]); w.w = cvt_pk_bf16(v1[2], v1[3]);
                        *(u32x4*)(rowp + bj * HALF) = w; } }
            return;
        }
        const int wid = wr * 4 + wc;
#pragma unroll
        for (int bj = 0; bj < 2; ++bj) {
            const int ty = head_type(pn * BM + bj * HALF + (wc >> 1) * 64);
            const bool nrm = ntile && ty >= 0 && ty != 2;
            float ps[2][4];
            if (ntile) {
#pragma unroll
                for (int ai = 0; ai < 2; ++ai)
#pragma unroll
                    for (int m = 0; m < 4; ++m) { const f32x4 v0 = acc[ai][bj][m][0], v1 = acc[ai][bj][m][1];
                        float ss = (v0[0] * v0[0] + v0[1] * v0[1]) + (v0[2] * v0[2] + v0[3] * v0[3]) + (v1[0] * v1[0] + v1[1] * v1[1]) + (v1[2] * v1[2] + v1[3] * v1[3]);
                        ss += __shfl_xor(ss, 16); ss += __shfl_xor(ss, 32);
                        ps[ai][m] = ss;
                        if (fq == 0) SC[(wid * 16 + bj * 8 + ai * 4 + m) * 16 + fr] = ss; }
                asm volatile("s_waitcnt lgkmcnt(0)" ::: "memory");
                __builtin_amdgcn_s_barrier();
            }
            f32x4 g0 = (f32x4){1.f, 1.f, 1.f, 1.f}, g1 = g0;
            if (ty >= 0) { const float* gp = GT + ty * 64 + (wc & 1) * 32 + 8 * fq; g0 = *(const f32x4*)gp; g1 = *(const f32x4*)(gp + 4); }
#pragma unroll
            for (int ai = 0; ai < 2; ++ai)
#pragma unroll
                for (int m = 0; m < 4; ++m) { float r = 1.0f;
                    if (nrm) { const float tot = ps[ai][m] + SC[((wid ^ 1) * 16 + bj * 8 + ai * 4 + m) * 16 + fr]; r = __builtin_amdgcn_rsqf(tot * (1.0f / 64.0f) + 1e-6f); }
                    const f32x4 v0 = acc[ai][bj][m][0] * g0 * r, v1 = acc[ai][bj][m][1] * g1 * r;
                    u32x4 w; w.x = cvt_pk_bf16(v0[0], v0[1]); w.y = cvt_pk_bf16(v0[2], v0[3]); w.z = cvt_pk_bf16(v1[0], v1[1]); w.w = cvt_pk_bf16(v1[2], v1[3]);
                    *(u32x4*)(O + (size_t)(row0 + ai * HALF + m * 16) * ldc + col0 + bj * HALF) = w; }
        }
    }
};
struct EpiResGate {
    static constexpr bool PERM = false, AFTER_DRAIN = false;
    const float* base; float* out; const float* gate; int ldc; int gate_ld; int dry;
    __device__ __forceinline__ void operator()(const f32x4 (&acc)[2][2][4][2], const Unit& u, int wr, int wc, int fr, int fq) const {
        if (dry) return;
        const int row0 = u.pm * BM + wr * 64 + fr, col0 = u.pn * BM + wc * 32 + 4 * fq;
        const float* gp = gate + (size_t)((u.pm * BM) >> 12) * gate_ld + col0;
        f32x4 gv[2][2];
#pragma unroll
        for (int bj = 0; bj < 2; ++bj)
#pragma unroll
            for (int n = 0; n < 2; ++n) gv[bj][n] = *(const f32x4*)(gp + bj * HALF + n * 16);
#pragma unroll
        for (int ai = 0; ai < 2; ++ai)
#pragma unroll
            for (int mb = 0; mb < 4; mb += RES_BATCH) {
                f32x4 bs[RES_BATCH][2][2];
#pragma unroll
                for (int mi = 0; mi < RES_BATCH; ++mi) { const size_t off = (size_t)(row0 + ai * HALF + (mb + mi) * 16) * ldc + col0;
#pragma unroll
                    for (int bj = 0; bj < 2; ++bj)
#pragma unroll
                        for (int n = 0; n < 2; ++n) bs[mi][bj][n] = *(const __attribute__((address_space(1))) f32x4*)(base + off + bj * HALF + n * 16); }
                asm volatile("" ::: "memory");
#pragma unroll
                for (int mi = 0; mi < RES_BATCH; ++mi) { const size_t off = (size_t)(row0 + ai * HALF + (mb + mi) * 16) * ldc + col0;
#pragma unroll
                    for (int bj = 0; bj < 2; ++bj)
#pragma unroll
                        for (int n = 0; n < 2; ++n) *(__attribute__((address_space(1))) f32x4*)(out + off + bj * HALF + n * 16) = bs[mi][bj][n] + gv[bj][n] * acc[ai][bj][mb + mi][n]; }
                asm volatile("" ::: "memory"); }
    }
};
struct EpiSwiGLU {
    static constexpr bool PERM = true, AFTER_DRAIN = false;
    bf16_t* O; int ldc; int pn_mod; int row_sub; int dry;
    __device__ __forceinline__ void operator()(const f32x4 (&acc)[2][2][4][2], const Unit& u, int wr, int wc, int fr, int fq) const {
        if (dry) return;
        const int row0 = u.pm * BM - row_sub + wr * 64 + fr, col0 = (u.pn % pn_mod) * HALF + wc * 32 + 8 * fq;
#pragma unroll
        for (int ai = 0; ai < 2; ++ai)
#pragma unroll
            for (int m = 0; m < 4; ++m) { bf16_t* rowp = O + (size_t)(row0 + ai * HALF + m * 16) * ldc + col0;
                const f32x4 g0 = acc[ai][0][m][0], g1 = acc[ai][0][m][1], u0 = acc[ai][1][m][0], u1 = acc[ai][1][m][1];
                float v[8];
#pragma unroll
                for (int j = 0; j < 4; ++j) { v[j] = silu_f(g0[j]) * u0[j]; v[4 + j] = silu_f(g1[j]) * u1[j]; }
                u32x4 w; w.x = cvt_pk_bf16(v[0], v[1]); w.y = cvt_pk_bf16(v[2], v[3]); w.z = cvt_pk_bf16(v[4], v[5]); w.w = cvt_pk_bf16(v[6], v[7]);
                *(u32x4*)rowp = w; }
    }
};
struct MoeMap {
    int c0, c1, c2, c3, c4, c5, c6, c7, p1, p2, p3, p4, p5, p6, p7; const int* tokof; const float* tokw;
    __device__ __forceinline__ int expert(int tile) const { return (tile >= p1) + (tile >= p2) + (tile >= p3) + (tile >= p4) + (tile >= p5) + (tile >= p6) + (tile >= p7); }
    __device__ __forceinline__ int index(int tile, int r) const {
        tile = __builtin_amdgcn_readfirstlane(tile);
        const int g1 = tile >= p1, g2 = tile >= p2, g3 = tile >= p3, g4 = tile >= p4, g5 = tile >= p5, g6 = tile >= p6, g7 = tile >= p7;
        const int e = g1 + g2 + g3 + g4 + g5 + g6 + g7;
        int pte = g1 * p1; pte = max(pte, g2 * p2); pte = max(pte, g3 * p3); pte = max(pte, g4 * p4); pte = max(pte, g5 * p5); pte = max(pte, g6 * p6); pte = max(pte, g7 * p7);
        const int ce = c0 + g1 * (c1 - c0) + g2 * (c2 - c1) + g3 * (c3 - c2) + g4 * (c4 - c3) + g5 * (c5 - c4) + g6 * (c6 - c5) + g7 * (c7 - c6);
        const int slot = (tile - pte) * 256 + r; return slot < ce ? e * 32768 + slot : -1; }
};
struct EpiMoeDown {
    static constexpr bool PERM = false, AFTER_DRAIN = false;
    MoeMap mm; float* out; bf16_t* y1; const float* gate; int gate_ld; int tile_add; int pn_mod; int dry;
    __device__ __forceinline__ void operator()(const f32x4 (&acc)[2][2][4][2], const Unit& u, int wr, int wc, int fr, int fq) const {
        if (dry) return;
        const int tile = u.pm + tile_add, rl0 = wr * 64 + fr, col0 = (u.pn % pn_mod) * BM + wc * 32 + 4 * fq;
        int tks[8]; float ws[8];
#pragma unroll
        for (int q = 0; q < 8; ++q) { const int ix = mm.index(tile, rl0 + (q >> 2) * HALF + (q & 3) * 16); tks[q] = ix >= 0 ? mm.tokof[ix] : -1; ws[q] = ix >= 0 ? mm.tokw[ix] : 0.f; }
#pragma unroll
        for (int ai = 0; ai < 2; ++ai)
#pragma unroll
            for (int m = 0; m < 4; ++m) { const int tk = tks[ai * 4 + m];
                if (tk >= 0) { const float w = ws[ai * 4 + m]; const int tok = tk & 0x3fffffff; const bool s1 = (tk >> 30) & 1;
                    const float* gp = gate + (size_t)(tok >> 12) * gate_ld + col0; const size_t off = (size_t)tok * 1024 + col0;
#pragma unroll
                    for (int bj = 0; bj < 2; ++bj)
#pragma unroll
                        for (int n = 0; n < 2; ++n) { const f32x4 gv = *(const f32x4*)(gp + bj * HALF + n * 16); const f32x4 v = gv * acc[ai][bj][m][n] * w;
                            if (s1) { typedef unsigned u32x2v __attribute__((ext_vector_type(2))); u32x2v pw; pw.x = cvt_pk_bf16(v[0], v[1]); pw.y = cvt_pk_bf16(v[2], v[3]); *(u32x2v*)(y1 + off + bj * HALF + n * 16) = pw; }
                            else { float* op = out + off + bj * HALF + n * 16; *(f32x4*)op = *(const f32x4*)op + v; } } }
                if (m & 1) asm volatile("" ::: "memory"); }
    }
};
struct MoeOrder {
    int t0, nt, ncol, G, c, pm_off; MoeMap mm;
    __device__ __forceinline__ bool next(int i, Unit& u) const {
        int tile, pnr;
        if (nt == 64 && G == 256) {
            pnr = i * 4 + (c >> 6); if (pnr >= ncol) return false; tile = t0 + (c & 7) * 8 + ((c >> 3) & 7);
        } else { const long L = (long)i * G + c; if (L >= (long)nt * ncol) return false; const int idx = (int)L; tile = t0 + idx % nt; pnr = idx / nt; }
        u.pm = tile - pm_off; u.pn = mm.expert(tile) * ncol + pnr; return true;
    }
    __device__ __forceinline__ unsigned row_byte(const Unit& u, int r) const { const int ix = mm.index(u.pm + pm_off, r); const int tok = ix >= 0 ? (mm.tokof[ix] & 0x3fffffff) : 0; return (unsigned)tok * 2048u; }
    __device__ __forceinline__ void a_ready(const Unit&) const {}
    __device__ __forceinline__ void done(const Unit&) const {}
};
struct MoeOrderB {
    int t0, ncol, c, nd; MoeMap mm;
    __device__ __forceinline__ bool next(int i, Unit& u) const {
        int ii = i, cc = c;
        if (c < nd) { if (i >= 4) return false; }
        else if (i == 7) { const int k = c - nd; if (k >= 3 * nd) return false; ii = 4 + k / nd; cc = k % nd; }
        else if (i > 7) return false;
        const int pnr = ii * 4 + (cc >> 6); if (pnr >= ncol) return false;
        const int tile = t0 + (cc & 7) * 8 + ((cc >> 3) & 7);
        u.pm = tile; u.pn = mm.expert(tile) * ncol + pnr; return true;
    }
    __device__ __forceinline__ unsigned row_byte(const Unit& u, int r) const { const int ix = mm.index(u.pm, r); const int tok = ix >= 0 ? (mm.tokof[ix] & 0x3fffffff) : 0; return (unsigned)tok * 2048u; }
    __device__ __forceinline__ void a_ready(const Unit&) const {}
    __device__ __forceinline__ void done(const Unit&) const {}
};
template <class Epi, class Sched, bool ALIGN_EPI = false, bool SP2 = false>
__device__ __forceinline__ void gemm_phase(PG8_LAS unsigned char* lds, const Gemm g, const Sched& S, const Epi& E) {
    int tid_ = threadIdx.x; asm volatile("" : "+v"(tid_));
    const int tid = tid_, wid = __builtin_amdgcn_readfirstlane(tid >> 6), lane = tid & 63, wr = wid >> 2, wc = wid & 3, fr = lane & 15, fq = lane >> 4;
    const int K = g.K, nt = K / BK;
    unsigned voffA[2], voffB[2];
#pragma unroll
    for (int i = 0; i < 2; ++i) { int R, C; stage_rc(tid * 16 + i * 8192, R, C); const int Rb = Epi::PERM ? ((R & ~31) + perm32(R & 31)) : R;
        voffA[i] = (unsigned)(R * K + C) * 2u; voffB[i] = (unsigned)(Rb * K + C) * 2u; }
    const size_t kstep = (size_t)(BK * 2);
    const size_t hstep = (size_t)HALF * K * 2;
    const size_t tstep = 2 * hstep;
    const unsigned ldsw = (unsigned)wid * 1024u;
    const int aoff = lds_byte(wr * 64 + fr, fq * 8), boff = lds_byte(wc * 32 + fr, fq * 8);
#define PG8_SA(b, h) (((b) * 2 + (h)) * HTB)
#define PG8_SB(b, h) ((4 + (b) * 2 + (h)) * HTB)
#define PG8_STAGE(bufoff, gbase, voff) do { _Pragma("unroll") for (int _i = 0; _i < 2; ++_i) \
        __builtin_amdgcn_global_load_lds((const unsigned*)((const char*)(gbase) + (voff)[_i]), (PG8_LAS unsigned*)(lds + (bufoff) + ldsw + _i * 8192), 16, 0, 0); } while (0)
#define PG8_LDA(dst, b, h) do { _Pragma("unroll") for (int m = 0; m < 4; ++m) _Pragma("unroll") for (int k = 0; k < 2; ++k) dst[m][k] = *(const PG8_LAS bf16x8*)(lds + PG8_SA(b, h) + aoff + m * 2048 + k * 1024); } while (0)
#define PG8_LDB(dst, b, h) do { _Pragma("unroll") for (int n = 0; n < 2; ++n) _Pragma("unroll") for (int k = 0; k < 2; ++k) dst[n][k] = *(const PG8_LAS bf16x8*)(lds + PG8_SB(b, h) + boff + n * 2048 + k * 1024); } while (0)
#define PG8_MMA(ai, bj, At, Bt) do { __builtin_amdgcn_s_setprio(1); _Pragma("unroll") for (int m = 0; m < 4; ++m) _Pragma("unroll") for (int n = 0; n < 2; ++n) _Pragma("unroll") for (int k = 0; k < 2; ++k) \
        acc[ai][bj][m][n] = __builtin_amdgcn_mfma_f32_16x16x32_bf16(Bt[n][k], At[m][k], acc[ai][bj][m][n], 0, 0, 0); __builtin_amdgcn_s_setprio(0); } while (0)
#define PG8_WAIT_V(n) asm volatile("s_waitcnt vmcnt(" #n ")" ::: "memory")
#define PG8_WAIT_L(n) asm volatile("s_waitcnt lgkmcnt(" #n ")" ::: "memory")
#define PG8_BAR __builtin_amdgcn_s_barrier()
#define PG8_SCHED __builtin_amdgcn_sched_barrier(0)
    Unit cur, nxt; int ui = 0;
    if (!S.next(0, cur)) return;
    f32x4 acc[2][2][4][2];
#pragma unroll
    for (int a = 0; a < 2; ++a)
#pragma unroll
        for (int b = 0; b < 2; ++b)
#pragma unroll
            for (int m = 0; m < 4; ++m)
#pragma unroll
                for (int n = 0; n < 2; ++n) acc[a][b][m][n] = (f32x4){0.f, 0.f, 0.f, 0.f};
    bf16x8 At[4][2], B0[2][2], B1[2][2];
    const char* cA = (const char*)g.A + (size_t)cur.pm * tstep; const char* cB = (const char*)g.Bt + (size_t)cur.pn * tstep;
    S.a_ready(cur);
    if constexpr (SP2) {
        PG8_STAGE(PG8_SB(0, 0), cB, voffB); PG8_STAGE(PG8_SB(0, 1), cB + hstep, voffB); PG8_STAGE(PG8_SA(0, 0), cA, voffA); PG8_STAGE(PG8_SA(0, 1), cA + hstep, voffA);
        if (wr == 1) PG8_BAR;
        PG8_WAIT_V(2); PG8_BAR;
        PG8_STAGE(PG8_SB(1, 0), cB + kstep, voffB); PG8_STAGE(PG8_SA(1, 0), cA + kstep, voffA); PG8_STAGE(PG8_SB(1, 1), cB + hstep + kstep, voffB);
        PG8_WAIT_V(6); PG8_BAR;
    } else {
        PG8_STAGE(PG8_SB(0, 0), cB, voffB); PG8_STAGE(PG8_SA(0, 0), cA, voffA); PG8_STAGE(PG8_SB(0, 1), cB + hstep, voffB); PG8_STAGE(PG8_SA(0, 1), cA + hstep, voffA);
        if (wr == 1) PG8_BAR;
        PG8_WAIT_V(4); PG8_BAR;
        PG8_STAGE(PG8_SB(1, 0), cB + kstep, voffB); PG8_STAGE(PG8_SA(1, 0), cA + kstep, voffA); PG8_STAGE(PG8_SB(1, 1), cB + hstep + kstep, voffB);
        PG8_WAIT_V(6); PG8_BAR;
    }
    for (;;) {
        const bool has_next = S.next(ui + 1, nxt);
        const char* nA = has_next ? (const char*)g.A + (size_t)nxt.pm * tstep : cA; const char* nB = has_next ? (const char*)g.Bt + (size_t)nxt.pn * tstep : cB;
        for (int t = 0; t < nt; t += 2) {
            const bool last = (t == nt - 2);
            const char* a1 = cA + (size_t)(t + 1) * kstep;
            const char* a2 = last ? nA : cA + (size_t)(t + 2) * kstep; const char* b2 = last ? nB : cB + (size_t)(t + 2) * kstep;
            const char* a3 = a2 + kstep; const char* b3 = b2 + kstep;
            if (last && has_next) S.a_ready(nxt);
            if constexpr (SP2) {
            PG8_LDB(B0, 0, 0); PG8_LDB(B1, 0, 1); PG8_SCHED; PG8_LDA(At, 0, 0); PG8_STAGE(PG8_SA(1, 1), a1 + hstep, voffA);
            PG8_WAIT_V(8); PG8_WAIT_L(0); PG8_BAR; PG8_MMA(0, 0, At, B0); PG8_MMA(0, 1, At, B1); PG8_BAR; PG8_SCHED;
            PG8_LDA(At, 0, 1); PG8_STAGE(PG8_SB(0, 0), b2, voffB); PG8_STAGE(PG8_SB(0, 1), b2 + hstep, voffB); PG8_STAGE(PG8_SA(0, 0), a2, voffA);
            PG8_WAIT_V(8); PG8_WAIT_L(0); PG8_BAR; PG8_MMA(1, 0, At, B0); PG8_MMA(1, 1, At, B1); PG8_BAR; PG8_SCHED;
            PG8_LDB(B0, 1, 0); PG8_LDB(B1, 1, 1); PG8_SCHED; PG8_LDA(At, 1, 0); PG8_STAGE(PG8_SA(0, 1), a2 + hstep, voffA);
            PG8_WAIT_V(8); PG8_WAIT_L(0); PG8_BAR; PG8_MMA(0, 0, At, B0); PG8_MMA(0, 1, At, B1); PG8_BAR; PG8_SCHED;
            PG8_LDA(At, 1, 1); PG8_STAGE(PG8_SB(1, 0), b3, voffB); PG8_STAGE(PG8_SB(1, 1), b3 + hstep, voffB); PG8_STAGE(PG8_SA(1, 0), a3, voffA);
            PG8_WAIT_V(8); PG8_WAIT_L(0); PG8_BAR; PG8_MMA(1, 0, At, B0); PG8_MMA(1, 1, At, B1); PG8_BAR; PG8_SCHED;
            } else {
            PG8_LDB(B0, 0, 0); PG8_SCHED; PG8_LDA(At, 0, 0); PG8_STAGE(PG8_SA(1, 1), a1 + hstep, voffA);
            PG8_WAIT_L(8); PG8_BAR; PG8_WAIT_L(0); PG8_MMA(0, 0, At, B0); PG8_BAR; PG8_SCHED;
            PG8_LDB(B1, 0, 1); PG8_STAGE(PG8_SB(0, 0), b2, voffB);
            PG8_BAR; PG8_WAIT_L(0); PG8_MMA(0, 1, At, B1); PG8_BAR;
            PG8_LDA(At, 0, 1); PG8_STAGE(PG8_SA(0, 0), a2, voffA);
            PG8_BAR; PG8_WAIT_L(0); PG8_MMA(1, 0, At, B0); PG8_BAR; PG8_SCHED;
            PG8_STAGE(PG8_SB(0, 1), b2 + hstep, voffB);
            PG8_WAIT_V(6); PG8_BAR; PG8_MMA(1, 1, At, B1); PG8_BAR;
            PG8_LDB(B0, 1, 0); PG8_SCHED; PG8_LDA(At, 1, 0); PG8_STAGE(PG8_SA(0, 1), a2 + hstep, voffA);
            PG8_WAIT_L(8); PG8_BAR; PG8_WAIT_L(0); PG8_MMA(0, 0, At, B0); PG8_BAR; PG8_SCHED;
            PG8_LDB(B1, 1, 1); PG8_STAGE(PG8_SB(1, 0), b3, voffB);
            PG8_BAR; PG8_WAIT_L(0); PG8_MMA(0, 1, At, B1); PG8_BAR;
            PG8_LDA(At, 1, 1); PG8_STAGE(PG8_SA(1, 0), a3, voffA);
            PG8_BAR; PG8_WAIT_L(0); PG8_MMA(1, 0, At, B0); PG8_BAR; PG8_SCHED;
            PG8_STAGE(PG8_SB(1, 1), b3 + hstep, voffB);
            PG8_WAIT_V(6); PG8_BAR; PG8_MMA(1, 1, At, B1); PG8_BAR;
            }
        }
        if constexpr (ALIGN_EPI) { if (wr == 0) PG8_BAR; }
        if constexpr (!Epi::AFTER_DRAIN) { E(acc, cur, wr, wc, fr, fq); S.done(cur); }
        if (!has_next) break;
#pragma unroll
        for (int a = 0; a < 2; ++a)
#pragma unroll
            for (int b = 0; b < 2; ++b)
#pragma unroll
                for (int m = 0; m < 4; ++m)
#pragma unroll
                    for (int n = 0; n < 2; ++n) acc[a][b][m][n] = (f32x4){0.f, 0.f, 0.f, 0.f};
        cur = nxt; cA = nA; cB = nB; ++ui;
        if constexpr (ALIGN_EPI) { if (wr == 1) PG8_BAR; }
    }
    PG8_WAIT_V(0);
    if constexpr (!ALIGN_EPI) { if (wr == 0) PG8_BAR; }
    PG8_BAR;
    if constexpr (Epi::AFTER_DRAIN) { E.fused(acc, cur, wr, wc, fr, fq, lds, wid, lane); S.done(cur); }
#undef PG8_SA
#undef PG8_SB
#undef PG8_STAGE
#undef PG8_LDA
#undef PG8_LDB
#undef PG8_MMA
#undef PG8_WAIT_V
#undef PG8_WAIT_L
#undef PG8_BAR
#undef PG8_SCHED
}
template <class Epi, class Sched, bool ALIGN_EPI = false, bool SP2 = false>
__device__ __forceinline__ void gemm_phase_ga(PG8_LAS unsigned char* lds, const Gemm g, const Sched& S, const Epi& E) {
    int tid_ = threadIdx.x; asm volatile("" : "+v"(tid_));
    const int tid = tid_, wid = __builtin_amdgcn_readfirstlane(tid >> 6), lane = tid & 63, wr = wid >> 2, wc = wid & 3, fr = lane & 15, fq = lane >> 4;
    const int K = g.K, nt = K / BK;
    static_assert(SP2, "gemm_phase_ga: SP2 loop only");
    unsigned voffA[2], voffB[2], colA[2]; int rowA[2];
#pragma unroll
    for (int i = 0; i < 2; ++i) { int R, C; stage_rc(tid * 16 + i * 8192, R, C); const int Rb = Epi::PERM ? ((R & ~31) + perm32(R & 31)) : R;
        voffA[i] = (unsigned)(R * K + C) * 2u; voffB[i] = (unsigned)(Rb * K + C) * 2u; rowA[i] = R; colA[i] = (unsigned)C * 2u; }
    const size_t kstep = (size_t)(BK * 2);
    const size_t hstep = (size_t)HALF * K * 2;
    const size_t tstep = 2 * hstep;
    const unsigned ldsw = (unsigned)wid * 1024u;
    const int aoff = lds_byte(wr * 64 + fr, fq * 8), boff = lds_byte(wc * 32 + fr, fq * 8);
#define PG8_SA(b, h) (((b) * 2 + (h)) * HTB)
#define PG8_SB(b, h) ((4 + (b) * 2 + (h)) * HTB)
#define PG8_STAGE(bufoff, gbase, voff) do { _Pragma("unroll") for (int _i = 0; _i < 2; ++_i) \
        __builtin_amdgcn_global_load_lds((const unsigned*)((const char*)(gbase) + (voff)[_i]), (PG8_LAS unsigned*)(lds + (bufoff) + ldsw + _i * 8192), 16, 0, 0); } while (0)
#define PG8_STAGE_A(bufoff, koff, V0, V1) do { \
        __builtin_amdgcn_global_load_lds((const unsigned*)(A0 + (koff) + (V0)), (PG8_LAS unsigned*)(lds + (bufoff) + ldsw), 16, 0, 0); \
        __builtin_amdgcn_global_load_lds((const unsigned*)(A0 + (koff) + (V1)), (PG8_LAS unsigned*)(lds + (bufoff) + ldsw + 8192), 16, 0, 0); } while (0)
#define PG8_FILLA(V, U) do { _Pragma("unroll") for (int h_ = 0; h_ < 2; ++h_) _Pragma("unroll") for (int i_ = 0; i_ < 2; ++i_) V[h_][i_] = S.row_byte(U, h_ * HALF + rowA[i_]) + colA[i_]; } while (0)
#define PG8_LDA(dst, b, h) do { _Pragma("unroll") for (int m = 0; m < 4; ++m) _Pragma("unroll") for (int k = 0; k < 2; ++k) dst[m][k] = *(const PG8_LAS bf16x8*)(lds + PG8_SA(b, h) + aoff + m * 2048 + k * 1024); } while (0)
#define PG8_LDB(dst, b, h) do { _Pragma("unroll") for (int n = 0; n < 2; ++n) _Pragma("unroll") for (int k = 0; k < 2; ++k) dst[n][k] = *(const PG8_LAS bf16x8*)(lds + PG8_SB(b, h) + boff + n * 2048 + k * 1024); } while (0)
#define PG8_MMA(ai, bj, At, Bt) do { __builtin_amdgcn_s_setprio(1); _Pragma("unroll") for (int m = 0; m < 4; ++m) _Pragma("unroll") for (int n = 0; n < 2; ++n) _Pragma("unroll") for (int k = 0; k < 2; ++k) \
        acc[ai][bj][m][n] = __builtin_amdgcn_mfma_f32_16x16x32_bf16(Bt[n][k], At[m][k], acc[ai][bj][m][n], 0, 0, 0); __builtin_amdgcn_s_setprio(0); } while (0)
#define PG8_WAIT_V(n) asm volatile("s_waitcnt vmcnt(" #n ")" ::: "memory")
#define PG8_WAIT_L(n) asm volatile("s_waitcnt lgkmcnt(" #n ")" ::: "memory")
#define PG8_BAR __builtin_amdgcn_s_barrier()
#define PG8_SCHED __builtin_amdgcn_sched_barrier(0)
    Unit cur, nxt; int ui = 0;
    if (!S.next(0, cur)) return;
    f32x4 acc[2][2][4][2];
#pragma unroll
    for (int a = 0; a < 2; ++a)
#pragma unroll
        for (int b = 0; b < 2; ++b)
#pragma unroll
            for (int m = 0; m < 4; ++m)
#pragma unroll
                for (int n = 0; n < 2; ++n) acc[a][b][m][n] = (f32x4){0.f, 0.f, 0.f, 0.f};
    bf16x8 At[4][2], B0[2][2], B1[2][2];
    const char* A0 = (const char*)g.A; const char* cB = (const char*)g.Bt + (size_t)cur.pn * tstep;
    unsigned cv[2][2], nv[2][2];
    PG8_FILLA(cv, cur);
    S.a_ready(cur);
    if constexpr (SP2) {
        PG8_STAGE(PG8_SB(0, 0), cB, voffB); PG8_STAGE(PG8_SB(0, 1), cB + hstep, voffB); PG8_STAGE_A(PG8_SA(0, 0), 0, cv[0][0], cv[0][1]); PG8_STAGE_A(PG8_SA(0, 1), 0, cv[1][0], cv[1][1]);
        if (wr == 1) PG8_BAR;
        PG8_WAIT_V(2); PG8_BAR;
        PG8_STAGE(PG8_SB(1, 0), cB + kstep, voffB); PG8_STAGE_A(PG8_SA(1, 0), kstep, cv[0][0], cv[0][1]); PG8_STAGE(PG8_SB(1, 1), cB + hstep + kstep, voffB);
        PG8_WAIT_V(6); PG8_BAR;
    } else {
        PG8_STAGE(PG8_SB(0, 0), cB, voffB); PG8_STAGE_A(PG8_SA(0, 0), 0, cv[0][0], cv[0][1]); PG8_STAGE(PG8_SB(0, 1), cB + hstep, voffB); PG8_STAGE_A(PG8_SA(0, 1), 0, cv[1][0], cv[1][1]);
        if (wr == 1) PG8_BAR;
        PG8_WAIT_V(4); PG8_BAR;
        PG8_STAGE(PG8_SB(1, 0), cB + kstep, voffB); PG8_STAGE_A(PG8_SA(1, 0), kstep, cv[0][0], cv[0][1]); PG8_STAGE(PG8_SB(1, 1), cB + hstep + kstep, voffB);
        PG8_WAIT_V(6); PG8_BAR;
    }
    for (;;) {
        const bool has_next = S.next(ui + 1, nxt);
        const char* nB = has_next ? (const char*)g.Bt + (size_t)nxt.pn * tstep : cB;
        if (has_next && nxt.pm != cur.pm) PG8_FILLA(nv, nxt);
        else { nv[0][0] = cv[0][0]; nv[0][1] = cv[0][1]; nv[1][0] = cv[1][0]; nv[1][1] = cv[1][1]; }
        for (int t = 0; t < nt; t += 2) {
            const bool last = (t == nt - 2);
            const size_t k1 = (size_t)(t + 1) * kstep, k2 = last ? (size_t)0 : (size_t)(t + 2) * kstep; const char* b2 = last ? nB : cB + (size_t)(t + 2) * kstep;
            const unsigned w00 = last ? nv[0][0] : cv[0][0], w01 = last ? nv[0][1] : cv[0][1], w10 = last ? nv[1][0] : cv[1][0], w11 = last ? nv[1][1] : cv[1][1];
            const char* b3 = b2 + kstep;
            if (last && has_next) S.a_ready(nxt);
            if constexpr (SP2) {
            PG8_LDB(B0, 0, 0); PG8_LDB(B1, 0, 1); PG8_SCHED; PG8_LDA(At, 0, 0); PG8_STAGE_A(PG8_SA(1, 1), k1, cv[1][0], cv[1][1]);
            PG8_WAIT_V(8); PG8_WAIT_L(0); PG8_BAR; PG8_MMA(0, 0, At, B0); PG8_MMA(0, 1, At, B1); PG8_BAR; PG8_SCHED;
            PG8_LDA(At, 0, 1); PG8_STAGE(PG8_SB(0, 0), b2, voffB); PG8_STAGE(PG8_SB(0, 1), b2 + hstep, voffB); PG8_STAGE_A(PG8_SA(0, 0), k2, w00, w01);
            PG8_WAIT_V(8); PG8_WAIT_L(0); PG8_BAR; PG8_MMA(1, 0, At, B0); PG8_MMA(1, 1, At, B1); PG8_BAR; PG8_SCHED;
            PG8_LDB(B0, 1, 0); PG8_LDB(B1, 1, 1); PG8_SCHED; PG8_LDA(At, 1, 0); PG8_STAGE_A(PG8_SA(0, 1), k2, w10, w11);
            PG8_WAIT_V(8); PG8_WAIT_L(0); PG8_BAR; PG8_MMA(0, 0, At, B0); PG8_MMA(0, 1, At, B1); PG8_BAR; PG8_SCHED;
            PG8_LDA(At, 1, 1); PG8_STAGE(PG8_SB(1, 0), b3, voffB); PG8_STAGE(PG8_SB(1, 1), b3 + hstep, voffB); PG8_STAGE_A(PG8_SA(1, 0), k2 + kstep, w00, w01);
            PG8_WAIT_V(8); PG8_WAIT_L(0); PG8_BAR; PG8_MMA(1, 0, At, B0); PG8_MMA(1, 1, At, B1); PG8_BAR; PG8_SCHED;
            } else {
            PG8_LDB(B0, 0, 0); PG8_SCHED; PG8_LDA(At, 0, 0); PG8_STAGE_A(PG8_SA(1, 1), k1, cv[1][0], cv[1][1]);
            PG8_WAIT_L(8); PG8_BAR; PG8_WAIT_L(0); PG8_MMA(0, 0, At, B0); PG8_BAR; PG8_SCHED;
            PG8_LDB(B1, 0, 1); PG8_STAGE(PG8_SB(0, 0), b2, voffB);
            PG8_BAR; PG8_WAIT_L(0); PG8_MMA(0, 1, At, B1); PG8_BAR;
            PG8_LDA(At, 0, 1); PG8_STAGE_A(PG8_SA(0, 0), k2, w00, w01);
            PG8_BAR; PG8_WAIT_L(0); PG8_MMA(1, 0, At, B0); PG8_BAR; PG8_SCHED;
            PG8_STAGE(PG8_SB(0, 1), b2 + hstep, voffB);
            PG8_WAIT_V(6); PG8_BAR; PG8_MMA(1, 1, At, B1); PG8_BAR;
            PG8_LDB(B0, 1, 0); PG8_SCHED; PG8_LDA(At, 1, 0); PG8_STAGE_A(PG8_SA(0, 1), k2, w10, w11);
            PG8_WAIT_L(8); PG8_BAR; PG8_WAIT_L(0); PG8_MMA(0, 0, At, B0); PG8_BAR; PG8_SCHED;
            PG8_LDB(B1, 1, 1); PG8_STAGE(PG8_SB(1, 0), b3, voffB);
            PG8_BAR; PG8_WAIT_L(0); PG8_MMA(0, 1, At, B1); PG8_BAR;
            PG8_LDA(At, 1, 1); PG8_STAGE_A(PG8_SA(1, 0), k2 + kstep, w00, w01);
            PG8_BAR; PG8_WAIT_L(0); PG8_MMA(1, 0, At, B0); PG8_BAR; PG8_SCHED;
            PG8_STAGE(PG8_SB(1, 1), b3 + hstep, voffB);
            PG8_WAIT_V(6); PG8_BAR; PG8_MMA(1, 1, At, B1); PG8_BAR;
            }
        }
        if constexpr (ALIGN_EPI) { if (wr == 0) PG8_BAR; }
        if constexpr (!Epi::AFTER_DRAIN) { E(acc, cur, wr, wc, fr, fq); S.done(cur); }
        if (!has_next) break;
#pragma unroll
        for (int a = 0; a < 2; ++a)
#pragma unroll
            for (int b = 0; b < 2; ++b)
#pragma unroll
                for (int m = 0; m < 4; ++m)
#pragma unroll
                    for (int n = 0; n < 2; ++n) acc[a][b][m][n] = (f32x4){0.f, 0.f, 0.f, 0.f};
        cur = nxt; cB = nB; ++ui; cv[0][0] = nv[0][0]; cv[0][1] = nv[0][1]; cv[1][0] = nv[1][0]; cv[1][1] = nv[1][1];
        if constexpr (ALIGN_EPI) { if (wr == 1) PG8_BAR; }
    }
    PG8_WAIT_V(0);
    if constexpr (!ALIGN_EPI) { if (wr == 0) PG8_BAR; }
    PG8_BAR;
    if constexpr (Epi::AFTER_DRAIN) { E.fused(acc, cur, wr, wc, fr, fq, lds, wid, lane); S.done(cur); }
#undef PG8_SA
#undef PG8_SB
#undef PG8_STAGE
#undef PG8_STAGE_A
#undef PG8_FILLA
#undef PG8_LDA
#undef PG8_LDB
#undef PG8_MMA
#undef PG8_WAIT_V
#undef PG8_WAIT_L
#undef PG8_BAR
#undef PG8_SCHED
}
}

constexpr int NB = 8, SEQ = 4096, D = 1024, T = NB * SEQ, DEPTH = 2;
constexpr int INW = 3224, PW = 3328;
constexpr int FF = 2816, FFE = 3584, NEXP = 8;
constexpr int NWAVES = 8, NTHR = 512;
constexpr float NORM_EPS = 1e-6f, LOG2E = 1.4426950408889634f, QSCALE = 0.125f * 1.4426950408889634f;
constexpr int C_MQ = 0, C_MK = 256, C_MV = 512, C_MO = 768, C_FQ = 1024, C_FK = 1280, C_FV = 1536, C_SQ = 1792, C_SK = 2048, C_SV = 2304,
              C_NQ = 2560, C_KC = 2816, C_VC = 2880, C_KS = 2944, C_VS = 3008, C_KW = 3072, C_VW = 3136, C_MIF = 3200, C_FF = 3208, C_NG = 3212;
__host__ __device__ __forceinline__ int map_in_col(int c) {
    if (c < 1024) return c;
    if (c < 1792) return 1032 + (c - 1024);
    if (c < 2560) return 1804 + (c - 1792);
    if (c < 2816) return 2572 + (c - 2560);
    if (c < 3200) return 2828 + (c - 2816);
    if (c < 3208) return 1024 + (c - 3200);
    if (c < 3212) return 1800 + (c - 3208);
    if (c < 3224) return 3212 + (c - 3212);
    return -1;
}
constexpr size_t MiB = 1u << 20;
constexpr size_t WS_CTL = 0, CTL_ZERO_BYTES = 1 * MiB;
constexpr size_t WS_MODP = 1 * MiB;
constexpr size_t WS_MOD = 7 * MiB;
constexpr size_t WS_BL = 7 * MiB + 512 * 1024;
constexpr size_t WS_KCMP = 8 * MiB, WS_VCMP = 8 * MiB + 256 * 1024;
constexpr size_t WS_GB = 8 * MiB + 512 * 1024, WS_GI = 9 * MiB, WS_FLOC = 9 * MiB + 512 * 1024, WS_F2 = 10 * MiB;
constexpr size_t WS_G = 10 * MiB + 512 * 1024, WS_MLOC = WS_G + 8192, WS_MPREV = WS_G + 16384, WS_FTOT = WS_G + 24576;
constexpr size_t WS_NCH = 11 * MiB;
constexpr size_t WS_NG = 12 * MiB;
constexpr size_t WS_TOKOF = 14 * MiB, WS_TOKW = 15 * MiB;
constexpr size_t WS_ROWTOK = 16 * MiB, WS_ROWW = 16 * MiB + 512 * 1024;
constexpr size_t WS_WCT = 17 * MiB;
constexpr size_t WS_P0 = WS_BL + 4096;
constexpr size_t WS_GT = WS_BL + 8192;
constexpr size_t WS_U = 1 * MiB;
constexpr size_t WS_WIN = 18 * MiB;
constexpr size_t WS_WOUT = 31 * MiB;
constexpr size_t WS_WGU = 35 * MiB;
constexpr size_t WS_WD = 46 * MiB;
constexpr size_t WS_MWGU = 52 * MiB;
constexpr size_t WS_MWD = 164 * MiB;
constexpr size_t WS_H = 220 * MiB;
constexpr size_t WS_QKC = WS_H, WS_STATE = WS_H + 32 * MiB;
constexpr size_t WS_PROJ = 284 * MiB;
constexpr size_t WS_MIX = 492 * MiB;
constexpr size_t WS_ACT = WS_PROJ;
constexpr size_t WS_Y1 = WS_PROJ;
constexpr size_t WS_ACTE = WS_PROJ + 132 * MiB;
constexpr size_t WS_ACT2 = WS_ACTE + 112 * MiB;
constexpr size_t WS_END = 556 * MiB;
static_assert(WS_ACT2 + (size_t)8 * 256 * 3584 * 2 <= WS_END && WS_ACTE + (size_t)16384 * 3584 * 2 <= WS_ACT2 && WS_Y1 + (size_t)T * D * 2 <= WS_ACTE, "ws map");
constexpr int CHUNK_TILES = 64;
constexpr int CW_TMO = 0, CW_QUEUE = 64, CW_ECNT = 512, CW_BAR = 4096;
constexpr int LDS_BYTES = 160 * 1024, MISC_OFF = LDS_BYTES - 512;

#define GAS __attribute__((address_space(1)))
#define LAS __attribute__((address_space(3)))
#define DI __device__ __forceinline__
typedef unsigned short bf16;
typedef unsigned v4u __attribute__((ext_vector_type(4)));
typedef unsigned v2u __attribute__((ext_vector_type(2)));
typedef float f32x4 __attribute__((ext_vector_type(4)));
typedef float f32x16 __attribute__((ext_vector_type(16)));
typedef short bf16x8 __attribute__((ext_vector_type(8)));
typedef short s16x4 __attribute__((ext_vector_type(4)));
typedef GAS unsigned gu32;
#define RLX_AGENT __ATOMIC_RELAXED, __HIP_MEMORY_SCOPE_AGENT
DI float bf2f(bf16 v) { return __uint_as_float(((unsigned)v) << 16); }
DI float bflo(unsigned w) { return __uint_as_float(w << 16); }
DI float bfhi(unsigned w) { return __uint_as_float(w & 0xffff0000u); }
DI unsigned pk2(float lo, float hi) { typedef float f2_t __attribute__((ext_vector_type(2))); typedef __bf16 b2_t __attribute__((ext_vector_type(2))); f2_t v = {lo, hi}; b2_t b = __builtin_convertvector(v, b2_t); return __builtin_bit_cast(unsigned, b); }
DI bf16 f2bf(float f) { return (bf16)(pk2(f, 0.f) & 0xffffu); }
DI float ex2(float x) { return __builtin_amdgcn_exp2f(x); }
DI float lg2(float x) { return __builtin_amdgcn_logf(x); }
DI float rcp(float x) { return __builtin_amdgcn_rcpf(x); }
DI float wave_sum(float v) {
#pragma unroll
    for (int o = 1; o < 64; o <<= 1) v += __shfl_xor(v, o);
    return v;
}
DI float wave_max(float v) {
#pragma unroll
    for (int o = 1; o < 64; o <<= 1) v = fmaxf(v, __shfl_xor(v, o));
    return v;
}
DI float log_sigmoid(float x) { return fminf(x, 0.f) - 0.6931471805599453f * lg2(1.0f + ex2(-fabsf(x) * LOG2E)); }
DI float sigmoid_f(float x) { return rcp(1.0f + ex2(-x * LOG2E)); }
DI float silu(float x) { return x * sigmoid_f(x); }
#define BLOCK_SYNC() __syncthreads()
#define LDS_BARRIER() asm volatile("s_waitcnt lgkmcnt(0)\n\ts_barrier" ::: "memory")
typedef short v4i16_tr __attribute__((ext_vector_type(4)));
DI s16x4 att_trr(LAS const char* p) { return __builtin_bit_cast(s16x4, __builtin_amdgcn_ds_read_tr16_b64_v4i16((LAS v4i16_tr*)p)); }
#define XB_TMO      128
#define XB_XCNT(j)  (256  + 64 * (j))
#define XB_XSUB(j)  (1280 + 64 * (j))
#define XB_XGEN(j)  (2304 + 64 * (j))
#define XB_TOP      3328
#define XB_TOPGEN   3392
#define XCD_BAR_WORDS 3456
#define XB_SPIN_CAP (1u << 18)

__device__ __forceinline__ unsigned xb_ld(unsigned* p)              { return __hip_atomic_load(p, __ATOMIC_RELAXED, __HIP_MEMORY_SCOPE_AGENT); }
__device__ __forceinline__ unsigned xb_add(unsigned* p, unsigned v) { return __hip_atomic_fetch_add(p, v, __ATOMIC_RELAXED, __HIP_MEMORY_SCOPE_AGENT); }
__device__ __forceinline__ unsigned xb_xcc_id() { return (unsigned)__builtin_amdgcn_s_getreg((3 << 11) | 20) & 0xFu; }
#define XB_SPIN(cond, bar) do { unsigned _sp = 0; while (cond) { __builtin_amdgcn_s_sleep(1); \
    if ((++_sp & 255u) == 0u) { if (xb_ld(&(bar)[XB_TMO])) break; if (_sp > XB_SPIN_CAP) { atomicAdd(&(bar)[XB_TMO], 1u); break; } } } } while (0)

struct XcdBarrier {
    unsigned* bar; unsigned x;
    volatile LAS unsigned* st;
};

__device__ __forceinline__ XcdBarrier xcd_barrier_post(unsigned* bar, volatile LAS unsigned* st) {
    XcdBarrier b; b.bar = bar; b.x = xb_xcc_id(); b.st = st;
    if (threadIdx.x == 0) (void)xb_add(&bar[XB_XCNT(b.x)], 1u);
    return b;
}
__device__ __forceinline__ void xcd_barrier_complete(unsigned* bar, unsigned x, unsigned& nloc, unsigned& nx) {
    const unsigned G = gridDim.x * gridDim.y * gridDim.z;
    unsigned sum, cnt, mine, sp = 0u;
    for (;;) {
        sum = 0u; cnt = 0u; mine = 0u;
#pragma unroll
        for (unsigned j = 0; j < 16; ++j) { const unsigned c = xb_ld(&bar[XB_XCNT(j)]); sum += c; cnt += (c > 0u) ? 1u : 0u; mine = (j == x) ? c : mine; }
        if (sum == G) break;
        __builtin_amdgcn_s_sleep(1);
        if ((++sp & 255u) == 0u) { if (xb_ld(&bar[XB_TMO])) break; if (sp > XB_SPIN_CAP) { atomicAdd(&bar[XB_TMO], 1u); break; } }
    }
    nloc = mine > 0u ? mine : 1u; nx = cnt > 0u ? cnt : 1u;
}

__device__ __forceinline__ void xcd_barrier(const XcdBarrier& b) {
    asm volatile("s_waitcnt vmcnt(0)" ::: "memory");
    __syncthreads();
    if (threadIdx.x == 0) {
        unsigned* bar = b.bar;
        __builtin_amdgcn_s_waitcnt(0);
        unsigned nloc = b.st[0], nx = b.st[1];
        if (nloc == 0u) { xcd_barrier_complete(bar, b.x, nloc, nx); b.st[0] = nloc; b.st[1] = nx; }
        const unsigned old = xb_add(&bar[XB_XSUB(b.x)], 1u);
        const unsigned gen = old / nloc;
        if (old + 1u == (gen + 1u) * nloc) {
            __builtin_amdgcn_fence(__ATOMIC_RELEASE, "agent");
            asm volatile("s_waitcnt vmcnt(0)" ::: "memory");
            const unsigned og = xb_add(&bar[XB_TOP], 1u);
            const unsigned tg = og / nx;
            if (og + 1u == (tg + 1u) * nx) xb_add(&bar[XB_TOPGEN], 1u);
            else XB_SPIN(xb_ld(&bar[XB_TOPGEN]) == tg, bar);
            __builtin_amdgcn_fence(__ATOMIC_ACQUIRE, "agent");
            xb_add(&bar[XB_XGEN(b.x)], 1u);
            asm volatile("s_waitcnt vmcnt(0)" ::: "memory");
        } else {
            XB_SPIN(xb_ld(&bar[XB_XGEN(b.x)]) == gen, bar);
            __builtin_amdgcn_fence(__ATOMIC_ACQUIRE, "agent");
            asm volatile("s_waitcnt vmcnt(0)" ::: "memory");
        }
    }
    __syncthreads();
}

struct Ctx {
    LAS unsigned char* lds;
    volatile LAS unsigned* MISC;
    gu32* ctl;
    int tid, lane, wave, G, blk;
    float* out; unsigned char* ws;
    const void __attribute__((address_space(4)))* ka;
};
#define WSP(T_, off) ((T_*)(C.ws + (off)))
#define KIN(k) (((const float* const __attribute__((address_space(4)))*)C.ka)[k])

DI void tr_load(float (&v_)[32], const float* W, int ldw, int k0, int sc, int lane) {
    const GAS float* wp_ = (const GAS float*)(W + (size_t)(k0 + (lane >> 5)) * ldw + (sc >= 0 ? sc : 0));
#pragma unroll
    for (int i = 0; i < 32; ++i) v_[i] = wp_[(size_t)(2 * i) * ldw];
}
DI void tr_finish(const float (&v_)[32], int sc, int k0, bf16* WT, int ldt, int dstrow0, LAS float* scr, int lane) {
#pragma unroll
    for (int i = 0; i < 32; ++i) scr[(2 * i + (lane >> 5)) * 33 + (lane & 31)] = sc >= 0 ? v_[i] : 0.f;
    asm volatile("s_waitcnt lgkmcnt(0)" ::: "memory");
    const int c = lane & 7;
#pragma unroll
    for (int j = 0; j < 4; ++j) { const int n = (lane >> 3) + 8 * j; const LAS float* s = scr + (8 * c) * 33 + n;
        v4u o; o.x = pk2(s[0 * 33], s[1 * 33]); o.y = pk2(s[2 * 33], s[3 * 33]); o.z = pk2(s[4 * 33], s[5 * 33]); o.w = pk2(s[6 * 33], s[7 * 33]);
        *(GAS v4u*)(WT + (size_t)(dstrow0 + n) * ldt + k0 + 8 * c) = o; }
    asm volatile("s_waitcnt lgkmcnt(0)" ::: "memory");
}
DI void tr_item(const float* W, int ldw, int k0, int sc, bf16* WT, int ldt, int dstrow0, LAS float* scr, int lane) {
    float v_[32];
    tr_load(v_, W, ldw, k0, sc, lane);
    tr_finish(v_, sc, k0, WT, ldt, dstrow0, scr, lane);
}
DI void p_prologue(Ctx& C) {
    const int gw = C.blk * NWAVES + C.wave, NGW = C.G * NWAVES, lane = C.lane;
    LAS float* SC = (LAS float*)(C.lds + 96 * 1024);
    for (int i = C.tid; i < NB * D; i += NTHR) SC[i] = silu(KIN(1)[i]);
    BLOCK_SYNC();
    {
        float* MODP = WSP(float, WS_MODP);
        for (int it = gw; it < 2 * 96 * 16; it += NGW) {
            const int ks = it & 15, nb = (it >> 4) % 96, l = it / (16 * 96);
            const int n = nb * 64 + lane; const float* wp = KIN(3) + (size_t)l * D * 6144 + (size_t)(ks * 64) * 6144 + n;
            float acc[8];
#pragma unroll
            for (int b = 0; b < 8; ++b) acc[b] = 0.f;
#pragma unroll 16
            for (int k = 0; k < 64; ++k) { const float w = wp[(size_t)k * 6144];
#pragma unroll
                for (int b = 0; b < 8; ++b) acc[b] += SC[b * D + ks * 64 + k] * w; }
#pragma unroll
            for (int b = 0; b < 8; ++b) MODP[(((size_t)ks * 2 + l) * 8 + b) * 6144 + n] = acc[b];
        }
    }
    if (C.blk == 0 && C.tid < 129) {
        const int n = C.tid; int bucket;
        if (n < 16) bucket = n; else { const int large = 16 + (int)(logf((float)n / 16.0f) / 2.0794415416798357f * 16.0f); bucket = large < 31 ? large : 31; }
        if (n == 128) bucket = 31;
        float* BL = WSP(float, WS_BL);
#pragma unroll
        for (int h = 0; h < 4; ++h) BL[h * 132 + n] = KIN(2)[bucket * 4 + h] * LOG2E;
    }
    if (C.blk == 1 && C.tid < 128) { const int l = C.tid >> 6, d = C.tid & 63; float* gt = WSP(float, WS_GT) + l * 384 + d;
        gt[0] = KIN(13)[l * 64 + d] * QSCALE; gt[64] = KIN(14)[l * 64 + d]; gt[128] = QSCALE; gt[192] = KIN(15)[l * 64 + d] * QSCALE;
        gt[256] = KIN(16)[l * 192 + 64 + d]; gt[320] = KIN(16)[l * 192 + 128 + d]; }
    if (gw >= NGW - 4) { const int q = gw - (NGW - 4), l = q >> 1, kv = q & 1; const float* W = (kv ? KIN(19) : KIN(18)) + (size_t)l * 2048 * 64 + lane; const float* pos = KIN(17) + (size_t)l * 2048;
        float a0 = 0.f, a1 = 0.f, a2 = 0.f, a3 = 0.f;
#pragma unroll 4
        for (int i = 0; i < 2048; i += 4) { a0 += pos[i] * W[(size_t)i * 64]; a1 += pos[i + 1] * W[(size_t)(i + 1) * 64]; a2 += pos[i + 2] * W[(size_t)(i + 2) * 64]; a3 += pos[i + 3] * W[(size_t)(i + 3) * 64]; }
        WSP(float, WS_P0)[(l * 2 + kv) * 64 + lane] = (a0 + a1) + (a2 + a3); }
    LAS float* scr = (LAS float*)(C.lds + C.wave * 8448);
    constexpr int I_IN = 16 * (PW / 32), I_OUT = 16 * 32, I_GU = 16 * (2 * FF / 32), I_D = (FF / 64) * 32;
    constexpr int I_WC = 2 * 2 * 2 * 16 * 2;
    constexpr int NITEMS = 2 * I_IN + 2 * I_OUT + I_GU + I_D + I_WC;
    for (int it = gw; it < NITEMS; it += NGW) {
        int r = it;
        if (r < 2 * I_IN) { const int l = r / I_IN; r -= l * I_IN; const int nblk = PW / 32, kb = r / nblk, nb = r % nblk;
            tr_item(KIN(7) + (size_t)l * D * INW, INW, 64 * kb, map_in_col(32 * nb + (lane & 31)), WSP(bf16, WS_WIN) + (size_t)l * PW * D, D, 32 * nb, scr, lane); continue; }
        r -= 2 * I_IN;
        if (r < 2 * I_OUT) { const int l = r / I_OUT; r -= l * I_OUT; const int kb = r / 32, nb = r % 32;
            tr_item(KIN(8) + (size_t)l * D * D, D, 64 * kb, 32 * nb + (lane & 31), WSP(bf16, WS_WOUT) + (size_t)l * D * D, D, 32 * nb, scr, lane); continue; }
        r -= 2 * I_OUT;
        if (r < I_GU) { const int nblk = 2 * FF / 32, kb = r / nblk, nb = r % nblk; const int pn = nb >> 3, jb = nb & 7;
            tr_item(jb < 4 ? KIN(21) : KIN(22), FF, 64 * kb, pn * 128 + (jb & 3) * 32 + (lane & 31), WSP(bf16, WS_WGU), D, 32 * nb, scr, lane); continue; }
        r -= I_GU;
        if (r < I_D) { const int kb = r / 32, nb = r % 32;
            tr_item(KIN(23), D, 64 * kb, 32 * nb + (lane & 31), WSP(bf16, WS_WD), FF, 32 * nb, scr, lane); continue; }
        r -= I_D;
        { const int nb = r & 1, kb = (r >> 1) & 15, a = (r >> 5) & 1, kv = (r >> 6) & 1, l = r >> 7;
            tr_item((kv ? KIN(19) : KIN(18)) + (size_t)l * 2048 * 64 + (size_t)a * 1024 * 64, 64, 64 * kb, 32 * nb + (lane & 31), WSP(bf16, WS_WCT) + (size_t)(l * 2 + kv) * 128 * 1024, 1024, a * 64 + 32 * nb, scr, lane); }
    }
}
constexpr int MOE_I_MGU = 16 * (2 * FFE / 32), MOE_I_MD = (FFE / 64) * 32, MOE_CONV_ITEMS = NEXP * (MOE_I_MGU + MOE_I_MD);
struct ConvIt { const float* W; int ldw, k0, sc, ldt, dstrow0; bf16* WT; };
DI ConvIt moe_conv_decode(Ctx& C, int r) {
    const int lane = C.lane; ConvIt q;
    if (r < NEXP * MOE_I_MGU) { const int e = r / MOE_I_MGU; r -= e * MOE_I_MGU; const int nblk = 2 * FFE / 32, kb = r / nblk, nb = r % nblk; const int pn = nb >> 3, jb = nb & 7;
        q.W = (jb < 4 ? KIN(26) : KIN(27)) + (size_t)e * D * FFE; q.ldw = FFE; q.k0 = 64 * kb; q.sc = pn * 128 + (jb & 3) * 32 + (lane & 31); q.WT = WSP(bf16, WS_MWGU) + (size_t)e * 2 * FFE * D; q.ldt = D; q.dstrow0 = 32 * nb; return q; }
    r -= NEXP * MOE_I_MGU;
    { const int e = r / MOE_I_MD; r -= e * MOE_I_MD; const int kb = r / 32, nb = r % 32;
        q.W = KIN(28) + (size_t)e * FFE * D; q.ldw = D; q.k0 = 64 * kb; q.sc = 32 * nb + (lane & 31); q.WT = WSP(bf16, WS_MWD) + (size_t)e * D * FFE; q.ldt = FFE; q.dstrow0 = 32 * nb; return q; }
}
DI void moe_conv_items4(Ctx& C, int r0, LAS float* scr) {
    const ConvIt q0 = moe_conv_decode(C, r0), q1 = moe_conv_decode(C, r0 + 1), q2 = moe_conv_decode(C, r0 + 2), q3 = moe_conv_decode(C, r0 + 3);
    float v0[32], v1[32], v2[32], v3[32];
    tr_load(v0, q0.W, q0.ldw, q0.k0, q0.sc, C.lane); tr_load(v1, q1.W, q1.ldw, q1.k0, q1.sc, C.lane); tr_load(v2, q2.W, q2.ldw, q2.k0, q2.sc, C.lane); tr_load(v3, q3.W, q3.ldw, q3.k0, q3.sc, C.lane);
    tr_finish(v0, q0.sc, q0.k0, q0.WT, q0.ldt, q0.dstrow0, scr, C.lane); tr_finish(v1, q1.sc, q1.k0, q1.WT, q1.ldt, q1.dstrow0, scr, C.lane);
    tr_finish(v2, q2.sc, q2.k0, q2.WT, q2.ldt, q2.dstrow0, scr, C.lane); tr_finish(v3, q3.sc, q3.k0, q3.WT, q3.ldt, q3.dstrow0, scr, C.lane);
}
DI void p_modfin(Ctx& C) {
    const float* MODP = WSP(float, WS_MODP); float* MOD = WSP(float, WS_MOD);
    for (int i = C.blk * NTHR + C.tid; i < 2 * 8 * 6144; i += C.G * NTHR) {
        const int n = i % 6144, l = i / (8 * 6144); float s = KIN(4)[l * 6144 + n];
#pragma unroll
        for (int ks = 0; ks < 16; ++ks) s += MODP[(size_t)ks * (2 * 8 * 6144) + i];
        MOD[i] = s;
    }
}

template <bool ROUTE> DI void p_norm(Ctx& C, int l, const float* xin, const float* gain, int off_sh, int off_sc) {
    const int lane = C.lane; bf16* H = WSP(bf16, WS_H);
    const int rows_per_blk = T / C.G;
    const int m_base = C.blk * rows_per_blk, b = m_base >> 12;
    const float* MOD = WSP(float, WS_MOD) + (size_t)(l * 8 + b) * 6144;
    f32x4 gs[4], sh[4];
#pragma unroll
    for (int j = 0; j < 4; ++j) { const int c0 = 4 * lane + 256 * j; const f32x4 g = *(const f32x4*)(gain + c0), sc = *(const f32x4*)(MOD + off_sc + c0); gs[j] = g * (sc + 1.0f); sh[j] = *(const f32x4*)(MOD + off_sh + c0); }
    LAS int* cntL = (LAS int*)(C.lds);
    LAS int* baseL = (LAS int*)(C.lds + 64);
    LAS int* recE = (LAS int*)(C.lds + 1024);
    LAS int* recS = (LAS int*)(C.lds + 1024 + 2048);
    LAS float* recW = (LAS float*)(C.lds + 1024 + 4096);
    LAS float* RW = (LAS float*)(C.lds + 8192);
    if (ROUTE) { if (C.tid < 8) cntL[C.tid] = 0; for (int i = C.tid; i < D * 8 / 4; i += NTHR) *(LAS f32x4*)(RW + 4 * i) = *(const f32x4*)(KIN(24) + 4 * i); BLOCK_SYNC(); }
    f32x4 vn[4];
    { const GAS f32x4* xr0 = (const GAS f32x4*)(xin + (size_t)(m_base + C.wave) * D) + lane;
#pragma unroll
      for (int j = 0; j < 4; ++j) vn[j] = xr0[64 * j]; }
    for (int r = C.wave; r < rows_per_blk; r += NWAVES) {
        const int m = m_base + r;
        f32x4 v[4]; float s = 0.f;
#pragma unroll
        for (int j = 0; j < 4; ++j) v[j] = vn[j];
        if (r + NWAVES < rows_per_blk) { const GAS f32x4* xr1 = (const GAS f32x4*)(xin + (size_t)(m + NWAVES) * D) + lane;
#pragma unroll
            for (int j = 0; j < 4; ++j) vn[j] = xr1[64 * j]; }
#pragma unroll
        for (int j = 0; j < 4; ++j) s += (v[j].x * v[j].x + v[j].y * v[j].y) + (v[j].z * v[j].z + v[j].w * v[j].w);
        const float rstd = 1.0f / sqrtf(wave_sum(s) * (1.0f / D) + NORM_EPS);
        v2u* o8 = (v2u*)(H + (size_t)m * D) + lane;
#pragma unroll
        for (int j = 0; j < 4; ++j) { v[j] = v[j] * rstd * gs[j] + sh[j]; v2u w; w.x = pk2(v[j].x, v[j].y); w.y = pk2(v[j].z, v[j].w); o8[64 * j] = w; }
        if (ROUTE) {
            float lg[8];
#pragma unroll
            for (int e = 0; e < 8; ++e) lg[e] = 0.f;
#pragma unroll
            for (int j = 0; j < 4; ++j)
#pragma unroll
                for (int i = 0; i < 4; ++i) { const LAS float* rw = RW + (4 * lane + 256 * j + i) * 8; const f32x4 w0 = *(const LAS f32x4*)rw, w1 = *(const LAS f32x4*)(rw + 4); const float hv = v[j][i];
                    lg[0] += hv * w0.x; lg[1] += hv * w0.y; lg[2] += hv * w0.z; lg[3] += hv * w0.w; lg[4] += hv * w1.x; lg[5] += hv * w1.y; lg[6] += hv * w1.z; lg[7] += hv * w1.w; }
#pragma unroll
            for (int e = 0; e < 8; ++e) lg[e] = wave_sum(lg[e]) + KIN(25)[e];
            int e0 = 0; float l0 = lg[0];
#pragma unroll
            for (int e = 1; e < 8; ++e) if (lg[e] > l0) { l0 = lg[e]; e0 = e; }
            int e1 = -1; float l1 = -3.0e38f;
#pragma unroll
            for (int e = 0; e < 8; ++e) if (e != e0 && lg[e] > l1) { l1 = lg[e]; e1 = e; }
            const float p1 = ex2((l1 - l0) * LOG2E), w0 = 1.0f / (1.0f + p1), w1 = p1 * w0;
            if (lane == 0) { const int s0 = atomicAdd((int*)&cntL[e0], 1), s1 = atomicAdd((int*)&cntL[e1], 1);
                recE[2 * r] = e0; recE[2 * r + 1] = e1; recS[2 * r] = s0; recS[2 * r + 1] = s1; recW[2 * r] = w0; recW[2 * r + 1] = w1; }
        }
    }
    if (ROUTE) {
        BLOCK_SYNC();
        if (C.tid < 8) baseL[C.tid] = (int)__hip_atomic_fetch_add((unsigned*)(C.ctl + CW_ECNT + C.tid), (unsigned)cntL[C.tid], RLX_AGENT);
        BLOCK_SYNC();
        int* TOKOF = WSP(int, WS_TOKOF); float* TOKW = WSP(float, WS_TOKW);
        for (int i = C.tid; i < 2 * rows_per_blk; i += NTHR) { const int e = recE[i], slot = baseL[e] + recS[i], tok = m_base + (i >> 1);
            TOKOF[e * T + slot] = tok | ((i & 1) << 30); TOKW[e * T + slot] = recW[i]; }
    }
}

DI void prep_unit(Ctx& C, int l, int b, int c, int mode) {
    const int tid = C.tid, lane = C.lane, wave = C.wave;
    bf16* PROJ = WSP(bf16, WS_PROJ); bf16* QKC = WSP(bf16, WS_QKC);
    const int t0 = 64 * c; const size_t m0 = (size_t)b * SEQ + t0;
    LAS char* KWt = (LAS char*)(C.lds); LAS char* Vt = (LAS char*)(C.lds + 49152); LAS float* EW = (LAS float*)(C.lds + 98304);
    constexpr int VP = 192, VTB = 64 * 192;
    v4u xr[11], vr[4];
    { const int rg = tid >> 6, ch0 = (tid & 63) * 8;
#pragma unroll
      for (int i = 0; i < 11; ++i) { const int r = 8 * rg - 3 + i; xr[i] = (r >= 0 || c > 0) ? *(const GAS v4u*)(PROJ + (long)((long)m0 + r) * PW + ch0) : (v4u){0u, 0u, 0u, 0u}; }
#pragma unroll
      for (int hh = 0; hh < 4; ++hh) { const int r = tid >> 3, c8 = tid & 7; vr[hh] = *(const GAS v4u*)(PROJ + (m0 + r) * PW + C_MV + hh * 64 + c8 * 8); } }
    {
        const int hd = wave & 3, bh = b * 4 + hd; const size_t m = m0 + lane;
        if (wave < 4) {
            const float ig = bf2f(PROJ[m * PW + C_MIF + hd]) + KIN(10)[l * 8 + hd], fg = bf2f(PROJ[m * PW + C_MIF + 4 + hd]) + KIN(10)[l * 8 + 4 + hd];
            float bcs = log_sigmoid(fg);
#pragma unroll
            for (int o = 1; o < 64; o <<= 1) { const float t = __shfl_up(bcs, o); if (lane >= o) bcs += t; }
            const float g = __shfl(bcs, 63), w = g - bcs + ig, mloc = wave_max(w);
            EW[hd * 64 + lane] = ex2((w - mloc) * LOG2E);
            WSP(float, WS_GB)[(size_t)bh * SEQ + t0 + lane] = bcs; WSP(float, WS_GI)[(size_t)bh * SEQ + t0 + lane] = ig;
            if (lane == 0) { WSP(float, WS_G)[bh * 64 + c] = g; WSP(float, WS_MLOC)[bh * 64 + c] = mloc; }
        } else {
            const float ff = bf2f(PROJ[m * PW + C_FF + hd]) + KIN(12)[l * 4 + hd];
            float fcs = log_sigmoid(ff);
#pragma unroll
            for (int o = 1; o < 64; o <<= 1) { const float t = __shfl_up(fcs, o); if (lane >= o) fcs += t; }
            WSP(float, WS_FLOC)[(size_t)bh * SEQ + t0 + lane] = fcs;
            if (lane == 63) WSP(float, WS_FTOT)[bh * 64 + c] = fcs;
        }
    }
    LDS_BARRIER();
    {
        const int rg = tid >> 6, cp = tid & 63, ch0 = cp * 8; const float* cw = KIN(9) + (size_t)l * 4 * 512 + ch0;
        float wj[4][8];
#pragma unroll
        for (int j = 0; j < 4; ++j) { const f32x4 a = *(const f32x4*)(cw + j * 512), b4 = *(const f32x4*)(cw + j * 512 + 4); wj[j][0] = a.x; wj[j][1] = a.y; wj[j][2] = a.z; wj[j][3] = a.w; wj[j][4] = b4.x; wj[j][5] = b4.y; wj[j][6] = b4.z; wj[j][7] = b4.w; }
        const bool isk = ch0 >= 256; const int kh = (ch0 - 256) >> 6, kc = ch0 & 63;
#pragma unroll
        for (int i = 0; i < 8; ++i) { const int r = 8 * rg + i; float y[8];
#pragma unroll
            for (int e = 0; e < 8; ++e) { float acc = 0.f;
#pragma unroll
                for (int j = 0; j < 4; ++j) { const v4u xv = xr[i + 3 - j]; const unsigned wd = (e < 2) ? xv.x : (e < 4) ? xv.y : (e < 6) ? xv.z : xv.w; acc += wj[j][e] * ((e & 1) ? bfhi(wd) : bflo(wd)); }
                y[e] = silu(acc) * (isk ? 0.125f : 1.0f); }
            v4u o; o.x = pk2(y[0], y[1]); o.y = pk2(y[2], y[3]); o.z = pk2(y[4], y[5]); o.w = pk2(y[6], y[7]);
            *(GAS v4u*)(QKC + (m0 + r) * 512 + ch0) = o;
            if (isk) { const float ew = EW[kh * 64 + r]; v4u k2; k2.x = pk2(y[0] * ew, y[1] * ew); k2.y = pk2(y[2] * ew, y[3] * ew); k2.z = pk2(y[4] * ew, y[5] * ew); k2.w = pk2(y[6] * ew, y[7] * ew);
                *(LAS v4u*)(KWt + kh * VTB + r * VP + kc * 2) = k2; } }
#pragma unroll
        for (int hh = 0; hh < 4; ++hh) { const int r = tid >> 3, c8 = tid & 7; *(LAS v4u*)(Vt + hh * VTB + r * VP + c8 * 16) = vr[hh]; }
    }
    LDS_BARRIER();
    {
        const int hd = wave & 3, dvh = wave >> 2, bh = b * 4 + hd, h = lane >> 5, i16 = lane & 15, q4 = i16 >> 2, p = i16 & 3, blk = (lane >> 4) & 1;
        LAS const char* va = Vt + hd * VTB + (8 * h + q4) * VP + (32 * dvh + 16 * blk + 4 * p) * 2;
        LAS const char* kb = KWt + hd * VTB + (8 * h + q4) * VP + (16 * blk + 4 * p) * 2;
        float* ST = WSP(float, WS_STATE) + ((size_t)bh * 64 + c) * 4096;
#pragma unroll
        for (int nt = 0; nt < 2; ++nt) {
            f32x16 acc;
#pragma unroll
            for (int r = 0; r < 16; ++r) acc[r] = 0.f;
#pragma unroll
            for (int s = 0; s < 4; ++s) {
                const s16x4 alo = att_trr(va + 16 * s * VP), ahi = att_trr(va + (16 * s + 4) * VP), blo = att_trr(kb + 16 * s * VP + nt * 64), bhi = att_trr(kb + (16 * s + 4) * VP + nt * 64);
                acc = __builtin_amdgcn_mfma_f32_32x32x16_bf16(__builtin_shufflevector(alo, ahi, 0, 1, 2, 3, 4, 5, 6, 7), __builtin_shufflevector(blo, bhi, 0, 1, 2, 3, 4, 5, 6, 7), acc, 0, 0, 0);
            }
#pragma unroll
            for (int r = 0; r < 16; ++r) ST[(32 * dvh + (r & 3) + 8 * (r >> 2) + 4 * h) * 64 + 32 * nt + (lane & 31)] = acc[r];
        }
        if (tid < 256) { const int hh = tid >> 6, dk = tid & 63; float s = 0.f;
#pragma unroll 8
            for (int r = 0; r < 64; ++r) s += bf2f(*(LAS const bf16*)(KWt + hh * VTB + r * VP + dk * 2));
            WSP(float, WS_NCH)[((size_t)(b * 4 + hh) * 64 + c) * 64 + dk] = s; }
    }
    for (int i = tid; i < 64 * 12; i += NTHR) { const int r = i / 12, j = i % 12; WSP(float, WS_NG)[(m0 + r) * 16 + j] = sigmoid_f(bf2f(PROJ[(m0 + r) * PW + C_NG + j]) + KIN(20)[l * 12 + j]); }
    LDS_BARRIER();
}
DI void compress_tile(Ctx& C, int l, int wt) {
    const int lane = C.lane, h = lane >> 5, r32 = lane & 31;
    const int nt = wt & 3, mt = (wt >> 2) & 7, b = (wt >> 5) & 7, kv = wt >> 8;
    const bf16* PROJ = WSP(bf16, WS_PROJ);
    const bf16* ap = PROJ + ((size_t)b * SEQ + 16 * (mt * 32 + r32)) * PW + (kv ? C_VC : C_KC) + 8 * h;
    const bf16* bp = WSP(bf16, WS_WCT) + ((size_t)(l * 2 + kv) * 128 + nt * 32 + r32) * 1024 + 8 * h;
    f32x16 acc;
#pragma unroll
    for (int r = 0; r < 16; ++r) acc[r] = 0.f;
#pragma unroll 4
    for (int ks = 0; ks < 64; ++ks) {
        const bf16x8 a = *(const bf16x8*)(ap + (size_t)(ks >> 2) * PW + 16 * (ks & 3)), bb = *(const bf16x8*)(bp + 16 * ks);
        acc = __builtin_amdgcn_mfma_f32_32x32x16_bf16(a, bb, acc, 0, 0, 0);
    }
    float* U = WSP(float, WS_U) + (((size_t)kv * 8 + b) * 256 + mt * 32) * 128 + nt * 32 + r32;
#pragma unroll
    for (int r = 0; r < 16; ++r) U[(size_t)((r & 3) + 8 * (r >> 2) + 4 * h) * 128] = acc[r];
}
DI void p_prep(Ctx& C, int l, int mode) {
    { const int gw = C.blk * NWAVES + C.wave; if (gw < 512) compress_tile(C, l, gw); }
    for (int u = C.blk; u < NB * 64; u += C.G) prep_unit(C, l, u >> 6, u & 63, mode);
}

DI void p_scan(Ctx& C, int l, bool dry) {
    { const int gw = C.blk * NWAVES + C.wave, NGW = C.G * NWAVES, lane = C.lane; const float* U = WSP(float, WS_U); const float* P0 = WSP(float, WS_P0) + l * 128;
      for (int it = gw; it < 8 * 256; it += NGW) { const int b = it >> 8, n = it & 255; float kx = 0.f, vx = 0.f;
          if (n < 255) { const float* u0 = U + ((size_t)b * 256 + n) * 128; const float* u1 = U + ((size_t)(8 + b) * 256 + n) * 128;
              kx = u0[lane] + u0[128 + 64 + lane] + P0[lane]; vx = u1[lane] + u1[128 + 64 + lane] + P0[64 + lane];
              const float ss = wave_sum(kx * kx); kx = kx / sqrtf(ss * (1.0f / 64.0f) + NORM_EPS) * KIN(16)[l * 192 + lane]; }
          if (!dry) { WSP(bf16, WS_KCMP)[((size_t)b * 256 + n) * 64 + lane] = f2bf(kx); WSP(bf16, WS_VCMP)[((size_t)b * 256 + n) * 64 + lane] = f2bf(vx); } } }
    const int gid = C.blk * NTHR + C.tid;
    for (int g = gid; g < 32 * 4096; g += C.G * NTHR) {
        const int bh = g >> 12, e = g & 4095;
        const float* Gp = WSP(float, WS_G) + bh * 64; const float* ML = WSP(float, WS_MLOC) + bh * 64;
        float* ST = WSP(float, WS_STATE) + (size_t)bh * 64 * 4096 + e; float* NC = WSP(float, WS_NCH) + (size_t)bh * 64 * 64 + e;
        float Cst = 0.f, nst = 0.f, m = 0.f;
        float cc[64];
#pragma unroll
        for (int c = 0; c < 64; ++c) cc[c] = *(const GAS float*)(ST + (size_t)c * 4096);
        const float gq = Gp[C.lane], mq = ML[C.lane];
#pragma unroll
        for (int c = 0; c < 64; ++c) {
            const float nc = (e < 64) ? *(const GAS float*)(NC + c * 64) : 0.f;
            if (!dry) { ST[(size_t)c * 4096] = Cst; if (e < 64) NC[c * 64] = nst;
                if (e == 0) WSP(float, WS_MPREV)[bh * 64 + c] = m; }
            const float gc = __shfl(gq, c), ml = __shfl(mq, c), mn = fmaxf(gc + m, ml), a = ex2((gc + m - mn) * LOG2E), bb = ex2((ml - mn) * LOG2E);
            Cst = a * Cst + bb * cc[c]; nst = a * nst + bb * nc; m = mn;
        }
        { const float* FT = WSP(float, WS_FTOT) + bh * 64; const int ch = e >> 6; const float off = wave_sum((C.lane < ch) ? FT[C.lane] : 0.f);
          const float f2v = (WSP(float, WS_FLOC)[g] + off) * LOG2E; if (!dry) WSP(float, WS_F2)[g] = f2v; else if (f2v == 123.456f) WSP(float, WS_F2)[g] = Cst + nst; }
    }
}

namespace att {
constexpr int KP = 144, VP = 192;
constexpr int KT = 64 * KP, VT = 64 * VP;
constexpr int L_K0 = 0, L_V0 = 3 * KT, L_F = 3 * KT + 3 * VT  , L_BL = L_F + 512, L_IMP = 67584, L_TOT = L_IMP + 65536, L_SEL = L_TOT + 16384, L_FLAG = L_SEL + 512, L_EL = L_FLAG + 64  , L_BL2 = L_EL + 4 * 320 * 4  , L_NST = L_BL2 + 4 * 132 * 4  , L_END = L_NST + 64;
static_assert(L_BL + 4 * 132 * 4 <= L_IMP && L_END <= MISC_OFF, "attention LDS map");
typedef short v4i16_t __attribute__((ext_vector_type(4)));
#define MFMA32(a, b, c) __builtin_amdgcn_mfma_f32_32x32x16_bf16((a), (b), (c), 0, 0, 0)
DI int crow(int r, int h) { return (r & 3) + 8 * (r >> 2) + 4 * h; }
DI s16x4 trr(LAS const char* p) { return __builtin_bit_cast(s16x4, __builtin_amdgcn_ds_read_tr16_b64_v4i16((LAS v4i16_t*)p)); }
struct Stg { v4u k, v; };
DI void stage_load(Stg& s, const bf16* Kg, const bf16* Vg, int ld, int tid) { const int row = tid >> 3, ch = tid & 7; s.k = *(const GAS v4u*)(Kg + (size_t)row * ld + ch * 8); s.v = *(const GAS v4u*)(Vg + (size_t)row * ld + ch * 8); }
DI void stage_store(const Stg& s, LAS char* Kt, LAS char* Vt, int tid) { const int row = tid >> 3, ch = tid & 7; *(LAS v4u*)(Kt + row * KP + ch * 16) = s.k; *(LAS v4u*)(Vt + row * VP + ch * 16) = s.v; }
DI void qkt(f32x16& p0, f32x16& p1, LAS const char* Kt, const bf16x8 (&qf)[4], int lane) {
    LAS const char* kb = Kt + (lane & 31) * KP + (lane >> 5) * 16;
#pragma unroll
    for (int d0 = 0; d0 < 4; ++d0) {
        const bf16x8 a0 = *(LAS const bf16x8*)(kb + d0 * 32), a1 = *(LAS const bf16x8*)(kb + 32 * KP + d0 * 32);
        p0 = MFMA32(a0, qf[d0], p0); p1 = MFMA32(a1, qf[d0], p1);
    }
}
DI bf16x8 pack8(const f32x16& p, int b) { v4u w; w.x = pk2(p[b], p[b + 1]); w.y = pk2(p[b + 2], p[b + 3]); w.z = pk2(p[b + 4], p[b + 5]); w.w = pk2(p[b + 6], p[b + 7]); return __builtin_bit_cast(bf16x8, w); }
DI void pv_packed(f32x16 (&o)[2], LAS const char* Vt, const bf16x8 (&pb)[4], int lane) {
    const int h = lane >> 5, i16 = lane & 15, q4 = i16 >> 2, p = i16 & 3, blk = (lane >> 4) & 1;
    LAS const char* vb = Vt + (4 * h + q4) * VP + (16 * blk + 4 * p) * 2;
#pragma unroll
    for (int hf = 0; hf < 2; ++hf) {
        s16x4 lo[4], hi[4];
#pragma unroll
        for (int i = 0; i < 4; ++i) { const int s = 2 * hf + (i >> 1), dh = i & 1; lo[i] = trr(vb + (16 * s) * VP + dh * 64); hi[i] = trr(vb + (16 * s + 8) * VP + dh * 64); }
        __builtin_amdgcn_sched_barrier(0);
#pragma unroll
        for (int i = 0; i < 4; ++i) { const int s = 2 * hf + (i >> 1), dh = i & 1;
            o[dh] = MFMA32(__builtin_shufflevector(lo[i], hi[i], 0, 1, 2, 3, 4, 5, 6, 7), pb[s], o[dh]); }
    }
}
DI void pack_p(bf16x8 (&pb)[4], const f32x16& p0, const f32x16& p1) { pb[0] = pack8(p0, 0); pb[1] = pack8(p0, 8); pb[2] = pack8(p1, 0); pb[3] = pack8(p1, 8); }
DI void pv(f32x16 (&o)[2], LAS const char* Vt, const f32x16& p0, const f32x16& p1, int lane) { bf16x8 pb[4]; pack_p(pb, p0, p1); pv_packed(o, Vt, pb, lane); }
DI float half_max(float v) { return fmaxf(v, __shfl_xor(v, 32)); }
DI float half_sum(float v) { return v + __shfl_xor(v, 32); }
template <bool MASKED> DI void osm(f32x16& p0, f32x16& p1, float& m_run, float& lsum, f32x16 (&o)[2]) {
    float tm = -1e30f;
#pragma unroll
    for (int r = 0; r < 16; ++r) tm = fmaxf(tm, fmaxf(p0[r], p1[r]));
    tm = half_max(tm);
    const float mn = fmaxf(m_run, tm);
    if (__any(mn > m_run)) {
        const float f = ex2(m_run - mn); m_run = mn; lsum *= f;
#pragma unroll
        for (int r = 0; r < 16; ++r) { o[0][r] *= f; o[1][r] *= f; }
    }
    float ps = 0.f;
#pragma unroll
    for (int r = 0; r < 16; ++r) { float a = ex2(p0[r] - mn), b = ex2(p1[r] - mn); if (MASKED) { a = p0[r] > -1e29f ? a : 0.f; b = p1[r] > -1e29f ? b : 0.f; } p0[r] = a; p1[r] = b; ps += a + b; }
    lsum += ps;
}
DI void osm_fast(f32x16& p0, f32x16& p1, float cb, bool active, float& m_run, float& lsum, f32x16 (&o)[2]) {
    float t0 = fmaxf(p0[0], p1[0]), t1 = fmaxf(p0[1], p1[1]);
#pragma unroll
    for (int r = 2; r < 16; r += 2) { t0 = fmaxf(t0, fmaxf(p0[r], p1[r])); t1 = fmaxf(t1, fmaxf(p0[r + 1], p1[r + 1])); }
    float tm = active ? fmaxf(t0, t1) + cb : -1e30f;
    tm = half_max(tm);
    const float mn = fmaxf(m_run, tm);
    if (__any(mn > m_run)) {
        const float f = ex2(m_run - mn); m_run = mn; lsum *= f;
#pragma unroll
        for (int r = 0; r < 16; ++r) { o[0][r] *= f; o[1][r] *= f; }
    }
    const float e = active ? mn - cb : 1e30f;
    float ps0 = 0.f, ps1 = 0.f;
#pragma unroll
    for (int r = 0; r < 16; ++r) { const float a = ex2(p0[r] - e), b = ex2(p1[r] - e); p0[r] = a; p1[r] = b; ps0 += a; ps1 += b; }
    lsum += ps0 + ps1;
}
DI void store_o(bf16* orow, const f32x16 (&o)[2], float sc, int h) {
#pragma unroll
    for (int dh = 0; dh < 2; ++dh)
#pragma unroll
        for (int g = 0; g < 4; ++g) { v2u w; w.x = pk2(o[dh][4 * g] * sc, o[dh][4 * g + 1] * sc); w.y = pk2(o[dh][4 * g + 2] * sc, o[dh][4 * g + 3] * sc); *(v2u*)(orow + 32 * dh + 8 * g + 4 * h) = w; }
}

DI void fox_tile(LAS const char* Kt, LAS const char* Vt, const LAS float* fk, const bf16x8 (&qf)[4], int key0, bool diag, int tq, float f2q, float& m_run, float& lsum, f32x16 (&o)[2], int lane) {
    const int h = lane >> 5;
    f32x16 p0, p1;
#pragma unroll
    for (int r = 0; r < 16; ++r) { p0[r] = 0.f; p1[r] = 0.f; }
    qkt(p0, p1, Kt, qf, lane);
    if (diag) {
#pragma unroll
        for (int g = 0; g < 4; ++g) { const f32x4 fa = *(const LAS f32x4*)(fk + 8 * g + 4 * h), fb = *(const LAS f32x4*)(fk + 32 + 8 * g + 4 * h);
#pragma unroll
            for (int i = 0; i < 4; ++i) { const int r = 4 * g + i, ka = key0 + 8 * g + 4 * h + i; float sa = p0[r] + (f2q - fa[i]), sb = p1[r] + (f2q - fb[i]);
                if (ka > tq) sa = -1e30f; if (ka + 32 > tq) sb = -1e30f; p0[r] = sa; p1[r] = sb; } }
        osm<true>(p0, p1, m_run, lsum, o);
    } else {
#pragma unroll
        for (int g = 0; g < 4; ++g) { const f32x4 fa = *(const LAS f32x4*)(fk + 8 * g + 4 * h), fb = *(const LAS f32x4*)(fk + 32 + 8 * g + 4 * h);
#pragma unroll
            for (int i = 0; i < 4; ++i) { p0[4 * g + i] -= fa[i]; p1[4 * g + i] -= fb[i]; } }
        osm_fast(p0, p1, f2q, true, m_run, lsum, o);
    }
    pv(o, Vt, p0, p1, lane);
}
DI void fox_tile_s(LAS const char* Kt, LAS const char* Vt, const LAS float* fk, const bf16x8 (&qf)[4], int key0, bool diag, int tq, const f32x16& cq, float& lsum, f32x16 (&o)[2], int lane) {
    const int h = lane >> 5;
    f32x16 p0 = cq, p1 = cq;
    qkt(p0, p1, Kt, qf, lane);
    float ps0 = 0.f, ps1 = 0.f;
    if (diag) {
#pragma unroll
        for (int g = 0; g < 4; ++g) { const f32x4 fa = *(const LAS f32x4*)(fk + 8 * g + 4 * h), fb = *(const LAS f32x4*)(fk + 32 + 8 * g + 4 * h);
#pragma unroll
            for (int i = 0; i < 4; ++i) { const int r = 4 * g + i, ka = key0 + 8 * g + 4 * h + i; float sa = p0[r] - fa[i], sb = p1[r] - fb[i];
                if (ka > tq) sa = -1e30f; if (ka + 32 > tq) sb = -1e30f; const float a = ex2(sa), b = ex2(sb); p0[r] = a; p1[r] = b; ps0 += a; ps1 += b; } }
    } else {
#pragma unroll
        for (int g = 0; g < 4; ++g) { const f32x4 fa = *(const LAS f32x4*)(fk + 8 * g + 4 * h), fb = *(const LAS f32x4*)(fk + 32 + 8 * g + 4 * h);
#pragma unroll
            for (int i = 0; i < 4; ++i) { const int r = 4 * g + i; const float a = ex2(p0[r] - fa[i]), b = ex2(p1[r] - fb[i]); p0[r] = a; p1[r] = b; ps0 += a; ps1 += b; } }
    }
    lsum += ps0 + ps1;
    pv(o, Vt, p0, p1, lane);
}
constexpr int RING = 5, L_KR = 0, L_VR = RING * KT, L_FR = RING * (KT + VT);
static_assert(L_FR + RING * 256 <= L_FLAG, "ring LDS map");
DI void fox_unit(Ctx& C, int l, int b, int hd, int qb) {
    const int tid = C.tid, lane = C.lane, w = C.wave, r32 = lane & 31, h = lane >> 5;
    const bf16* PROJ = WSP(bf16, WS_PROJ); const size_t m0 = (size_t)b * SEQ;
    const bf16* Kg = PROJ + m0 * PW + C_FK + hd * 64; const bf16* Vg = PROJ + m0 * PW + C_FV + hd * 64;
    const float* F2 = WSP(float, WS_F2) + (size_t)(b * 4 + hd) * SEQ;
    LAS char* lds = (LAS char*)C.lds; LAS float* Fr = (LAS float*)(lds + L_FR); volatile LAS int* flag = (volatile LAS int*)(lds + L_FLAG);
    const int tq = 256 * qb + 32 * w + r32;
    bf16x8 qf[4];
    { const bf16* qp = PROJ + (m0 + tq) * PW + C_FQ + hd * 64 + 8 * h;
#pragma unroll
      for (int d0 = 0; d0 < 4; ++d0) qf[d0] = *(const bf16x8*)(qp + 16 * d0); }
    const float f2q = F2[tq];
    const float sbound = ((const LAS float*)(lds + L_NST))[4];
    float lsum = 0.f; f32x16 o[2]; f32x16 cq;
#pragma unroll
    for (int r = 0; r < 16; ++r) { o[0][r] = 0.f; o[1][r] = 0.f; cq[r] = f2q; }
    const int j0 = 4 * qb, jd = j0 + (w >> 1);
#define FOX_LD(S_, F_, j_) do { stage_load(S_, Kg + (size_t)(j_) * 64 * PW, Vg + (size_t)(j_) * 64 * PW, PW, tid); if (tid < 64) F_ = *(const GAS float*)(F2 + (j_) * 64 + tid); } while (0)
#define FOX_ST(S_, F_, j_) do { stage_store(S_, lds + L_KR + ((j_) % RING) * KT, lds + L_VR + ((j_) % RING) * VT, tid); if (tid < 64) Fr[((j_) % RING) * 64 + tid] = F_; } while (0)
    Stg sA, sB; float fA = 0.f, fB = 0.f;
    { Stg s0, s1, s2, s3; float f0 = 0.f, f1 = 0.f, f2 = 0.f, f3 = 0.f; FOX_LD(s0, f0, j0 + 3); FOX_LD(s1, f1, j0 + 2); FOX_LD(s2, f2, j0 + 1); FOX_LD(s3, f3, j0);
      if (j0 - 1 >= 0) FOX_LD(sA, fA, j0 - 1);
      if (j0 - 2 >= 0) FOX_LD(sB, fB, j0 - 2);
      FOX_ST(s0, f0, j0 + 3); FOX_ST(s1, f1, j0 + 2); FOX_ST(s2, f2, j0 + 1); FOX_ST(s3, f3, j0); }
    if (tid < 16) flag[tid] = 0;
    LDS_BARRIER();
#define FOX_STEP(s_, DIAG_, SX_, FX_) { const int t_ = jd - (s_); bool done = true; \
        if (t_ >= 0) { LAS const char* kt_ = lds + L_KR + (t_ % RING) * KT; LAS const char* vt_ = lds + L_VR + (t_ % RING) * VT; const LAS float* ft_ = Fr + (t_ % RING) * 64; asm volatile("" : "+v"(kt_), "+v"(vt_), "+v"(ft_)); \
            fox_tile_s(kt_, vt_, ft_, qf, 64 * t_, DIAG_, tq, cq, lsum, o, lane); \
            if (t_ > 0) { const float fl = *(const GAS float*)(F2 + 64 * t_ - 1); done = __all(sbound + f2q - fl + 40.0f < lg2(lsum)); } } \
        if (lane == 0) flag[((s_) & 1) * 8 + w] = done ? 1 : 0; \
        if (j0 - (s_) - 1 >= 0) FOX_ST(SX_, FX_, j0 - (s_) - 1); \
        LDS_BARRIER(); \
        int alld = 1; _Pragma("unroll") for (int i = 0; i < 8; ++i) alld &= flag[((s_) & 1) * 8 + i]; \
        if (alld) break; \
        if (j0 - (s_) - 3 >= 0) FOX_LD(SX_, FX_, j0 - (s_) - 3); }
    for (int s = 0; ; s += 2) {
        if (s == 0) FOX_STEP(0, true, sA, fA) else FOX_STEP(s, false, sA, fA)
        FOX_STEP(s + 1, false, sB, fB)
    }
#undef FOX_LD
#undef FOX_ST
#undef FOX_STEP
    LDS_BARRIER();
    lsum = half_sum(lsum);
    { int tq2 = tq; asm volatile("" : "+v"(tq2)); store_o(WSP(bf16, WS_MIX) + (m0 + tq2) * 1024 + 256 + hd * 64, o, 1.0f / lsum, h); }
}

DI void fox_unit_safe(Ctx& C, int l, int b, int hd, int qb) {
    const int tid = C.tid, lane = C.lane, w = C.wave, r32 = lane & 31, h = lane >> 5;
    const bf16* PROJ = WSP(bf16, WS_PROJ); const size_t m0 = (size_t)b * SEQ;
    const bf16* Kg = PROJ + m0 * PW + C_FK + hd * 64; const bf16* Vg = PROJ + m0 * PW + C_FV + hd * 64;
    const float* F2 = WSP(float, WS_F2) + (size_t)(b * 4 + hd) * SEQ;
    LAS char* lds = (LAS char*)C.lds; LAS float* Ft = (LAS float*)(lds + L_F);
    const int tq = 256 * qb + 32 * w + r32;
    bf16x8 qf[4];
    { const bf16* qp = PROJ + (m0 + tq) * PW + C_FQ + hd * 64 + 8 * h;
#pragma unroll
      for (int d0 = 0; d0 < 4; ++d0) qf[d0] = *(const bf16x8*)(qp + 16 * d0); }
    const float f2q = F2[tq];
    float m_run = -1e30f, lsum = 0.f; f32x16 o[2];
#pragma unroll
    for (int r = 0; r < 16; ++r) { o[0][r] = 0.f; o[1][r] = 0.f; }
    const int jtop = 4 * qb + 3, jd = 4 * qb + (w >> 1);
    for (int j = jtop; j >= 0; --j) {
        Stg st; stage_load(st, Kg + (size_t)j * 64 * PW, Vg + (size_t)j * 64 * PW, PW, tid); float fv = 0.f; if (tid < 64) fv = F2[j * 64 + tid];
        stage_store(st, lds + L_K0, lds + L_V0, tid); if (tid < 64) Ft[tid] = fv;
        LDS_BARRIER();
        if (j <= jd) fox_tile(lds + L_K0, lds + L_V0, Ft, qf, 64 * j, j == jd, tq, f2q, m_run, lsum, o, lane);
        LDS_BARRIER();
    }
    lsum = half_sum(lsum);
    store_o(WSP(bf16, WS_MIX) + (m0 + tq) * 1024 + 256 + hd * 64, o, 1.0f / lsum, h);
}

constexpr float SB_CUT = -48.0f;
template <bool diag> DI void sb_tile(LAS const char* Kt, LAS const char* Vt, const bf16x8 (&qf)[4], int key0, int tq, float& R2, f32x16 (&o)[2], int lane) {
    const int h = lane >> 5;
    f32x16 p0, p1;
#pragma unroll
    for (int r = 0; r < 16; ++r) { p0[r] = 0.f; p1[r] = 0.f; }
    qkt(p0, p1, Kt, qf, lane);
    float sp[2][16], gs[8];
#pragma unroll
    for (int pi = 0; pi < 2; ++pi)
#pragma unroll
        for (int r = 0; r < 16; ++r) { const float z = pi ? p1[r] : p0[r]; float s = fmaxf(z, 0.f) + lg2(1.0f + ex2(-fabsf(z)));
            if (diag && (key0 + 32 * pi + crow(r, h) >= tq)) s = 0.f; sp[pi][r] = s; }
#pragma unroll
    for (int k = 0; k < 8; ++k) { const int pi = k >> 2, c4 = k & 3; gs[k] = (sp[pi][4 * c4] + sp[pi][4 * c4 + 1]) + (sp[pi][4 * c4 + 2] + sp[pi][4 * c4 + 3]); }
    float Tk[8]; float run = 0.f;
    float og[8];
#pragma unroll
    for (int k = 0; k < 8; ++k) og[k] = __shfl_xor(gs[k], 32);
#pragma unroll
    for (int k = 7; k >= 0; --k) { Tk[k] = run; run += gs[k] + og[k]; }
#pragma unroll
    for (int pi = 0; pi < 2; ++pi)
#pragma unroll
        for (int c4 = 0; c4 < 4; ++c4) { const int k = 4 * pi + c4; const float later = Tk[k] + (h == 0 ? og[k] : 0.f);
            const float s1 = sp[pi][4 * c4 + 1], s2 = sp[pi][4 * c4 + 2], s3 = sp[pi][4 * c4 + 3];
            const float e3 = later, e2 = later + s3, e1 = e2 + s2, e0 = e1 + s1;
            const float ee[4] = {e0, e1, e2, e3};
#pragma unroll
            for (int i = 0; i < 4; ++i) { const int r = 4 * c4 + i; const float z = pi ? p1[r] : p0[r]; const bool msk = diag && (key0 + 32 * pi + crow(r, h) >= tq);
                const float a = msk ? 0.f : ex2(z - sp[pi][r] + R2 - ee[i]); if (pi) p1[r] = a; else p0[r] = a; } }
    R2 -= run;
    pv(o, Vt, p0, p1, lane);
}
DI void sb_unit(Ctx& C, int b, int hd, int qb) {
    const int tid = C.tid, lane = C.lane, w = C.wave, r32 = lane & 31, h = lane >> 5;
    const bf16* PROJ = WSP(bf16, WS_PROJ); const size_t m0 = (size_t)b * SEQ;
    const bf16* Kg = PROJ + m0 * PW + C_SK + hd * 64; const bf16* Vg = PROJ + m0 * PW + C_SV + hd * 64;
    LAS char* lds = (LAS char*)C.lds; volatile LAS int* flag = (volatile LAS int*)(lds + L_FLAG);
    const int tq = 256 * qb + 32 * w + r32;
    bf16x8 qf[4];
    { const bf16* qp = PROJ + (m0 + tq) * PW + C_SQ + hd * 64 + 8 * h;
#pragma unroll
      for (int d0 = 0; d0 < 4; ++d0) qf[d0] = *(const bf16x8*)(qp + 16 * d0); }
    float R2 = 0.f; f32x16 o[2];
#pragma unroll
    for (int r = 0; r < 16; ++r) { o[0][r] = 0.f; o[1][r] = 0.f; }
    const int j0 = 4 * qb, jd = j0 + (w >> 1);
#define SB_LD(S_, j_) stage_load(S_, Kg + (size_t)(j_) * 64 * PW, Vg + (size_t)(j_) * 64 * PW, PW, tid)
#define SB_ST(S_, j_) stage_store(S_, lds + L_KR + ((j_) % RING) * KT, lds + L_VR + ((j_) % RING) * VT, tid)
    Stg sA, sB;
    { Stg s0, s1, s2, s3; SB_LD(s0, j0 + 3); SB_LD(s1, j0 + 2); SB_LD(s2, j0 + 1); SB_LD(s3, j0);
      if (j0 - 1 >= 0) SB_LD(sA, j0 - 1);
      if (j0 - 2 >= 0) SB_LD(sB, j0 - 2);
      SB_ST(s0, j0 + 3); SB_ST(s1, j0 + 2); SB_ST(s2, j0 + 1); SB_ST(s3, j0); }
    if (tid < 16) flag[tid] = 0;
    LDS_BARRIER();
#define SB_STEP(s_, DIAG_, SX_) { const int t_ = jd - (s_); bool done = true; \
        if (t_ >= 0) { done = __all(R2 < SB_CUT); if (!done) { LAS const char* kt_ = lds + L_KR + (t_ % RING) * KT; LAS const char* vt_ = lds + L_VR + (t_ % RING) * VT; asm volatile("" : "+v"(kt_), "+v"(vt_));   \
            sb_tile<DIAG_>(kt_, vt_, qf, 64 * t_, tq, R2, o, lane); done = __all(R2 < SB_CUT); } } \
        if (lane == 0) flag[((s_) & 1) * 8 + w] = done ? 1 : 0; \
        if (j0 - (s_) - 1 >= 0) SB_ST(SX_, j0 - (s_) - 1); \
        LDS_BARRIER(); \
        int alld = 1; _Pragma("unroll") for (int i = 0; i < 8; ++i) alld &= flag[((s_) & 1) * 8 + i]; \
        if (alld) break; \
        if (j0 - (s_) - 3 >= 0) SB_LD(SX_, j0 - (s_) - 3); }
    for (int s = 0; ; s += 2) {
        if (s == 0) SB_STEP(0, true, sA) else SB_STEP(s, false, sA)
        SB_STEP(s + 1, false, sB)
    }
#undef SB_LD
#undef SB_ST
#undef SB_STEP
    LDS_BARRIER();
    { int tq2 = tq; asm volatile("" : "+v"(tq2));
      store_o(WSP(bf16, WS_MIX) + (m0 + tq2) * 1024 + 512 + hd * 64, o, 1.0f, h); }
}
}

namespace att {
template <int MODE> DI void nsa_tile(LAS const char* Kt, LAS const char* Vt, const bf16x8 (&qf)[4], int j, int t, int c, bool active, const LAS float* el, float bfar, float& m_run, float& lsum, f32x16 (&o)[2], int lane, int dry) {
    const int h = lane >> 5;
    f32x16 p0, p1;
#pragma unroll
    for (int r = 0; r < 16; ++r) { p0[r] = 0.f; p1[r] = 0.f; }
    qkt(p0, p1, Kt, qf, lane);
    if (j >= c - 2) {
        const int bd = t - 64 * j - 4 * h; const LAS float* eb = el + (255 - bd); const int bde = active ? bd : -1;
        float bv0[16], bv1[16];
#pragma unroll
        for (int r = 0; r < 16; ++r) { bv0[r] = eb[8 * (r >> 2) + (r & 3)]; bv1[r] = eb[32 + 8 * (r >> 2) + (r & 3)]; }
#pragma unroll
        for (int r = 0; r < 16; ++r) { asm volatile("" : "+v"(bv0[r])); asm volatile("" : "+v"(bv1[r])); }
#pragma unroll
        for (int r = 0; r < 16; ++r) { const int kc = 8 * (r >> 2) + (r & 3);
            p0[r] = (kc <= bde) ? p0[r] + bv0[r] : -1e30f; p1[r] = (kc + 32 <= bde) ? p1[r] + bv1[r] : -1e30f; }
        osm<true>(p0, p1, m_run, lsum, o);
    } else if (MODE == 1 && j == c - 8) {
        const int bd = t - 64 * j - 4 * h - 512;
#pragma unroll
        for (int pi = 0; pi < 2; ++pi)
#pragma unroll
            for (int r = 0; r < 16; ++r) { const int kc = 32 * pi + 8 * (r >> 2) + (r & 3); const bool valid = kc > bd;
                const float s = valid ? (pi ? p1[r] : p0[r]) + bfar : -1e30f; if (pi) p1[r] = s; else p0[r] = s; }
        osm<true>(p0, p1, m_run, lsum, o);
    } else {
        if (!(dry & 16)) osm_fast(p0, p1, bfar, active, m_run, lsum, o);
    }
    if (!(dry & 8)) pv(o, Vt, p0, p1, lane);
}
template <int MODE> DI void nsa_branch(Ctx& C, const bf16* Kg, const bf16* Vg, int j_lo, int j_hi, const bf16* qp, int t, int c, unsigned sel_lo, unsigned sel_hi,
                                       const LAS float* bl, float gate, LAS float* RES, bf16* orow, int dry) {
    const int tid = C.tid, lane = C.lane, h = lane >> 5; LAS char* lds = (LAS char*)C.lds;
    bf16x8 qf[4];
    asm volatile("" : "+v"(qp));
#pragma unroll
    for (int d0 = 0; d0 < 4; ++d0) qf[d0] = *(const bf16x8*)(qp + 16 * d0);
    float m_run = -1e30f, lsum = 0.f; f32x16 o[2];
#pragma unroll
    for (int r = 0; r < 16; ++r) { o[0][r] = 0.f; o[1][r] = 0.f; }
    const float bfar = bl[128]; const LAS float* el = (const LAS float*)(lds + L_EL) + (bl - (const LAS float*)(lds + L_BL2)) / 132 * 320;
    Stg sA, sB;
#define NB_LD(S_, j_) stage_load(S_, Kg + (size_t)(j_) * 64 * PW, Vg + (size_t)(j_) * 64 * PW, PW, tid)
#define NB_ST(S_, buf_) stage_store(S_, lds + L_K0 + (buf_) * KT, lds + L_V0 + (buf_) * VT, tid)
#define NB_ACT(j_) ((MODE == 1) ? true : ((((j_) < 32 ? (sel_lo >> (j_)) : (sel_hi >> ((j_) - 32))) & 1u) != 0u))
    NB_LD(sA, j_lo); NB_ST(sA, 0); if (j_lo + 1 <= j_hi) NB_LD(sB, j_lo + 1);
    LDS_BARRIER();
    for (int j = j_lo; j <= j_hi; j += 2) {
        if (j + 2 <= j_hi && !(dry & 32)) NB_LD(sA, j + 2);
        { const bool act = NB_ACT(j); if (__any(act) && !(dry & 64)) nsa_tile<MODE>(lds + L_K0, lds + L_V0, qf, j, t, c, act, el, bfar, m_run, lsum, o, lane, dry); }
        if (j + 1 <= j_hi && !(dry & 32)) NB_ST(sB, 1);
        LDS_BARRIER();
        if (j + 1 > j_hi) break;
        if (j + 3 <= j_hi && !(dry & 32)) NB_LD(sB, j + 3);
        { const bool act = NB_ACT(j + 1); if (__any(act) && !(dry & 64)) nsa_tile<MODE>(lds + L_K0 + KT, lds + L_V0 + VT, qf, j + 1, t, c, act, el, bfar, m_run, lsum, o, lane, dry); }
        if (j + 2 <= j_hi && !(dry & 32)) NB_ST(sA, 0);
        LDS_BARRIER();
    }
#undef NB_LD
#undef NB_ST
#undef NB_ACT
    lsum = half_sum(lsum); const float sc = lsum > 0.f ? gate / lsum : 0.f;
#pragma unroll
    for (int dh = 0; dh < 2; ++dh)
#pragma unroll
        for (int r = 0; r < 16; ++r) { const float v = RES[(dh * 16 + r) * 64 + lane] + o[dh][r] * sc; if (MODE == 1) o[dh][r] = v; else RES[(dh * 16 + r) * 64 + lane] = v; }
    if (MODE == 1 && orow) store_o(orow, o, 1.0f, h);
}
DI void nsa_selwin(Ctx& C, const bf16* Ks, const bf16* Vs, const bf16* Kw, const bf16* Vw, const bf16* qp, int t, int c, unsigned sel_lo, unsigned sel_hi,
                   const LAS float* bl, float g_sel, float g_win, LAS float* RES, bf16* orow, int dry) {
    const int tid = C.tid, lane = C.lane, h = lane >> 5; LAS char* lds = (LAS char*)C.lds;
    bf16x8 qf[4];
    asm volatile("" : "+v"(qp));
#pragma unroll
    for (int d0 = 0; d0 < 4; ++d0) qf[d0] = *(const bf16x8*)(qp + 16 * d0);
    float m_run = -1e30f, lsum = 0.f; f32x16 o[2];
#pragma unroll
    for (int r = 0; r < 16; ++r) { o[0][r] = 0.f; o[1][r] = 0.f; }
    const float bfar = bl[128]; const LAS float* el = (const LAS float*)(lds + L_EL) + (bl - (const LAS float*)(lds + L_BL2)) / 132 * 320;
    const int nsel = c + 1, jw0 = c >= 8 ? c - 8 : 0, ntot = nsel + (c - jw0 + 1);
    Stg sA, sB;
#define SW_J(v_) ((v_) < nsel ? (v_) : jw0 + ((v_) - nsel))
#define SW_LD(S_, v_) do { const int j_ = SW_J(v_); if ((v_) < nsel) stage_load(S_, Ks + (size_t)j_ * 64 * PW, Vs + (size_t)j_ * 64 * PW, PW, tid); else stage_load(S_, Kw + (size_t)j_ * 64 * PW, Vw + (size_t)j_ * 64 * PW, PW, tid); } while (0)
#define SW_ST(S_, buf_) stage_store(S_, lds + L_K0 + (buf_) * KT, lds + L_V0 + (buf_) * VT, tid)
#define SW_CLOSE() do { lsum = half_sum(lsum); const float sc_ = lsum > 0.f ? g_sel / lsum : 0.f; \
        _Pragma("unroll") for (int dh = 0; dh < 2; ++dh) _Pragma("unroll") for (int r = 0; r < 16; ++r) { RES[(dh * 16 + r) * 64 + lane] += o[dh][r] * sc_; o[dh][r] = 0.f; } \
        m_run = -1e30f; lsum = 0.f; } while (0)
#define SW_TILE(v_, buf_) do { const int j_ = SW_J(v_); \
        if ((v_) == nsel) SW_CLOSE(); \
        if ((v_) < nsel) { const bool act = (((j_ < 32 ? (sel_lo >> j_) : (sel_hi >> (j_ - 32))) & 1u) != 0u); if (__any(act)) nsa_tile<0>(lds + L_K0 + (buf_) * KT, lds + L_V0 + (buf_) * VT, qf, j_, t, c, act, el, bfar, m_run, lsum, o, lane, dry); } \
        else nsa_tile<1>(lds + L_K0 + (buf_) * KT, lds + L_V0 + (buf_) * VT, qf, j_, t, c, true, el, bfar, m_run, lsum, o, lane, dry); } while (0)
    SW_LD(sA, 0); SW_ST(sA, 0); SW_LD(sB, 1);
    LDS_BARRIER();
    for (int v = 0; v < ntot; v += 2) {
        if (v + 2 < ntot) SW_LD(sA, v + 2);
        SW_TILE(v, 0);
        if (v + 1 < ntot) SW_ST(sB, 1);
        LDS_BARRIER();
        if (v + 1 >= ntot) break;
        if (v + 3 < ntot) SW_LD(sB, v + 3);
        SW_TILE(v + 1, 1);
        if (v + 2 < ntot) SW_ST(sA, 0);
        LDS_BARRIER();
    }
#undef SW_J
#undef SW_LD
#undef SW_ST
#undef SW_CLOSE
#undef SW_TILE
    lsum = half_sum(lsum); const float sc = lsum > 0.f ? g_win / lsum : 0.f;
#pragma unroll
    for (int dh = 0; dh < 2; ++dh)
#pragma unroll
        for (int r = 0; r < 16; ++r) o[dh][r] = RES[(dh * 16 + r) * 64 + lane] + o[dh][r] * sc;
    if (orow) store_o(orow, o, 1.0f, h);
}
template <int MODE> DI void nsa_tile_s(LAS const char* Kt, LAS const char* Vt, const bf16x8 (&qf)[4], int j, int t, int c, bool active, const LAS float* el, float& lsum, f32x16 (&o)[2], int lane, int dry) {
    const int h = lane >> 5;
    f32x16 p0, p1;
#pragma unroll
    for (int r = 0; r < 16; ++r) { p0[r] = 0.f; p1[r] = 0.f; }
    LAS const char* kb = Kt + (lane & 31) * KP + h * 16;
    const int i16 = lane & 15, q4 = i16 >> 2, pp = i16 & 3, blk = (lane >> 4) & 1;
    LAS const char* vb = Vt + (4 * h + q4) * VP + (16 * blk + 4 * pp) * 2;
    bf16x8 ka[4], kc2[4]; s16x4 lo[8], hi[8];
#pragma unroll
    for (int d0 = 0; d0 < 4; ++d0) { if (dry & 64) { ka[d0] = qf[d0]; kc2[d0] = qf[d0]; } else { ka[d0] = *(LAS const bf16x8*)(kb + d0 * 32); kc2[d0] = *(LAS const bf16x8*)(kb + 32 * KP + d0 * 32); } }
#pragma unroll
    for (int i = 0; i < 4; ++i) { const int s = i >> 1, dh = i & 1; if (dry & 128) { lo[i] = s16x4{0,0,0,0}; hi[i] = lo[i]; } else { lo[i] = trr(vb + (16 * s) * VP + dh * 64); hi[i] = trr(vb + (16 * s + 8) * VP + dh * 64); } }
    __builtin_amdgcn_sched_barrier(0);
    if (!(dry & 8)) {
#pragma unroll
        for (int d0 = 0; d0 < 4; ++d0) { p0 = MFMA32(ka[d0], qf[d0], p0); p1 = MFMA32(kc2[d0], qf[d0], p1); } }
#pragma unroll
    for (int i = 4; i < 8; ++i) { const int s = i >> 1, dh = i & 1; if (dry & 128) { lo[i] = s16x4{0,0,0,0}; hi[i] = lo[i]; } else { lo[i] = trr(vb + (16 * s) * VP + dh * 64); hi[i] = trr(vb + (16 * s + 8) * VP + dh * 64); } }
    __builtin_amdgcn_sched_barrier(0);
    bf16x8 pb[4];
    float ps0 = 0.f, ps1 = 0.f;
    if (j >= c - 2 && !(dry & 256)) {
        const int bd = t - 64 * j - 4 * h; const LAS float* eb = el + (255 - bd); const int bde = active ? bd : -1;
        float bv0[16], bv1[16];
#pragma unroll
        for (int r = 0; r < 16; ++r) { bv0[r] = eb[8 * (r >> 2) + (r & 3)]; bv1[r] = eb[32 + 8 * (r >> 2) + (r & 3)]; }
#pragma unroll
        for (int r = 0; r < 16; ++r) { asm volatile("" : "+v"(bv0[r])); asm volatile("" : "+v"(bv1[r])); }
#pragma unroll
        for (int r = 0; r < 16; ++r) { const int kc = 8 * (r >> 2) + (r & 3);
            const float a = ex2((kc <= bde) ? p0[r] + bv0[r] : -1e30f), b = ex2((kc + 32 <= bde) ? p1[r] + bv1[r] : -1e30f); p0[r] = a; p1[r] = b; ps0 += a; ps1 += b; }
        pack_p(pb, p0, p1);
    } else if (MODE == 1 && j == c - 8 && !(dry & 256)) {
        const int bd = t - 64 * j - 4 * h - 512;
#pragma unroll
        for (int r = 0; r < 16; ++r) { const int kc = 8 * (r >> 2) + (r & 3);
            const float a = ex2((kc > bd) ? p0[r] : -1e30f), b = ex2((kc + 32 > bd) ? p1[r] : -1e30f); p0[r] = a; p1[r] = b; ps0 += a; ps1 += b; }
        pack_p(pb, p0, p1);
    } else {
        if (!(dry & 2)) {
#pragma unroll
        for (int r = 0; r < 16; ++r) { const float a = ex2(p0[r]), b = ex2(p1[r]); p0[r] = a; p1[r] = b; ps0 += a; ps1 += b; } }
        if (dry & 512) { pb[0] = qf[0]; pb[1] = qf[1]; pb[2] = qf[2]; pb[3] = qf[3]; } else pack_p(pb, p0, p1);
        if (MODE == 0 && !(dry & 512)) {
#pragma unroll
            for (int i = 0; i < 4; ++i) { v4u w = __builtin_bit_cast(v4u, pb[i]); w.x = active ? w.x : 0u; w.y = active ? w.y : 0u; w.z = active ? w.z : 0u; w.w = active ? w.w : 0u; pb[i] = __builtin_bit_cast(bf16x8, w); }
            ps0 = active ? ps0 : 0.f; ps1 = active ? ps1 : 0.f;
        }
    }
    lsum += ps0 + ps1;
    __builtin_amdgcn_sched_barrier(0);
    if (!(dry & 4)) {
#pragma unroll
        for (int i = 0; i < 8; ++i) { const int s = i >> 1, dh = i & 1; o[dh] = MFMA32(__builtin_shufflevector(lo[i], hi[i], 0, 1, 2, 3, 4, 5, 6, 7), pb[s], o[dh]); } }
}
DI void nsa_selwin_s(Ctx& C, const bf16* Ks, const bf16* Vs, const bf16* Kw, const bf16* Vw, const bf16* qp, int t, int c, unsigned sel_lo, unsigned sel_hi,
                     const LAS float* bl, float g_sel, float g_win, LAS float* RES, bf16* orow, int dry) {
    const int tid = C.tid, lane = C.lane, h = lane >> 5; LAS char* lds = (LAS char*)C.lds;
    bf16x8 qf[4];
    asm volatile("" : "+v"(qp));
#pragma unroll
    for (int d0 = 0; d0 < 4; ++d0) qf[d0] = *(const bf16x8*)(qp + 16 * d0);
    float lsum = 0.f; f32x16 o[2];
#pragma unroll
    for (int r = 0; r < 16; ++r) { o[0][r] = 0.f; o[1][r] = 0.f; }
    const float fbf = ex2(bl[128]); const LAS float* el = (const LAS float*)(lds + L_EL) + (bl - (const LAS float*)(lds + L_BL2)) / 132 * 320;
    const int nsel = c + 1, jw0 = c >= 8 ? c - 8 : 0, ntot = nsel + (c - jw0 + 1);
    Stg sA, sB;
#define SW_J(v_) ((v_) < nsel ? (v_) : jw0 + ((v_) - nsel))
#define SW_LD(S_, v_) do { const int j_ = SW_J(v_); if ((v_) < nsel) stage_load(S_, Ks + (size_t)j_ * 64 * PW, Vs + (size_t)j_ * 64 * PW, PW, tid); else stage_load(S_, Kw + (size_t)j_ * 64 * PW, Vw + (size_t)j_ * 64 * PW, PW, tid); } while (0)
#define SW_ST(S_, buf_) stage_store(S_, lds + L_K0 + (buf_) * KT, lds + L_V0 + (buf_) * VT, tid)
#define SW_CLOSE() do { lsum = half_sum(lsum); const float sc_ = lsum > 0.f ? g_sel / lsum : 0.f; \
        _Pragma("unroll") for (int dh = 0; dh < 2; ++dh) _Pragma("unroll") for (int r = 0; r < 16; ++r) { RES[(dh * 16 + r) * 64 + lane] += o[dh][r] * sc_; o[dh][r] = 0.f; } \
        lsum = 0.f; } while (0)
#define SW_TILE(v_, buf_) do { const int j_ = SW_J(v_); \
        if ((v_) == nsel) SW_CLOSE(); \
        if (j_ == c - 2) { lsum *= fbf; _Pragma("unroll") for (int r = 0; r < 16; ++r) { o[0][r] *= fbf; o[1][r] *= fbf; } } \
        if ((v_) < nsel) { const bool act = (((j_ < 32 ? (sel_lo >> j_) : (sel_hi >> (j_ - 32))) & 1u) != 0u); if (!(dry & 16)) nsa_tile_s<0>(lds + L_K0 + (buf_) * KT, lds + L_V0 + (buf_) * VT, qf, j_, t, c, act, el, lsum, o, lane, dry); } \
        else if (!(dry & 16)) nsa_tile_s<1>(lds + L_K0 + (buf_) * KT, lds + L_V0 + (buf_) * VT, qf, j_, t, c, true, el, lsum, o, lane, dry); } while (0)
    SW_LD(sA, 0); SW_ST(sA, 0); SW_LD(sB, 1);
    LDS_BARRIER();
    for (int v = 0; v < ntot; v += 2) {
        if (v + 2 < ntot && !(dry & 32)) SW_LD(sA, v + 2);
        SW_TILE(v, 0);
        if (v + 1 < ntot && !(dry & 32)) SW_ST(sB, 1);
        LDS_BARRIER();
        if (v + 1 >= ntot) break;
        if (v + 3 < ntot && !(dry & 32)) SW_LD(sB, v + 3);
        SW_TILE(v + 1, 1);
        if (v + 2 < ntot && !(dry & 32)) SW_ST(sA, 0);
        LDS_BARRIER();
    }
#undef SW_J
#undef SW_LD
#undef SW_ST
#undef SW_CLOSE
#undef SW_TILE
    lsum = half_sum(lsum); const float sc = lsum > 0.f ? g_win / lsum : 0.f;
#pragma unroll
    for (int dh = 0; dh < 2; ++dh)
#pragma unroll
        for (int r = 0; r < 16; ++r) o[dh][r] = RES[(dh * 16 + r) * 64 + lane] + o[dh][r] * sc;
    if (orow) store_o(orow, o, 1.0f, h);
}
DI void nsa_unit(Ctx& C, int b, int c, int dry) {
    const int tid = C.tid, lane = C.lane, w = C.wave, r32 = lane & 31, h = lane >> 5, hd = w & 3, th = w >> 2;
    const bf16* PROJ = WSP(bf16, WS_PROJ); const size_t m0 = (size_t)b * SEQ;
    LAS char* lds = (LAS char*)C.lds; LAS float* BLl = (LAS float*)(lds + L_BL2); LAS float* IMP = (LAS float*)(lds + L_IMP); LAS float* TOT = (LAS float*)(lds + L_TOT); LAS unsigned* SEL = (LAS unsigned*)(lds + L_SEL);
    const int tl = 32 * th + r32, t = 64 * c + tl;
    bf16x8 qf[4];
    { const bf16* qp = PROJ + (m0 + t) * PW + C_NQ + hd * 64 + 8 * h;
#pragma unroll
      for (int d0 = 0; d0 < 4; ++d0) qf[d0] = *(const bf16x8*)(qp + 16 * d0); }
    const float g0 = WSP(float, WS_NG)[(m0 + t) * 16 + hd * 3];
    const LAS float* bl = BLl + hd * 132;
    f32x16 res[2];
#pragma unroll
    for (int r = 0; r < 16; ++r) { res[0][r] = 0.f; res[1][r] = 0.f; }
    LAS float* MREF = (LAS float*)(lds);
    LAS float* MFIN = (LAS float*)(lds + 4096);
    if (!(dry & 1)) {
        const bf16* Kc = WSP(bf16, WS_KCMP) + (size_t)b * 256 * 64; const bf16* Vc = WSP(bf16, WS_VCMP) + (size_t)b * 256 * 64;
        const int ntc = (4 * c + 2) / 64 + 1, nlim = (t >= 31) ? ((t - 31) >> 4) : -1;
        float m_run = -1e30f, lsum = 0.f, carry = 0.f, mref0 = 0.f, mref1 = 0.f, mref2 = 0.f, mref3 = 0.f; f32x16 o[2];
#pragma unroll
        for (int r = 0; r < 16; ++r) { o[0][r] = 0.f; o[1][r] = 0.f; }
        const float bfar_c = bl[128];
        Stg st; stage_load(st, Kc, Vc, 64, tid); stage_store(st, lds + L_K0, lds + L_V0, tid);
        LDS_BARRIER();
        for (int nt = 0; nt < ntc; ++nt) {
            const int cur = nt & 1;
            if (nt + 1 < ntc) stage_load(st, Kc + (size_t)(nt + 1) * 64 * 64, Vc + (size_t)(nt + 1) * 64 * 64, 64, tid);
            f32x16 p0, p1;
#pragma unroll
            for (int r = 0; r < 16; ++r) { p0[r] = 0.f; p1[r] = 0.f; }
            qkt(p0, p1, lds + L_K0 + cur * KT, qf, lane);
            float tm = -1e30f;
            const bool allfar = c >= 16 * nt + 19;
            if (allfar) {
                float t0 = fmaxf(p0[0], p1[0]), t1 = fmaxf(p0[1], p1[1]);
#pragma unroll
                for (int r = 2; r < 16; r += 2) { t0 = fmaxf(t0, fmaxf(p0[r], p1[r])); t1 = fmaxf(t1, fmaxf(p0[r + 1], p1[r + 1])); }
                tm = fmaxf(t0, t1) + bfar_c;
            } else {
#pragma unroll
            for (int pi = 0; pi < 2; ++pi)
#pragma unroll
                for (int r = 0; r < 16; ++r) { const int n = 64 * nt + 32 * pi + crow(r, h), dist = t - 16 * n - 31; const bool valid = n <= nlim;
                    const int idx = dist < 0 ? 0 : (dist > 128 ? 128 : dist);
                    float bvv = bl[idx]; asm volatile("" : "+v"(bvv));
                    const float s = valid ? (pi ? p1[r] : p0[r]) + bvv : -1e30f; if (pi) p1[r] = s; else p0[r] = s; tm = fmaxf(tm, s); if ((r & 7) == 7) __builtin_amdgcn_sched_barrier(0); }
            }
            tm = half_max(tm); const float mn = fmaxf(m_run, tm), f = ex2(m_run - mn);
            m_run = mn; lsum *= f; carry *= f;
#pragma unroll
            for (int r = 0; r < 16; ++r) { o[0][r] *= f; o[1][r] *= f; }
            float ps = 0.f;
            if (allfar) { const float e = mn - bfar_c;
#pragma unroll
                for (int r = 0; r < 16; ++r) { p0[r] = ex2(p0[r] - e); p1[r] = ex2(p1[r] - e); ps += p0[r] + p1[r]; }
            } else {
#pragma unroll
            for (int r = 0; r < 16; ++r) { p0[r] = p0[r] > -1e29f ? ex2(p0[r] - mn) : 0.f; p1[r] = p1[r] > -1e29f ? ex2(p1[r] - mn) : 0.f; ps += p0[r] + p1[r]; }
            }
            lsum += ps;
            if (nt == 0) mref0 = mn; else if (nt == 1) mref1 = mn; else if (nt == 2) mref2 = mn; else mref3 = mn;
            float A[8], Bp[8], ob[8];
#pragma unroll
            for (int k = 0; k < 8; ++k) { const int pi = k >> 2, c4 = k & 3; const float x0 = pi ? p1[4 * c4] : p0[4 * c4], x1 = pi ? p1[4 * c4 + 1] : p0[4 * c4 + 1], x2 = pi ? p1[4 * c4 + 2] : p0[4 * c4 + 2], x3 = pi ? p1[4 * c4 + 3] : p0[4 * c4 + 3];
                Bp[k] = 0.5f * x3; A[k] = (x0 + x1) + (x2 + Bp[k]); }
#pragma unroll
            for (int k = 0; k < 8; ++k) ob[k] = __shfl_xor(Bp[k], 32);
            LAS float* ip = IMP + (hd * 64 + tl) * 64 + 16 * nt + h;
#pragma unroll
            for (int k = 0; k < 8; ++k) { const float add = (h == 1) ? ob[k] : (k == 0 ? carry : ob[k > 0 ? k - 1 : 0]); ip[2 * k] = A[k] + add; }
            carry = ob[7];
            pv(o, lds + L_V0 + cur * VT, p0, p1, lane);
            if (nt + 1 < ntc) stage_store(st, lds + L_K0 + (cur ^ 1) * KT, lds + L_V0 + (cur ^ 1) * VT, tid);
            LDS_BARRIER();
        }
        lsum = half_sum(lsum); const float inv = lsum > 0.f ? 1.0f / lsum : 0.f;
        if (h == 0) { LAS float* mr = MREF + (hd * 64 + tl) * 4; mr[0] = mref0; mr[1] = mref1; mr[2] = mref2; mr[3] = mref3; MFIN[(hd * 64 + tl) * 2] = m_run; MFIN[(hd * 64 + tl) * 2 + 1] = inv; }
#pragma unroll
        for (int r = 0; r < 16; ++r) { res[0][r] += o[0][r] * (g0 * inv); res[1][r] += o[1][r] * (g0 * inv); }
        LDS_BARRIER();
    }
    if (dry & 1) { if (tid < 128) SEL[tid] = 0xffffffffu; LDS_BARRIER(); } else {
        const int tok = tid >> 3, sub = tid & 7;
        float wsc[4][4];
#pragma unroll
        for (int hh = 0; hh < 4; ++hh) { const float mf = MFIN[(hh * 64 + tok) * 2], il = MFIN[(hh * 64 + tok) * 2 + 1];
#pragma unroll
            for (int q = 0; q < 4; ++q) wsc[hh][q] = ex2(MREF[(hh * 64 + tok) * 4 + q] - mf) * il; }
#pragma unroll
        for (int i = 0; i < 8; ++i) { const int j = sub * 8 + i; float sc;
            if (j == 0 || j == c || j == c - 1) sc = 1e30f * (1.0f - (float)j * 1e-6f); else if (j <= c) sc = ((IMP[(0 * 64 + tok) * 64 + j] * wsc[0][j >> 4] + IMP[(1 * 64 + tok) * 64 + j] * wsc[1][j >> 4]) + IMP[(2 * 64 + tok) * 64 + j] * wsc[2][j >> 4]) + IMP[(3 * 64 + tok) * 64 + j] * wsc[3][j >> 4]; else sc = -1e30f * (1.0f + (float)j * 1e-6f);
            TOT[tok * 64 + j] = sc; }
        LDS_BARRIER();
        float sj[8]; int rk[8];
        { const f32x4 a = *(const LAS f32x4*)(TOT + tok * 64 + sub * 8), b4 = *(const LAS f32x4*)(TOT + tok * 64 + sub * 8 + 4); sj[0] = a.x; sj[1] = a.y; sj[2] = a.z; sj[3] = a.w; sj[4] = b4.x; sj[5] = b4.y; sj[6] = b4.z; sj[7] = b4.w; }
#pragma unroll
        for (int i = 0; i < 8; ++i) rk[i] = 0;
#pragma unroll
        for (int k4 = 0; k4 < 16; ++k4) { const f32x4 v = *(const LAS f32x4*)(TOT + tok * 64 + 4 * k4);
#pragma unroll
            for (int i = 0; i < 8; ++i) rk[i] += (v.x > sj[i] ? 1 : 0) + (v.y > sj[i] ? 1 : 0) + (v.z > sj[i] ? 1 : 0) + (v.w > sj[i] ? 1 : 0); }
        unsigned mlo = 0u, mhi = 0u;
#pragma unroll
        for (int i = 0; i < 8; ++i) { const int j = sub * 8 + i; if (rk[i] < 16) { if (j < 32) mlo |= 1u << j; else mhi |= 1u << (j - 32); } }
        mlo |= __shfl_xor(mlo, 1); mlo |= __shfl_xor(mlo, 2); mlo |= __shfl_xor(mlo, 4);
        mhi |= __shfl_xor(mhi, 1); mhi |= __shfl_xor(mhi, 2); mhi |= __shfl_xor(mhi, 4);
        if (sub == 0) { SEL[tok * 2] = mlo; SEL[tok * 2 + 1] = mhi; }
        LDS_BARRIER();
    }
    const unsigned sel_lo = SEL[tl * 2], sel_hi = SEL[tl * 2 + 1];
    LAS float* RES = IMP + w * 2048;
#pragma unroll
    for (int dh = 0; dh < 2; ++dh)
#pragma unroll
        for (int r = 0; r < 16; ++r) RES[(dh * 16 + r) * 64 + lane] = res[dh][r];
    const bf16* qp2 = PROJ + (m0 + t) * PW + C_NQ + hd * 64 + 8 * h;
    const float* ng2 = WSP(float, WS_NG) + (m0 + t) * 16 + hd * 3;
    {
        const bool stat = NSA_STATIC && __builtin_amdgcn_readfirstlane((int)(((const LAS float*)(lds + L_NST))[hd] <= 100.0f));
        bf16* orow = dry ? (bf16*)nullptr : WSP(bf16, WS_MIX) + (m0 + t) * 1024 + 768 + hd * 64;
        if (stat) nsa_selwin_s(C, PROJ + m0 * PW + C_KS, PROJ + m0 * PW + C_VS, PROJ + m0 * PW + C_KW, PROJ + m0 * PW + C_VW, qp2, t, c, sel_lo, sel_hi, bl, ng2[1], ng2[2], RES, orow, dry);
        else nsa_selwin(C, PROJ + m0 * PW + C_KS, PROJ + m0 * PW + C_VS, PROJ + m0 * PW + C_KW, PROJ + m0 * PW + C_VW, qp2, t, c, sel_lo, sel_hi, bl, ng2[1], ng2[2], RES, orow, 0);
    }
    LDS_BARRIER();
}
}

DI void mlstm_out_unit(Ctx& C, int l, int b, int c) {
    using namespace att;
    const int tid = C.tid, lane = C.lane, w = C.wave, r32 = lane & 31, h = lane >> 5, hd = w & 3, lh = w >> 2;
    const bf16* PROJ = WSP(bf16, WS_PROJ); const bf16* QKC = WSP(bf16, WS_QKC);
    const int t0 = 64 * c; const size_t m0 = (size_t)b * SEQ + t0; const int bh = b * 4 + hd;
    LAS char* lds = (LAS char*)C.lds; LAS char* Kt = lds; LAS char* Vt = lds + 4 * KT; LAS char* Ct = lds + 4 * KT + 4 * VT;
    LAS float* vb = (LAS float*)(lds + 122880); LAS float* vi = (LAS float*)(lds + 123904); LAS float* vn = (LAS float*)(lds + 124928);
    { const int row = tid >> 3, ch = tid & 7;
#pragma unroll
      for (int hh = 0; hh < 4; ++hh) {
          *(LAS v4u*)(Kt + hh * KT + row * KP + ch * 16) = *(const v4u*)(QKC + (m0 + row) * 512 + 256 + hh * 64 + ch * 8);
          *(LAS v4u*)(Vt + hh * VT + row * VP + ch * 16) = *(const v4u*)(PROJ + (m0 + row) * PW + C_MV + hh * 64 + ch * 8);
          const float* cp = WSP(float, WS_STATE) + ((size_t)(b * 4 + hh) * 64 + c) * 4096 + row * 64 + ch * 8; const f32x4 c0 = *(const f32x4*)cp, c1 = *(const f32x4*)(cp + 4);
          v4u pc; pc.x = pk2(c0.x, c0.y); pc.y = pk2(c0.z, c0.w); pc.z = pk2(c1.x, c1.y); pc.w = pk2(c1.z, c1.w);
          *(LAS v4u*)(Ct + hh * KT + row * KP + ch * 16) = pc; }
      if (tid < 256) { const int hh = tid >> 6, i = tid & 63, bh2 = b * 4 + hh; vb[tid] = WSP(float, WS_GB)[(size_t)bh2 * SEQ + t0 + i]; vi[tid] = WSP(float, WS_GI)[(size_t)bh2 * SEQ + t0 + i]; vn[tid] = WSP(float, WS_NCH)[((size_t)bh2 * 64 + c) * 64 + i]; } }
    const int lq = 32 * lh + r32; const size_t m = m0 + lq;
    bf16x8 qf[4];
    { const bf16* qp = QKC + m * 512 + hd * 64 + 8 * h;
#pragma unroll
      for (int d0 = 0; d0 < 4; ++d0) qf[d0] = *(const bf16x8*)(qp + 16 * d0); }
    const float mprev = WSP(float, WS_MPREV)[bh * 64 + c];
    LDS_BARRIER();
    const float b_l = vb[hd * 64 + lq];
    f32x16 p0, p1;
#pragma unroll
    for (int r = 0; r < 16; ++r) { p0[r] = 0.f; p1[r] = 0.f; }
    qkt(p0, p1, Kt + hd * KT, qf, lane);
    float dl0[16], dl1[16]; float dmax = -1e30f;
#pragma unroll
    for (int g = 0; g < 4; ++g) { const f32x4 ba = *(const LAS f32x4*)(vb + hd * 64 + 8 * g + 4 * h), bb = *(const LAS f32x4*)(vb + hd * 64 + 32 + 8 * g + 4 * h), ia = *(const LAS f32x4*)(vi + hd * 64 + 8 * g + 4 * h), ib = *(const LAS f32x4*)(vi + hd * 64 + 32 + 8 * g + 4 * h);
#pragma unroll
        for (int i = 0; i < 4; ++i) { const int r = 4 * g + i, s = 8 * g + 4 * h + i; const float da = (s <= lq) ? b_l - ba[i] + ia[i] : -1e30f, db = (s + 32 <= lq) ? b_l - bb[i] + ib[i] : -1e30f; dl0[r] = da; dl1[r] = db; dmax = fmaxf(dmax, fmaxf(da, db)); } }
    dmax = half_max(dmax);
    const float m_inter = b_l + mprev, m_t = fmaxf(dmax, m_inter), inter_w = ex2((m_inter - m_t) * LOG2E);
    float dsum = 0.f;
#pragma unroll
    for (int r = 0; r < 16; ++r) { const float wa = dl0[r] > -1e29f ? ex2((dl0[r] - m_t) * LOG2E) : 0.f, wb = dl1[r] > -1e29f ? ex2((dl1[r] - m_t) * LOG2E) : 0.f; p0[r] *= wa; p1[r] *= wb; dsum += p0[r] + p1[r]; }
    dsum = half_sum(dsum);
    float nq = 0.f;
#pragma unroll
    for (int d0 = 0; d0 < 4; ++d0)
#pragma unroll
        for (int j = 0; j < 8; ++j) nq += bf2f((bf16)qf[d0][j]) * vn[hd * 64 + 16 * d0 + 8 * h + j];
    nq = half_sum(nq);
    const float den = dsum + inter_w * nq, dinv = 1.0f / fmaxf(fabsf(den), ex2(-m_t * LOG2E));
    f32x16 o[2];
#pragma unroll
    for (int r = 0; r < 16; ++r) { o[0][r] = 0.f; o[1][r] = 0.f; }
    qkt(o[0], o[1], Ct + hd * KT, qf, lane);
#pragma unroll
    for (int r = 0; r < 16; ++r) { o[0][r] *= inter_w; o[1][r] *= inter_w; }
    pv(o, Vt + hd * VT, p0, p1, lane);
    float ss = 0.f;
#pragma unroll
    for (int r = 0; r < 16; ++r) { o[0][r] *= dinv; o[1][r] *= dinv; ss += o[0][r] * o[0][r] + o[1][r] * o[1][r]; }
    ss = half_sum(ss);
    const float rs = 1.0f / sqrtf(ss * (1.0f / 64.0f) + NORM_EPS);
    const bf16* op = PROJ + m * PW + C_MO + hd * 64; const float* og = KIN(11) + l * 256 + hd * 64; bf16* orow = WSP(bf16, WS_MIX) + m * 1024 + hd * 64;
#pragma unroll
    for (int dh = 0; dh < 2; ++dh)
#pragma unroll
        for (int g = 0; g < 4; ++g) { const int d = 32 * dh + 8 * g + 4 * h; const v2u ow = *(const v2u*)(op + d); const f32x4 gg = *(const f32x4*)(og + d);
            const float y0 = o[dh][4 * g] * rs * gg.x * sigmoid_f(bflo(ow.x)), y1 = o[dh][4 * g + 1] * rs * gg.y * sigmoid_f(bfhi(ow.x)), y2 = o[dh][4 * g + 2] * rs * gg.z * sigmoid_f(bflo(ow.y)), y3 = o[dh][4 * g + 3] * rs * gg.w * sigmoid_f(bfhi(ow.y));
            v2u pw; pw.x = pk2(y0, y1); pw.y = pk2(y2, y3); *(v2u*)(orow + d) = pw; }
    LDS_BARRIER();
}

DI void p_mix(Ctx& C0, int l, int rp) {
    volatile LAS unsigned* bc = C0.MISC + 4;
    {
      const float* BLg = (const float*)(C0.ws + WS_BL); LAS float* BLl = (LAS float*)(C0.lds + att::L_BL2); LAS float* ELl = (LAS float*)(C0.lds + att::L_EL);
      for (int i = C0.tid; i < 4 * 132; i += NTHR) BLl[i] = BLg[i];
      for (int i = C0.tid; i < 4 * 320; i += NTHR) { const int hh = i / 320, dist = 255 - (i % 320); ELl[i] = dist >= 128 ? BLg[hh * 132 + 128] : (dist >= 0 ? BLg[hh * 132 + dist] : 0.f); }
      if (C0.wave == 0) { const Ctx& C = C0;
          const int ln = C0.lane; const float gq = wave_max(fabsf(KIN(15)[l * 64 + ln])), gk = wave_max(fmaxf(fabsf(KIN(16)[l * 192 + 64 + ln]), fabsf(KIN(16)[l * 192 + 128 + ln])));
          const float b0 = 64.0f * QSCALE * gq * gk * 1.02f + 0.5f;
          { const float fq = wave_max(fabsf(KIN(13)[l * 64 + ln])), fk = wave_max(fabsf(KIN(14)[l * 64 + ln])); if (ln == 0) ((LAS float*)(C0.lds + att::L_NST))[4] = 64.0f * QSCALE * fq * fk * 1.02f + 0.5f; }
#pragma unroll
          for (int hh = 0; hh < 4; ++hh) { const float mb = wave_max(fmaxf(fmaxf(fabsf(BLg[hh * 132 + ln]), fabsf(BLg[hh * 132 + 64 + ln])), fabsf(BLg[hh * 132 + 128]))); if (ln == 0) ((LAS float*)(C0.lds + att::L_NST))[hh] = b0 + mb; } }
      LDS_BARRIER(); }
    constexpr int NREG = 16 * 96 + 512, NCONV = MOE_CONV_ITEMS / 32;
    const int total = (l == 0) ? 13 * ((NCONV + 4) / 5 > (NREG + 7) / 8 ? (NCONV + 4) / 5 : (NREG + 7) / 8) : NREG;
    for (;;) {
        Ctx C = C0; { unsigned char* wsv = C0.ws; asm volatile("" : "+s"(wsv)); C.ws = wsv; int t_ = C0.tid; asm volatile("" : "+v"(t_)); C.tid = t_; C.lane = t_ & 63; }
        if (C.tid == 0) bc[0] = __hip_atomic_fetch_add((unsigned*)(C.ctl + CW_QUEUE + 64 * l + 16 * rp), 1u, RLX_AGENT);
        LDS_BARRIER();
        const int vidx = (int)bc[0];
        LDS_BARRIER();
        if (vidx >= total) break;
        int idx = vidx, cidx = -1;
#if QORDER == 1
        if (l == 0) { if (vidx >= NREG) { idx = NREG; cidx = vidx - NREG; } }
#else
        if (l == 0) { const int g = vidx / 13, r13 = vidx % 13; if (r13 < 8) idx = 8 * g + r13; else { idx = NREG; cidx = 5 * g + (r13 - 8); } }
#endif
        if (cidx >= 0) { if (cidx < NCONV && rp == 0) { LAS float* scr = (LAS float*)(C.lds + C.wave * 8448);
                moe_conv_items4(C, cidx * 32 + C.wave * 4, scr); LDS_BARRIER(); }
            continue; }
        if (idx >= NREG) continue;
        if (idx < 16 * 96) { const int lvl = idx / 96, r = idx % 96, qb = 15 - lvl;
            if (r < 32) { if (MIX_FOX && (rp == 0 || (RPF & 1))) { const bool fst = (FOX_STATIC == 2) || FOX_STATIC && __builtin_amdgcn_readfirstlane((int)(((const LAS float*)(C.lds + att::L_NST))[4] <= 100.0f)); if (fst) att::fox_unit(C, l, r >> 2, r & 3, qb); else att::fox_unit_safe(C, l, r >> 2, r & 3, qb); } }
            else if (r < 64) { if (MIX_SB && (rp == 0 || (RPF & 2))) att::sb_unit(C, (r - 32) >> 2, (r - 32) & 3, qb); }
            else { if (MIX_NSA && (rp == 0 || (RPF & 4))) att::nsa_unit(C, (r - 64) >> 2, 4 * qb + ((r - 64) & 3), rp == 0 ? 0 : NSADRY); } }
        else { if (MIX_MLSTM && (rp == 0 || (RPF & 8))) mlstm_out_unit(C, l, (idx - 16 * 96) >> 6, (idx - 16 * 96) & 63); }
    }
}

struct MoeL { int c0, c1, c2, c3, c4, c5, c6, c7, p1, p2, p3, p4, p5, p6, p7, p8; };
DI MoeL moe_layout(Ctx& C) {
    MoeL L;
#define LDC(e) ((int)__hip_atomic_load(C.ctl + CW_ECNT + (e), RLX_AGENT))
    L.c0 = LDC(0); L.c1 = LDC(1); L.c2 = LDC(2); L.c3 = LDC(3); L.c4 = LDC(4); L.c5 = LDC(5); L.c6 = LDC(6); L.c7 = LDC(7);
#undef LDC
    L.p1 = (L.c0 + 255) >> 8; L.p2 = L.p1 + ((L.c1 + 255) >> 8); L.p3 = L.p2 + ((L.c2 + 255) >> 8); L.p4 = L.p3 + ((L.c3 + 255) >> 8);
    L.p5 = L.p4 + ((L.c4 + 255) >> 8); L.p6 = L.p5 + ((L.c5 + 255) >> 8); L.p7 = L.p6 + ((L.c6 + 255) >> 8); L.p8 = L.p7 + ((L.c7 + 255) >> 8);
    return L;
}
DI void p_combine(Ctx& C, bool dry) {
    const bf16* Y1 = WSP(bf16, WS_Y1);
    const size_t N8 = (size_t)T * D / 8, st = (size_t)C.G * NTHR;
    for (size_t i = (size_t)C.blk * NTHR + C.tid; i < N8; i += 2 * st) {
        const size_t i2 = i + st; const bool two = i2 < N8; const size_t j2 = two ? i2 : i;
        const v4u y = *(const GAS v4u*)(Y1 + i * 8), y2 = *(const GAS v4u*)(Y1 + j2 * 8); f32x4* o = (f32x4*)(C.out + i * 8); f32x4* o2 = (f32x4*)(C.out + j2 * 8);
        f32x4 a = *(const GAS f32x4*)o, b = *(const GAS f32x4*)(o + 1), a2 = *(const GAS f32x4*)o2, b2 = *(const GAS f32x4*)(o2 + 1);
        a.x += bflo(y.x); a.y += bfhi(y.x); a.z += bflo(y.y); a.w += bfhi(y.y); b.x += bflo(y.z); b.y += bfhi(y.z); b.z += bflo(y.w); b.w += bfhi(y.w);
        a2.x += bflo(y2.x); a2.y += bfhi(y2.x); a2.z += bflo(y2.y); a2.w += bfhi(y2.y); b2.x += bflo(y2.z); b2.y += bfhi(y2.z); b2.z += bflo(y2.w); b2.w += bfhi(y2.w);
        if (!dry) { o[0] = a; o[1] = b; if (two) { o2[0] = a2; o2[1] = b2; } } else if (a.x == 123.456f) o[0] = b2;
    }
}

constexpr int PH_L = 20, NPH = 2 + 2 * PH_L;
struct Args { const float* in[29]; float* out; unsigned char* ws; int ph_lo, ph_hi; };
extern __shared__ __attribute__((aligned(16))) unsigned char lds_raw[];
template <class P> DI P* uni(P* p) { const unsigned long long v = (unsigned long long)p; const unsigned lo = __builtin_amdgcn_readfirstlane((unsigned)v), hi = __builtin_amdgcn_readfirstlane((unsigned)(v >> 32)); return (P*)(((unsigned long long)hi << 32) | lo); }
DI int uni(int v) { return __builtin_amdgcn_readfirstlane(v); }
DI MoeL uni(MoeL L) { MoeL R; R.c0 = uni(L.c0); R.c1 = uni(L.c1); R.c2 = uni(L.c2); R.c3 = uni(L.c3); R.c4 = uni(L.c4); R.c5 = uni(L.c5); R.c6 = uni(L.c6); R.c7 = uni(L.c7);
    R.p1 = uni(L.p1); R.p2 = uni(L.p2); R.p3 = uni(L.p3); R.p4 = uni(L.p4); R.p5 = uni(L.p5); R.p6 = uni(L.p6); R.p7 = uni(L.p7); R.p8 = uni(L.p8); return R; }
DI pg8::MoeMap mk_map(const MoeL& L, unsigned char* ws) { pg8::MoeMap m; m.c0 = L.c0; m.c1 = L.c1; m.c2 = L.c2; m.c3 = L.c3; m.c4 = L.c4; m.c5 = L.c5; m.c6 = L.c6; m.c7 = L.c7;
    m.p1 = L.p1; m.p2 = L.p2; m.p3 = L.p3; m.p4 = L.p4; m.p5 = L.p5; m.p6 = L.p6; m.p7 = L.p7; m.tokof = (const int*)(ws + WS_TOKOF); m.tokw = (const float*)(ws + WS_TOKW); return m; }
DI void mk_ctx(Ctx& C, unsigned char* ws, float* out) {
    ws = uni(ws); out = uni(out);
    { const void __attribute__((address_space(4)))* ka = (const void __attribute__((address_space(4)))*)__builtin_amdgcn_kernarg_segment_ptr(); asm volatile("" : "+s"(ka), "+s"(ws), "+s"(out)); C.ka = ka; }
    C.lds = (LAS unsigned char*)lds_raw; C.MISC = (volatile LAS unsigned*)(C.lds + MISC_OFF);
    { int t_ = threadIdx.x; asm volatile("" : "+v"(t_)); C.tid = t_; }
    C.lane = C.tid & 63; C.wave = __builtin_amdgcn_readfirstlane(C.tid >> 6); C.G = gridDim.x; C.blk = blockIdx.x;
    C.ws = ws; C.ctl = (gu32*)(ws + WS_CTL); C.out = out;
}
#ifndef PH_NOINLINE
#define PH_NOINLINE 0
#endif
#if PH_NOINLINE
#define PHFN __device__ __noinline__ void
#else
#define PHFN DI void
#endif
PHFN f_prologue(unsigned char* ws, float* out) { Ctx C; mk_ctx(C, ws, out); p_prologue(C); }
PHFN f_modfin(unsigned char* ws, float* out) { Ctx C; mk_ctx(C, ws, out); p_modfin(C); }
PHFN f_norm1(unsigned char* ws, float* out, int l) { l = uni(l); Ctx C; mk_ctx(C, ws, out); out = C.out; p_norm<false>(C, l, (l == 0) ? KIN(0) : (const float*)out, KIN(5) + l * D, 0, 1024); }
PHFN f_norm2(unsigned char* ws, float* out, int l) { l = uni(l); Ctx C; mk_ctx(C, ws, out); out = C.out; p_norm<false>(C, l, out, KIN(6) + l * D, 3072, 4096); }
PHFN f_norm2r(unsigned char* ws, float* out, int l) { l = uni(l); Ctx C; mk_ctx(C, ws, out); out = C.out; p_norm<true>(C, l, out, KIN(6) + l * D, 3072, 4096); }
PHFN f_gemm_in(unsigned char* ws, float* out, int l, int dry) { l = uni(l); dry = uni(dry); Ctx C; mk_ctx(C, ws, out);
    pg8::Gemm g{WSP(bf16, WS_H), WSP(bf16, WS_WIN) + (size_t)l * PW * D, T, PW, D}; pg8::StaticOrder S; S.init(T, PW, C.G, C.blk);
    pg8::EpiBf16N E{WSP(bf16, WS_PROJ), PW, WSP(float, WS_GT) + l * 384, (PG8_LAS float*)(C.lds + 131072), dry}; pg8::gemm_phase<pg8::EpiBf16N, pg8::StaticOrder, true, true>(C.lds, g, S, E); }
PHFN f_prep(unsigned char* ws, float* out, int l, int mode) { l = uni(l); mode = uni(mode); Ctx C; mk_ctx(C, ws, out); p_prep(C, l, mode); }
PHFN f_scan(unsigned char* ws, float* out, int l, int dry) { l = uni(l); dry = uni(dry); Ctx C; mk_ctx(C, ws, out); p_scan(C, l, dry != 0); }
PHFN f_mix(unsigned char* ws, float* out, int l, int rp) { l = uni(l); rp = uni(rp); Ctx C; mk_ctx(C, ws, out); p_mix(C, l, rp); }
PHFN f_gemm_res(unsigned char* ws, float* out, const bf16* A, const bf16* Bt, int K, const float* base, const float* gate, int dry) { dry = uni(dry); A = uni(A); Bt = uni(Bt); K = uni(K); base = uni(base); gate = uni(gate); Ctx C; mk_ctx(C, ws, out); out = C.out;
    pg8::Gemm g{A, Bt, T, D, K}; pg8::StaticOrder S; S.init(T, D, C.G, C.blk);
    pg8::EpiResGate E{base, out, gate, D, 6144, dry}; pg8::gemm_phase<pg8::EpiResGate, pg8::StaticOrder, true, true>(C.lds, g, S, E); }
PHFN f_gu(unsigned char* ws, float* out, int dry) { dry = uni(dry); Ctx C; mk_ctx(C, ws, out);
    pg8::Gemm g{WSP(bf16, WS_H), WSP(bf16, WS_WGU), T, 2 * FF, D}; pg8::StaticOrder S; S.init(T, 2 * FF, C.G, C.blk);
    pg8::EpiSwiGLU E{WSP(bf16, WS_ACT), FF, 2 * FF / 256, 0, dry}; pg8::gemm_phase<pg8::EpiSwiGLU, pg8::StaticOrder, GU_ALIGN, true>(C.lds, g, S, E); }
PHFN f_mgu(unsigned char* ws, float* out, MoeL L, int t0, int nt, int dry) { dry = uni(dry); L = uni(L); t0 = uni(t0); nt = uni(nt); Ctx C; mk_ctx(C, ws, out);
    pg8::Gemm g{WSP(bf16, WS_H), WSP(bf16, WS_MWGU), 0, 0, D};
    pg8::MoeOrder S{t0, nt, 2 * FFE / 256, C.G, C.blk, 0, mk_map(L, C.ws)};
    pg8::EpiSwiGLU E{t0 == 256 ? WSP(bf16, WS_ACT2) : WSP(bf16, WS_ACTE), FFE, 2 * FFE / 256, t0 * 256, dry}; pg8::gemm_phase_ga<pg8::EpiSwiGLU, pg8::MoeOrder, GU_ALIGN, true>(C.lds, g, S, E); }
PHFN f_mdown(unsigned char* ws, float* out, MoeL L, int t0, int nt, const float* gate, int dry) { dry = uni(dry); L = uni(L); t0 = uni(t0); nt = uni(nt); gate = uni(gate); Ctx C; mk_ctx(C, ws, out); out = C.out;
    pg8::Gemm g{t0 == 256 ? WSP(bf16, WS_ACT2) : WSP(bf16, WS_ACTE), WSP(bf16, WS_MWD), 0, 0, FFE};
    pg8::MoeOrder S{t0, nt, D / 256, C.G, C.blk, t0, mk_map(L, C.ws)};
    pg8::EpiMoeDown E{mk_map(L, C.ws), out, WSP(bf16, WS_Y1), gate, 6144, t0, D / 256, dry};
    pg8::gemm_phase<pg8::EpiMoeDown, pg8::MoeOrder, true, true>(C.lds, g, S, E); }
PHFN f_mgu_tail(unsigned char* ws, float* out, MoeL L, int t0, int ntail, const float* gate) { L = uni(L); t0 = uni(t0); ntail = uni(ntail); gate = uni(gate); Ctx C; mk_ctx(C, ws, out); out = C.out;
    { pg8::Gemm g{WSP(bf16, WS_ACT2), WSP(bf16, WS_MWD), 0, 0, FFE};
      pg8::MoeOrder S{256, ntail, D / 256, C.G, C.blk, 256, mk_map(L, C.ws)};
      pg8::EpiMoeDown E{mk_map(L, C.ws), out, WSP(bf16, WS_Y1), gate, 6144, 256, D / 256, 0};
      pg8::gemm_phase<pg8::EpiMoeDown, pg8::MoeOrder, true, true>(C.lds, g, S, E); }
    { pg8::Gemm g{WSP(bf16, WS_H), WSP(bf16, WS_MWGU), 0, 0, D};
      pg8::MoeOrderB S{t0, 2 * FFE / 256, C.blk, 4 * ntail, mk_map(L, C.ws)};
      pg8::EpiSwiGLU E{WSP(bf16, WS_ACTE), FFE, 2 * FFE / 256, t0 * 256, 0}; pg8::gemm_phase_ga<pg8::EpiSwiGLU, pg8::MoeOrderB, GU_ALIGN, true>(C.lds, g, S, E); }
}
PHFN f_combine(unsigned char* ws, float* out, int dry) { dry = uni(dry); Ctx C; mk_ctx(C, ws, out); p_combine(C, dry != 0); }

__global__ void __launch_bounds__(NTHR, 2) fwd(Args args) {
    unsigned char* const ws = args.ws; float* const out = args.out;
    volatile LAS unsigned* MISC = (volatile LAS unsigned*)((LAS unsigned char*)lds_raw + MISC_OFF);
    for (int u = threadIdx.x; u < (LDS_BYTES - MISC_OFF) / 4; u += NTHR) MISC[u] = 0u;
    __syncthreads();
    const int lo = args.ph_lo, hi = args.ph_hi;
    XcdBarrier bar; bar.bar = (unsigned*)(ws + WS_CTL) + CW_BAR; bar.x = 0; bar.st = nullptr;
    if (hi - lo > 1) bar = xcd_barrier_post((unsigned*)(ws + WS_CTL) + CW_BAR, MISC + 0);
#define IN(k) (lo <= (k) && (k) < hi)
#define SEAM(k) do { if (IN(k) && IN((k) + 1)) xcd_barrier(bar); } while (0)
    if (EN_PRO && IN(0)) for (int rp_ = 0; rp_ < REP_PRO; ++rp_) f_prologue(ws, out); SEAM(0);
    if (EN_PRO && IN(1)) f_modfin(ws, out); SEAM(1);
    for (int xb_ = 0; xb_ < XTRA_BAR; ++xb_) xcd_barrier(bar);
#pragma unroll 1
    for (int l = 0; l < DEPTH; ++l) {
        const int pb = 2 + PH_L * l;
        const float* MOD = (const float*)(ws + WS_MOD) + (size_t)l * 8 * 6144;
        if (EN_NORM && IN(pb + 0)) for (int rp_ = 0; rp_ < REP_NORM; ++rp_) f_norm1(ws, out, l); SEAM(pb + 0);
        if (EN_GIN && IN(pb + 1)) for (int rp_ = 0; rp_ < REP_GIN; ++rp_) f_gemm_in(ws, out, l, rp_ ? GDRY : 0); SEAM(pb + 1);
        if (EN_PREP && IN(pb + 2)) for (int rp_ = 0; rp_ < REP_PREP; ++rp_) f_prep(ws, out, l, rp_ == 0 ? 0 : PREP_RMODE); SEAM(pb + 2);
        if (EN_SCAN && IN(pb + 3)) for (int rp_ = 0; rp_ < REP_THIN; ++rp_) f_scan(ws, out, l, rp_); SEAM(pb + 3);
        if (EN_MIX && IN(pb + 4)) for (int rp_ = 0; rp_ < REP_MIX; ++rp_) f_mix(ws, out, l, rp_); SEAM(pb + 4);
        if (EN_GOUT && IN(pb + 5)) for (int rp_ = 0; rp_ < REP_RES; ++rp_) f_gemm_res(ws, out, (const bf16*)(ws + WS_MIX), (const bf16*)(ws + WS_WOUT) + (size_t)l * D * D, D, (l == 0) ? ((const float* const __attribute__((address_space(4)))*)__builtin_amdgcn_kernarg_segment_ptr())[0] : (const float*)out, MOD + 2048, rp_); SEAM(pb + 5);
        if (l == 0) {
            if (EN_NORM && IN(pb + 6)) for (int rp_ = 0; rp_ < REP_THIN; ++rp_) f_norm2(ws, out, l); SEAM(pb + 6);
            if (EN_GU && IN(pb + 7)) for (int rp_ = 0; rp_ < REP_GU; ++rp_) f_gu(ws, out, rp_ ? GDRY : 0); SEAM(pb + 7);
            if (EN_DOWN && IN(pb + 8)) for (int rp_ = 0; rp_ < REP_RES; ++rp_) f_gemm_res(ws, out, (const bf16*)(ws + WS_ACT), (const bf16*)(ws + WS_WD), FF, out, MOD + 5120, rp_); SEAM(pb + 8);
        } else {
            if (EN_MOE && IN(pb + 6)) f_norm2r(ws, out, l); SEAM(pb + 6);
            Ctx C; mk_ctx(C, ws, out);
            const MoeL L = uni(moe_layout(C));
            const int ntail = L.p8 - 4 * CHUNK_TILES;
            if (EN_MGU && IN(pb + 8)) for (int rp_ = 0; rp_ < REP_GU; ++rp_) f_mgu(ws, out, L, 0, CHUNK_TILES, rp_ ? GDRY : 0); SEAM(pb + 8);
            if (EN_MDOWN && IN(pb + 9)) f_mdown(ws, out, L, 0, CHUNK_TILES, MOD + 5120, 0); SEAM(pb + 9);
            if (ntail > 0) { if (EN_MGU && IN(pb + 10)) f_mgu(ws, out, L, 4 * CHUNK_TILES, ntail, 0); SEAM(pb + 10); }
            if (ntail > 0) { if (EN_MGU && IN(pb + 11)) f_mgu_tail(ws, out, L, CHUNK_TILES, ntail, MOD + 5120); }
            else { if (EN_MGU && IN(pb + 11)) f_mgu(ws, out, L, CHUNK_TILES, CHUNK_TILES, 0); }
            SEAM(pb + 11);
            if (EN_MDOWN && IN(pb + 12)) f_mdown(ws, out, L, CHUNK_TILES, CHUNK_TILES, MOD + 5120, 0); SEAM(pb + 12);
            if (EN_MGU && IN(pb + 13)) for (int rp_ = 0; rp_ < REP_GU; ++rp_) f_mgu(ws, out, L, 2 * CHUNK_TILES, CHUNK_TILES, rp_ ? GDRY : 0); SEAM(pb + 13);
            if (EN_MDOWN && IN(pb + 14)) f_mdown(ws, out, L, 2 * CHUNK_TILES, CHUNK_TILES, MOD + 5120, 0); SEAM(pb + 14);
            if (EN_MGU && IN(pb + 15)) for (int rp_ = 0; rp_ < REP_GU; ++rp_) f_mgu(ws, out, L, 3 * CHUNK_TILES, CHUNK_TILES, rp_ ? GDRY : 0); SEAM(pb + 15);
            if (EN_MDOWN && IN(pb + 16)) f_mdown(ws, out, L, 3 * CHUNK_TILES, CHUNK_TILES, MOD + 5120, 0); SEAM(pb + 16);
            if (EN_MOE && IN(pb + 18)) for (int rp_ = 0; rp_ < REP_THIN; ++rp_) f_combine(ws, out, rp_);
        }
    }
#undef IN
#undef SEAM
}

extern "C" void kernel_launch(void* const* d_in, const int* in_sizes, int n_in, void* d_out, int out_size, void* d_ws, size_t ws_size, hipStream_t stream) {
    static int grid = 0;
    if (grid == 0) {
        if (n_in != 29 || in_sizes[0] != T * D || out_size != T * D || ws_size < WS_END) { fprintf(stderr, "kernel_launch: unexpected shapes (n_in %d, in0 %d, out %d, ws %zu)\n", n_in, n_in > 0 ? in_sizes[0] : -1, out_size, ws_size); grid = -1; return; }
        if (hipFuncSetAttribute((const void*)fwd, hipFuncAttributeMaxDynamicSharedMemorySize, LDS_BYTES) != hipSuccess) { fprintf(stderr, "kernel_launch: hipFuncSetAttribute failed\n"); grid = -1; return; }
        int dev = 0, cus = 0, per_cu = 0;
        (void)hipGetDevice(&dev); (void)hipDeviceGetAttribute(&cus, hipDeviceAttributeMultiprocessorCount, dev);
        if (hipOccupancyMaxActiveBlocksPerMultiprocessor(&per_cu, (const void*)fwd, NTHR, LDS_BYTES) != hipSuccess || per_cu < 1) fprintf(stderr, "kernel_launch: occupancy query says %d per CU\n", per_cu);
        (void)hipGetLastError();
        grid = 256;
        if (cus < 256) fprintf(stderr, "kernel_launch: device has %d CUs; this kernel needs 256\n", cus);
    }
    if (grid < 0) return;
    (void)hipMemsetAsync((char*)d_ws + WS_CTL, 0, CTL_ZERO_BYTES, stream);
    Args a{};
    for (int i = 0; i < 29; ++i) a.in[i] = (const float*)d_in[i];
    a.out = (float*)d_out; a.ws = (unsigned char*)d_ws;
#if N_LAUNCHES == 1
    a.ph_lo = 0; a.ph_hi = NPH;
    hipLaunchKernelGGL(fwd, dim3(grid), dim3(NTHR), LDS_BYTES, stream, a);
#else
    for (int k = 0; k < NPH; ++k) {
        const int r = (k - 2) % PH_L; if (k >= 2 && ((k < 2 + PH_L && r > 8) || (k >= 2 + PH_L && r > 18))) continue;
        a.ph_lo = k; a.ph_hi = k + 1;
        hipLaunchKernelGGL(fwd, dim3(grid), dim3(NTHR), LDS_BYTES, stream, a);
    }
#endif
}
```

```cpp
#include <hip/hip_runtime.h>
#include <cstdio>
#include <cstdint>
#include <cmath>
#ifndef N_LAUNCHES
#define N_LAUNCHES 1
#endif
#ifndef RES_BATCH
#define RES_BATCH 4
#endif
#ifndef FOX_STATIC
#define FOX_STATIC 1
#endif
#ifndef NSA_STATIC
#define NSA_STATIC 1
#endif
#ifndef MIX_FOX
#define MIX_FOX 1
#endif
#ifndef MIX_SB
#define MIX_SB 1
#endif
#ifndef MIX_NSA
#define MIX_NSA 1
#endif
#ifndef MIX_MLSTM
#define MIX_MLSTM 1
#endif
#ifndef EN_PRO
#define EN_PRO 1
#endif
#ifndef EN_NORM
#define EN_NORM 1
#endif
#ifndef EN_GIN
#define EN_GIN 1
#endif
#ifndef EN_PREP
#define EN_PREP 1
#endif
#ifndef EN_SCAN
#define EN_SCAN 1
#endif
#ifndef EN_MIX
#define EN_MIX 1
#endif
#ifndef EN_GOUT
#define EN_GOUT 1
#endif
#ifndef EN_GU
#define EN_GU 1
#endif
#ifndef EN_DOWN
#define EN_DOWN 1
#endif
#ifndef EN_MOE
#define EN_MOE 1
#endif
#ifndef EN_MGU
#define EN_MGU 1
#endif
#ifndef EN_MDOWN
#define EN_MDOWN 1
#endif
#ifndef REP_PRO
#define REP_PRO 1
#endif
#ifndef REP_GIN
#define REP_GIN 1
#endif
#ifndef REP_PREP
#define REP_PREP 1
#endif
#ifndef REP_MIX
#define REP_MIX 1
#endif
#ifndef REP_GU
#define REP_GU 1
#endif
#ifndef REP_NORM
#define REP_NORM 1
#endif
#ifndef REPU_FOX
#define REPU_FOX 1
#endif
#ifndef REPU_SB
#define REPU_SB 1
#endif
#ifndef REPU_NSA
#define REPU_NSA 1
#endif
#ifndef REPU_ML
#define REPU_ML 1
#endif
#ifndef XTRA_BAR
#define XTRA_BAR 0
#endif
#ifndef REP_GATHER
#define REP_GATHER 1
#endif
#ifndef REP_RES
#define REP_RES 1
#endif
#ifndef RPF
#define RPF 15
#endif
#ifndef NSADRY
#define NSADRY 0
#endif
#ifndef GU_ALIGN
#define GU_ALIGN true
#endif
#ifndef REP_THIN
#define REP_THIN 1
#endif
#ifndef PREP_RMODE
#define PREP_RMODE 1
#endif
#ifndef GDRY
#define GDRY 0
#endif
#ifndef QORDER
#define QORDER 0
#endif
namespace pg8 {
#define PG8_LAS __attribute__((address_space(3)))
typedef unsigned short bf16_t;
typedef short bf16x8 __attribute__((ext_vector_type(8)));
typedef float f32x4 __attribute__((ext_vector_type(4)));
typedef unsigned u32x4 __attribute__((ext_vector_type(4)));
constexpr int BM = 256, BK = 64, HALF = 128, HTB = HALF * BK * 2  , STAGE_BYTES = 8 * HTB, NXCD = 8, WGM = 8;

__host__ __device__ __forceinline__ int lds_byte(int r, int c) { const int st = (r >> 4) * 2 + (c >> 5), rr = r & 15, cc = c & 31, ob = rr * 64 + cc * 2; return st * 1024 + (ob ^ (((ob >> 9) & 1) << 5)); }
__host__ __device__ __forceinline__ void stage_rc(int b, int& R, int& C) { const int st = b / 1024, sb = b % 1024, swz = sb ^ (((sb >> 9) & 1) << 5); R = (st >> 1) * 16 + swz / 64; C = (st & 1) * 32 + (swz % 64) / 2; }
__host__ __device__ __forceinline__ int perm32(int rho) { const int n = rho >> 4, i = rho & 15; return 8 * (i >> 2) + 4 * n + (i & 3); }

struct Unit { int pm, pn; };
struct Gemm { const bf16_t* A; const bf16_t* Bt; int M, N, K; };

struct StaticOrder {
    int nM, nN, nwg, G, c;
    __host__ __device__ void init(int M, int N, int G_, int c_) { nM = M / BM; nN = N / BM; nwg = nM * nN; G = G_; c = c_; }
    __host__ __device__ bool next(int i, Unit& u) const {
        const long L = (long)i * G + c; if (L >= nwg) return false;
        int wgid = (int)L; { const int q = nwg / NXCD, r = nwg % NXCD, xcd = wgid % NXCD, off = wgid / NXCD; wgid = (xcd < r ? xcd * (q + 1) : r * (q + 1) + (xcd - r) * q) + off; }
        const int nig = WGM * nN, gid = wgid / nig, fm = gid * WGM, gsz = (nM - fm) < WGM ? (nM - fm) : WGM;
        u.pm = fm + ((wgid % nig) % gsz); u.pn = (wgid % nig) / gsz; return true;
    }
    __device__ __forceinline__ void a_ready(const Unit&) const {}
    __device__ __forceinline__ void done(const Unit&) const {}
};
__device__ __forceinline__ unsigned cvt_pk_bf16(float lo, float hi) { unsigned r; asm volatile("v_cvt_pk_bf16_f32 %0, %1, %2" : "=v"(r) : "v"(lo), "v"(hi)); return r; }
typedef float f32x2 __attribute__((ext_vector_type(2)));

__device__ __forceinline__ float silu_f(float x) { return x * __builtin_amdgcn_rcpf(1.0f + __builtin_amdgcn_exp2f(-1.4426950408889634f * x)); }
struct EpiBf16 {
    static constexpr bool PERM = true, AFTER_DRAIN = false;
    bf16_t* O; int ldc; int dry;
    __device__ __forceinline__ void operator()(const f32x4 (&acc)[2][2][4][2], const Unit& u, int wr, int wc, int fr, int fq) const {
        if (dry) return;
        const int row0 = u.pm * BM + wr * 64 + fr, col0 = u.pn * BM + wc * 32 + 8 * fq;
#pragma unroll
        for (int ai = 0; ai < 2; ++ai)
#pragma unroll
            for (int m = 0; m < 4; ++m) { bf16_t* rowp = O + (size_t)(row0 + ai * HALF + m * 16) * ldc + col0;
#pragma unroll
                for (int bj = 0; bj < 2; ++bj) { const f32x4 v0 = acc[ai][bj][m][0], v1 = acc[ai][bj][m][1];
                    u32x4 w; w.x = cvt_pk_bf16(v0[0], v0[1]); w.y = cvt_pk_bf16(v0[2], v0[3]); w.z = cvt_pk_bf16(v1[0], v1[1]); w.w = cvt_pk_bf16(v1[2], v1[3]);
                    *(u32x4*)(rowp + bj * HALF) = w; } }
    }
};
struct EpiBf16N {
    static constexpr bool PERM = true, AFTER_DRAIN = false;
    bf16_t* O; int ldc; const float* GT; PG8_LAS float* SC; int dry;
    __device__ __forceinline__ static int head_type(int hc) { return (hc >= 1024 && hc < 1280) ? 0 : (hc >= 1280 && hc < 1536) ? 1 : (hc >= 1792 && hc < 2048) ? 2 : (hc >= 2560 && hc < 2816) ? 3 : hc == 2944 ? 4 : hc == 3072 ? 5 : -1; }
    __device__ __forceinline__ void operator()(const f32x4 (&acc)[2][2][4][2], const Unit& u, int wr, int wc, int fr, int fq) const {
        if (dry) return;
        asm volatile("" : "+v"(fr), "+v"(fq));
        const int pn = __builtin_amdgcn_readfirstlane(u.pn);
        const int row0 = u.pm * BM + wr * 64 + fr, col0 = pn * BM + wc * 32 + 8 * fq;
        const bool ntile = (pn == 4) | (pn == 5) | (pn == 10) | (pn == 11) | (pn == 12), stile = ntile | (pn == 7);
        if (!stile) {
#pragma unroll
            for (int ai = 0; ai < 2; ++ai)
#pragma unroll
                for (int m = 0; m < 4; ++m) { bf16_t* rowp = O + (size_t)(row0 + ai * HALF + m * 16) * ldc + col0;
#pragma unroll
                    for (int bj = 0; bj < 2; ++bj) { const f32x4 v0 = acc[ai][bj][m][0], v1 = acc[ai][bj][m][1];
                        u32x4 w; w.x = cvt_pk_bf16(v0[0], v0[1]); w.y = cvt_pk_bf16(v0[2], v0[3]); w.z = cvt_pk_bf16(v1[0], v1[1]); w.w = cvt_pk_bf16(v1[2], v1[3]);
                        *(u32x4*)(rowp + bj * HALF) = w; } }
            return;
        }
        const int wid = wr * 4 + wc;
#pragma unroll
        for (int bj = 0; bj < 2; ++bj) {
            const int ty = head_type(pn * BM + bj * HALF + (wc >> 1) * 64);
            const bool nrm = ntile && ty >= 0 && ty != 2;
            float ps[2][4];
            if (ntile) {
#pragma unroll
                for (int ai = 0; ai < 2; ++ai)
#pragma unroll
                    for (int m = 0; m < 4; ++m) { const f32x4 v0 = acc[ai][bj][m][0], v1 = acc[ai][bj][m][1];
                        float ss = (v0[0] * v0[0] + v0[1] * v0[1]) + (v0[2] * v0[2] + v0[3] * v0[3]) + (v1[0] * v1[0] + v1[1] * v1[1]) + (v1[2] * v1[2] + v1[3] * v1[3]);
                        ss += __shfl_xor(ss, 16); ss += __shfl_xor(ss, 32);
                        ps[ai][m] = ss;
                        if (fq == 0) SC[(wid * 16 + bj * 8 + ai * 4 + m) * 16 + fr] = ss; }
                asm volatile("s_waitcnt lgkmcnt(0)" ::: "memory");
                __builtin_amdgcn_s_barrier();
            }
            f32x4 g0 = (f32x4){1.f, 1.f, 1.f, 1.f}, g1 = g0;
            if (ty >= 0) { const float* gp = GT + ty * 64 + (wc & 1) * 32 + 8 * fq; g0 = *(const f32x4*)gp; g1 = *(const f32x4*)(gp + 4); }
#pragma unroll
            for (int ai = 0; ai < 2; ++ai)
#pragma unroll
                for (int m = 0; m < 4; ++m) { float r = 1.0f;
                    if (nrm) { const float tot = ps[ai][m] + SC[((wid ^ 1) * 16 + bj * 8 + ai * 4 + m) * 16 + fr]; r = __builtin_amdgcn_rsqf(tot * (1.0f / 64.0f) + 1e-6f); }
                    const f32x4 v0 = acc[ai][bj][m][0] * g0 * r, v1 = acc[ai][bj][m][1] * g1 * r;
                    u32x4 w; w.x = cvt_pk_bf16(v0[0], v0[1]); w.y = cvt_pk_bf16(v0[2], v0[3]); w.z = cvt_pk_bf16(v1[0], v1[1]); w.w = cvt_pk_bf16(v1[2], v1[3]);
                    *(u32x4*)(O + (size_t)(row0 + ai * HALF + m * 16) * ldc + col0 + bj * HALF) = w; }
        }
    }
};
struct EpiResGate {
    static constexpr bool PERM = false, AFTER_DRAIN = false;
    const float* base; float* out; const float* gate; int ldc; int gate_ld; int dry;
    __device__ __forceinline__ void operator()(const f32x4 (&acc)[2][2][4][2], const Unit& u, int wr, int wc, int fr, int fq) const {
        if (dry) return;
        const int row0 = u.pm * BM + wr * 64 + fr, col0 = u.pn * BM + wc * 32 + 4 * fq;
        const float* gp = gate + (size_t)((u.pm * BM) >> 12) * gate_ld + col0;
        f32x4 gv[2][2];
#pragma unroll
        for (int bj = 0; bj < 2; ++bj)
#pragma unroll
            for (int n = 0; n < 2; ++n) gv[bj][n] = *(const f32x4*)(gp + bj * HALF + n * 16);
#pragma unroll
        for (int ai = 0; ai < 2; ++ai)
#pragma unroll
            for (int mb = 0; mb < 4; mb += RES_BATCH) {
                f32x4 bs[RES_BATCH][2][2];
#pragma unroll
                for (int mi = 0; mi < RES_BATCH; ++mi) { const size_t off = (size_t)(row0 + ai * HALF + (mb + mi) * 16) * ldc + col0;
#pragma unroll
                    for (int bj = 0; bj < 2; ++bj)
#pragma unroll
                        for (int n = 0; n < 2; ++n) bs[mi][bj][n] = *(const __attribute__((address_space(1))) f32x4*)(base + off + bj * HALF + n * 16); }
                asm volatile("" ::: "memory");
#pragma unroll
                for (int mi = 0; mi < RES_BATCH; ++mi) { const size_t off = (size_t)(row0 + ai * HALF + (mb + mi) * 16) * ldc + col0;
#pragma unroll
                    for (int bj = 0; bj < 2; ++bj)
#pragma unroll
                        for (int n = 0; n < 2; ++n) *(__attribute__((address_space(1))) f32x4*)(out + off + bj * HALF + n * 16) = bs[mi][bj][n] + gv[bj][n] * acc[ai][bj][mb + mi][n]; }
                asm volatile("" ::: "memory"); }
    }
};
struct EpiSwiGLU {
    static constexpr bool PERM = true, AFTER_DRAIN = false;
    bf16_t* O; int ldc; int pn_mod; int row_sub; int dry;
    __device__ __forceinline__ void operator()(const f32x4 (&acc)[2][2][4][2], const Unit& u, int wr, int wc, int fr, int fq) const {
        if (dry) return;
        const int row0 = u.pm * BM - row_sub + wr * 64 + fr, col0 = (u.pn % pn_mod) * HALF + wc * 32 + 8 * fq;
#pragma unroll
        for (int ai = 0; ai < 2; ++ai)
#pragma unroll
            for (int m = 0; m < 4; ++m) { bf16_t* rowp = O + (size_t)(row0 + ai * HALF + m * 16) * ldc + col0;
                const f32x4 g0 = acc[ai][0][m][0], g1 = acc[ai][0][m][1], u0 = acc[ai][1][m][0], u1 = acc[ai][1][m][1];
                float v[8];
#pragma unroll
                for (int j = 0; j < 4; ++j) { v[j] = silu_f(g0[j]) * u0[j]; v[4 + j] = silu_f(g1[j]) * u1[j]; }
                u32x4 w; w.x = cvt_pk_bf16(v[0], v[1]); w.y = cvt_pk_bf16(v[2], v[3]); w.z = cvt_pk_bf16(v[4], v[5]); w.w = cvt_pk_bf16(v[6], v[7]);
                *(u32x4*)rowp = w; }
    }
};
struct MoeMap {
    int c0, c1, c2, c3, c4, c5, c6, c7, p1, p2, p3, p4, p5, p6, p7; const int* tokof; const float* tokw;
    __device__ __forceinline__ int expert(int tile) const { return (tile >= p1) + (tile >= p2) + (tile >= p3) + (tile >= p4) + (tile >= p5) + (tile >= p6) + (tile >= p7); }
    __device__ __forceinline__ int index(int tile, int r) const {
        tile = __builtin_amdgcn_readfirstlane(tile);
        const int g1 = tile >= p1, g2 = tile >= p2, g3 = tile >= p3, g4 = tile >= p4, g5 = tile >= p5, g6 = tile >= p6, g7 = tile >= p7;
        const int e = g1 + g2 + g3 + g4 + g5 + g6 + g7;
        int pte = g1 * p1; pte = max(pte, g2 * p2); pte = max(pte, g3 * p3); pte = max(pte, g4 * p4); pte = max(pte, g5 * p5); pte = max(pte, g6 * p6); pte = max(pte, g7 * p7);
        const int ce = c0 + g1 * (c1 - c0) + g2 * (c2 - c1) + g3 * (c3 - c2) + g4 * (c4 - c3) + g5 * (c5 - c4) + g6 * (c6 - c5) + g7 * (c7 - c6);
        const int slot = (tile - pte) * 256 + r; return slot < ce ? e * 32768 + slot : -1; }
};
struct EpiMoeDown {
    static constexpr bool PERM = false, AFTER_DRAIN = false;
    MoeMap mm; float* out; bf16_t* y1; const float* gate; int gate_ld; int tile_add; int pn_mod; int dry;
    __device__ __forceinline__ void operator()(const f32x4 (&acc)[2][2][4][2], const Unit& u, int wr, int wc, int fr, int fq) const {
        if (dry) return;
        asm volatile("" : "+v"(fr), "+v"(fq));
        const int tile = u.pm + tile_add, rl0 = wr * 64 + fr, col0 = (u.pn % pn_mod) * BM + wc * 32 + 4 * fq;
        int tks[8]; float ws[8];
#pragma unroll
        for (int q = 0; q < 8; ++q) { const int ix = mm.index(tile, rl0 + (q >> 2) * HALF + (q & 3) * 16); tks[q] = ix >= 0 ? mm.tokof[ix] : -1; ws[q] = ix >= 0 ? mm.tokw[ix] : 0.f; }
        typedef const __attribute__((address_space(1))) f32x4* gld_t;
        const float* __restrict__ gate_r = gate;
#pragma unroll
        for (int ai = 0; ai < 2; ++ai)
#pragma unroll
            for (int mp = 0; mp < 4; mp += 2) {
                f32x4 ov[2][2][2];
#pragma unroll
                for (int mi = 0; mi < 2; ++mi) { const int tk = tks[ai * 4 + mp + mi];
                    if (tk >= 0 && !((tk >> 30) & 1)) { const size_t off = (size_t)(tk & 0x3fffffff) * 1024 + col0;
#pragma unroll
                        for (int bj = 0; bj < 2; ++bj)
#pragma unroll
                            for (int n = 0; n < 2; ++n) ov[mi][bj][n] = *(gld_t)(out + off + bj * HALF + n * 16); } }
#pragma unroll
                for (int mi = 0; mi < 2; ++mi) { const int m = mp + mi, tk = tks[ai * 4 + m];
                    if (tk >= 0) { const float w = ws[ai * 4 + m]; const int tok = tk & 0x3fffffff; const bool s1 = (tk >> 30) & 1; const size_t off = (size_t)tok * 1024 + col0;
                        const float* __restrict__ gp = gate_r + (size_t)(tok >> 12) * gate_ld + col0;
                        f32x4 gvv[2][2];
#pragma unroll
                        for (int bj = 0; bj < 2; ++bj)
#pragma unroll
                            for (int n = 0; n < 2; ++n) gvv[bj][n] = *(gld_t)(gp + bj * HALF + n * 16);
#pragma unroll
                        for (int bj = 0; bj < 2; ++bj)
#pragma unroll
                            for (int n = 0; n < 2; ++n) { const f32x4 v = gvv[bj][n] * acc[ai][bj][m][n] * w;
                                if (s1) { typedef unsigned u32x2v __attribute__((ext_vector_type(2))); u32x2v pw; pw.x = cvt_pk_bf16(v[0], v[1]); pw.y = cvt_pk_bf16(v[2], v[3]); *(u32x2v*)(y1 + off + bj * HALF + n * 16) = pw; }
                                else { *(f32x4*)(out + off + bj * HALF + n * 16) = ov[mi][bj][n] + v; } } } }
                asm volatile("" ::: "memory"); }
    }
};
struct MoeOrder {
    int t0, nt, ncol, G, c, pm_off; MoeMap mm;
    __device__ __forceinline__ bool next(int i, Unit& u) const {
        int tile, pnr;
        if (nt == 64 && G == 256) {
            pnr = i * 4 + (c >> 6); if (pnr >= ncol) return false; tile = t0 + (c & 7) * 8 + ((c >> 3) & 7);
        } else { const long L = (long)i * G + c; if (L >= (long)nt * ncol) return false; const int idx = (int)L; tile = t0 + idx % nt; pnr = idx / nt; }
        u.pm = tile - pm_off; u.pn = mm.expert(tile) * ncol + pnr; return true;
    }
    __device__ __forceinline__ unsigned row_byte(const Unit& u, int r) const { const int ix = mm.index(u.pm + pm_off, r); const int tok = ix >= 0 ? (mm.tokof[ix] & 0x3fffffff) : 0; return (unsigned)tok * 2048u; }
    __device__ __forceinline__ void a_ready(const Unit&) const {}
    __device__ __forceinline__ void done(const Unit&) const {}
};
struct MoeOrderB {
    int t0, ncol, c, nd; MoeMap mm;
    __device__ __forceinline__ bool next(int i, Unit& u) const {
        int ii = i, cc = c;
        if (c < nd) { if (i >= 4) return false; }
        else if (i == 7) { const int k = c - nd; if (k >= 3 * nd) return false; ii = 4 + k / nd; cc = k % nd; }
        else if (i > 7) return false;
        const int pnr = ii * 4 + (cc >> 6); if (pnr >= ncol) return false;
        const int tile = t0 + (cc & 7) * 8 + ((cc >> 3) & 7);
        u.pm = tile; u.pn = mm.expert(tile) * ncol + pnr; return true;
    }
    __device__ __forceinline__ unsigned row_byte(const Unit& u, int r) const { const int ix = mm.index(u.pm, r); const int tok = ix >= 0 ? (mm.tokof[ix] & 0x3fffffff) : 0; return (unsigned)tok * 2048u; }
    __device__ __forceinline__ void a_ready(const Unit&) const {}
    __device__ __forceinline__ void done(const Unit&) const {}
};
template <class Epi, class Sched, bool ALIGN_EPI = false, bool SP2 = false>
__device__ __forceinline__ void gemm_phase(PG8_LAS unsigned char* lds, const Gemm g, const Sched& S, const Epi& E) {
    int tid_ = threadIdx.x; asm volatile("" : "+v"(tid_));
    const int tid = tid_, wid = __builtin_amdgcn_readfirstlane(tid >> 6), lane = tid & 63, wr = wid >> 2, wc = wid & 3, fr = lane & 15, fq = lane >> 4;
    const int K = g.K, nt = K / BK;
    unsigned voffA[2], voffB[2];
#pragma unroll
    for (int i = 0; i < 2; ++i) { int R, C; stage_rc(tid * 16 + i * 8192, R, C); const int Rb = Epi::PERM ? ((R & ~31) + perm32(R & 31)) : R;
        voffA[i] = (unsigned)(R * K + C) * 2u; voffB[i] = (unsigned)(Rb * K + C) * 2u; }
    const size_t kstep = (size_t)(BK * 2);
    const size_t hstep = (size_t)HALF * K * 2;
    const size_t tstep = 2 * hstep;
    const unsigned ldsw = (unsigned)wid * 1024u;
    const int aoff = lds_byte(wr * 64 + fr, fq * 8), boff = lds_byte(wc * 32 + fr, fq * 8);
#define PG8_SA(b, h) (((b) * 2 + (h)) * HTB)
#define PG8_SB(b, h) ((4 + (b) * 2 + (h)) * HTB)
#define PG8_STAGE(bufoff, gbase, voff) do { _Pragma("unroll") for (int _i = 0; _i < 2; ++_i) \
        __builtin_amdgcn_global_load_lds((const unsigned*)((const char*)(gbase) + (voff)[_i]), (PG8_LAS unsigned*)(lds + (bufoff) + ldsw + _i * 8192), 16, 0, 0); } while (0)
#define PG8_LDA(dst, b, h) do { _Pragma("unroll") for (int m = 0; m < 4; ++m) _Pragma("unroll") for (int k = 0; k < 2; ++k) dst[m][k] = *(const PG8_LAS bf16x8*)(lds + PG8_SA(b, h) + aoff + m * 2048 + k * 1024); } while (0)
#define PG8_LDB(dst, b, h) do { _Pragma("unroll") for (int n = 0; n < 2; ++n) _Pragma("unroll") for (int k = 0; k < 2; ++k) dst[n][k] = *(const PG8_LAS bf16x8*)(lds + PG8_SB(b, h) + boff + n * 2048 + k * 1024); } while (0)
#define PG8_MMA(ai, bj, At, Bt) do { __builtin_amdgcn_s_setprio(1); _Pragma("unroll") for (int m = 0; m < 4; ++m) _Pragma("unroll") for (int n = 0; n < 2; ++n) _Pragma("unroll") for (int k = 0; k < 2; ++k) \
        acc[ai][bj][m][n] = __builtin_amdgcn_mfma_f32_16x16x32_bf16(Bt[n][k], At[m][k], acc[ai][bj][m][n], 0, 0, 0); __builtin_amdgcn_s_setprio(0); } while (0)
#define PG8_WAIT_V(n) asm volatile("s_waitcnt vmcnt(" #n ")" ::: "memory")
#define PG8_WAIT_L(n) asm volatile("s_waitcnt lgkmcnt(" #n ")" ::: "memory")
#define PG8_BAR __builtin_amdgcn_s_barrier()
#define PG8_SCHED __builtin_amdgcn_sched_barrier(0)
    Unit cur, nxt; int ui = 0;
    if (!S.next(0, cur)) return;
    f32x4 acc[2][2][4][2];
#pragma unroll
    for (int a = 0; a < 2; ++a)
#pragma unroll
        for (int b = 0; b < 2; ++b)
#pragma unroll
            for (int m = 0; m < 4; ++m)
#pragma unroll
                for (int n = 0; n < 2; ++n) acc[a][b][m][n] = (f32x4){0.f, 0.f, 0.f, 0.f};
    bf16x8 At[4][2], B0[2][2], B1[2][2];
    const char* cA = (const char*)g.A + (size_t)cur.pm * tstep; const char* cB = (const char*)g.Bt + (size_t)cur.pn * tstep;
    S.a_ready(cur);
    if constexpr (SP2) {
        PG8_STAGE(PG8_SB(0, 0), cB, voffB); PG8_STAGE(PG8_SB(0, 1), cB + hstep, voffB); PG8_STAGE(PG8_SA(0, 0), cA, voffA); PG8_STAGE(PG8_SA(0, 1), cA + hstep, voffA);
        if (wr == 1) PG8_BAR;
        PG8_WAIT_V(2); PG8_BAR;
        PG8_STAGE(PG8_SB(1, 0), cB + kstep, voffB); PG8_STAGE(PG8_SA(1, 0), cA + kstep, voffA); PG8_STAGE(PG8_SB(1, 1), cB + hstep + kstep, voffB);
        PG8_WAIT_V(6); PG8_BAR;
    } else {
        PG8_STAGE(PG8_SB(0, 0), cB, voffB); PG8_STAGE(PG8_SA(0, 0), cA, voffA); PG8_STAGE(PG8_SB(0, 1), cB + hstep, voffB); PG8_STAGE(PG8_SA(0, 1), cA + hstep, voffA);
        if (wr == 1) PG8_BAR;
        PG8_WAIT_V(4); PG8_BAR;
        PG8_STAGE(PG8_SB(1, 0), cB + kstep, voffB); PG8_STAGE(PG8_SA(1, 0), cA + kstep, voffA); PG8_STAGE(PG8_SB(1, 1), cB + hstep + kstep, voffB);
        PG8_WAIT_V(6); PG8_BAR;
    }
    for (;;) {
        const bool has_next = S.next(ui + 1, nxt);
        const char* nA = has_next ? (const char*)g.A + (size_t)nxt.pm * tstep : cA; const char* nB = has_next ? (const char*)g.Bt + (size_t)nxt.pn * tstep : cB;
        for (int t = 0; t < nt; t += 2) {
            const bool last = (t == nt - 2);
            const char* a1 = cA + (size_t)(t + 1) * kstep;
            const char* a2 = last ? nA : cA + (size_t)(t + 2) * kstep; const char* b2 = last ? nB : cB + (size_t)(t + 2) * kstep;
            const char* a3 = a2 + kstep; const char* b3 = b2 + kstep;
            if (last && has_next) S.a_ready(nxt);
            if constexpr (SP2) {
            PG8_LDB(B0, 0, 0); PG8_LDB(B1, 0, 1); PG8_SCHED; PG8_LDA(At, 0, 0); PG8_STAGE(PG8_SA(1, 1), a1 + hstep, voffA);
            PG8_WAIT_V(8); PG8_WAIT_L(0); PG8_BAR; PG8_MMA(0, 0, At, B0); PG8_MMA(0, 1, At, B1); PG8_BAR; PG8_SCHED;
            PG8_LDA(At, 0, 1); PG8_STAGE(PG8_SB(0, 0), b2, voffB); PG8_STAGE(PG8_SB(0, 1), b2 + hstep, voffB); PG8_STAGE(PG8_SA(0, 0), a2, voffA);
            PG8_WAIT_V(8); PG8_WAIT_L(0); PG8_BAR; PG8_MMA(1, 0, At, B0); PG8_MMA(1, 1, At, B1); PG8_BAR; PG8_SCHED;
            PG8_LDB(B0, 1, 0); PG8_LDB(B1, 1, 1); PG8_SCHED; PG8_LDA(At, 1, 0); PG8_STAGE(PG8_SA(0, 1), a2 + hstep, voffA);
            PG8_WAIT_V(8); PG8_WAIT_L(0); PG8_BAR; PG8_MMA(0, 0, At, B0); PG8_MMA(0, 1, At, B1); PG8_BAR; PG8_SCHED;
            PG8_LDA(At, 1, 1); PG8_STAGE(PG8_SB(1, 0), b3, voffB); PG8_STAGE(PG8_SB(1, 1), b3 + hstep, voffB); PG8_STAGE(PG8_SA(1, 0), a3, voffA);
            PG8_WAIT_V(8); PG8_WAIT_L(0); PG8_BAR; PG8_MMA(1, 0, At, B0); PG8_MMA(1, 1, At, B1); PG8_BAR; PG8_SCHED;
            } else {
            PG8_LDB(B0, 0, 0); PG8_SCHED; PG8_LDA(At, 0, 0); PG8_STAGE(PG8_SA(1, 1), a1 + hstep, voffA);
            PG8_WAIT_L(8); PG8_BAR; PG8_WAIT_L(0); PG8_MMA(0, 0, At, B0); PG8_BAR; PG8_SCHED;
            PG8_LDB(B1, 0, 1); PG8_STAGE(PG8_SB(0, 0), b2, voffB);
            PG8_BAR; PG8_WAIT_L(0); PG8_MMA(0, 1, At, B1); PG8_BAR;
            PG8_LDA(At, 0, 1); PG8_STAGE(PG8_SA(0, 0), a2, voffA);
            PG8_BAR; PG8_WAIT_L(0); PG8_MMA(1, 0, At, B0); PG8_BAR; PG8_SCHED;
            PG8_STAGE(PG8_SB(0, 1), b2 + hstep, voffB);
            PG8_WAIT_V(6); PG8_BAR; PG8_MMA(1, 1, At, B1); PG8_BAR;
            PG8_LDB(B0, 1, 0); PG8_SCHED; PG8_LDA(At, 1, 0); PG8_STAGE(PG8_SA(0, 1), a2 + hstep, voffA);
            PG8_WAIT_L(8); PG8_BAR; PG8_WAIT_L(0); PG8_MMA(0, 0, At, B0); PG8_BAR; PG8_SCHED;
            PG8_LDB(B1, 1, 1); PG8_STAGE(PG8_SB(1, 0), b3, voffB);
            PG8_BAR; PG8_WAIT_L(0); PG8_MMA(0, 1, At, B1); PG8_BAR;
            PG8_LDA(At, 1, 1); PG8_STAGE(PG8_SA(1, 0), a3, voffA);
            PG8_BAR; PG8_WAIT_L(0); PG8_MMA(1, 0, At, B0); PG8_BAR; PG8_SCHED;
            PG8_STAGE(PG8_SB(1, 1), b3 + hstep, voffB);
            PG8_WAIT_V(6); PG8_BAR; PG8_MMA(1, 1, At, B1); PG8_BAR;
            }
        }
        if constexpr (ALIGN_EPI) { if (wr == 0) PG8_BAR; }
        if constexpr (!Epi::AFTER_DRAIN) { E(acc, cur, wr, wc, fr, fq); S.done(cur); }
        if (!has_next) break;
#pragma unroll
        for (int a = 0; a < 2; ++a)
#pragma unroll
            for (int b = 0; b < 2; ++b)
#pragma unroll
                for (int m = 0; m < 4; ++m)
#pragma unroll
                    for (int n = 0; n < 2; ++n) acc[a][b][m][n] = (f32x4){0.f, 0.f, 0.f, 0.f};
        cur = nxt; cA = nA; cB = nB; ++ui;
        if constexpr (ALIGN_EPI) { if (wr == 1) PG8_BAR; }
    }
    PG8_WAIT_V(0);
    if constexpr (!ALIGN_EPI) { if (wr == 0) PG8_BAR; }
    PG8_BAR;
    if constexpr (Epi::AFTER_DRAIN) { E.fused(acc, cur, wr, wc, fr, fq, lds, wid, lane); S.done(cur); }
#undef PG8_SA
#undef PG8_SB
#undef PG8_STAGE
#undef PG8_LDA
#undef PG8_LDB
#undef PG8_MMA
#undef PG8_WAIT_V
#undef PG8_WAIT_L
#undef PG8_BAR
#undef PG8_SCHED
}
template <class Epi, class Sched, bool ALIGN_EPI = false, bool SP2 = false>
__device__ __forceinline__ void gemm_phase_ga(PG8_LAS unsigned char* lds, const Gemm g, const Sched& S, const Epi& E) {
    int tid_ = threadIdx.x; asm volatile("" : "+v"(tid_));
    const int tid = tid_, wid = __builtin_amdgcn_readfirstlane(tid >> 6), lane = tid & 63, wr = wid >> 2, wc = wid & 3, fr = lane & 15, fq = lane >> 4;
    const int K = g.K, nt = K / BK;
    static_assert(SP2, "gemm_phase_ga: SP2 loop only");
    unsigned voffA[2], voffB[2], colA[2]; int rowA[2];
#pragma unroll
    for (int i = 0; i < 2; ++i) { int R, C; stage_rc(tid * 16 + i * 8192, R, C); const int Rb = Epi::PERM ? ((R & ~31) + perm32(R & 31)) : R;
        voffA[i] = (unsigned)(R * K + C) * 2u; voffB[i] = (unsigned)(Rb * K + C) * 2u; rowA[i] = R; colA[i] = (unsigned)C * 2u; }
    const size_t kstep = (size_t)(BK * 2);
    const size_t hstep = (size_t)HALF * K * 2;
    const size_t tstep = 2 * hstep;
    const unsigned ldsw = (unsigned)wid * 1024u;
    const int aoff = lds_byte(wr * 64 + fr, fq * 8), boff = lds_byte(wc * 32 + fr, fq * 8);
#define PG8_SA(b, h) (((b) * 2 + (h)) * HTB)
#define PG8_SB(b, h) ((4 + (b) * 2 + (h)) * HTB)
#define PG8_STAGE(bufoff, gbase, voff) do { _Pragma("unroll") for (int _i = 0; _i < 2; ++_i) \
        __builtin_amdgcn_global_load_lds((const unsigned*)((const char*)(gbase) + (voff)[_i]), (PG8_LAS unsigned*)(lds + (bufoff) + ldsw + _i * 8192), 16, 0, 0); } while (0)
#define PG8_STAGE_A(bufoff, koff, V0, V1) do { \
        __builtin_amdgcn_global_load_lds((const unsigned*)(A0 + (koff) + (V0)), (PG8_LAS unsigned*)(lds + (bufoff) + ldsw), 16, 0, 0); \
        __builtin_amdgcn_global_load_lds((const unsigned*)(A0 + (koff) + (V1)), (PG8_LAS unsigned*)(lds + (bufoff) + ldsw + 8192), 16, 0, 0); } while (0)
#define PG8_FILLA(V, U) do { _Pragma("unroll") for (int h_ = 0; h_ < 2; ++h_) _Pragma("unroll") for (int i_ = 0; i_ < 2; ++i_) V[h_][i_] = S.row_byte(U, h_ * HALF + rowA[i_]) + colA[i_]; } while (0)
#define PG8_LDA(dst, b, h) do { _Pragma("unroll") for (int m = 0; m < 4; ++m) _Pragma("unroll") for (int k = 0; k < 2; ++k) dst[m][k] = *(const PG8_LAS bf16x8*)(lds + PG8_SA(b, h) + aoff + m * 2048 + k * 1024); } while (0)
#define PG8_LDB(dst, b, h) do { _Pragma("unroll") for (int n = 0; n < 2; ++n) _Pragma("unroll") for (int k = 0; k < 2; ++k) dst[n][k] = *(const PG8_LAS bf16x8*)(lds + PG8_SB(b, h) + boff + n * 2048 + k * 1024); } while (0)
#define PG8_MMA(ai, bj, At, Bt) do { __builtin_amdgcn_s_setprio(1); _Pragma("unroll") for (int m = 0; m < 4; ++m) _Pragma("unroll") for (int n = 0; n < 2; ++n) _Pragma("unroll") for (int k = 0; k < 2; ++k) \
        acc[ai][bj][m][n] = __builtin_amdgcn_mfma_f32_16x16x32_bf16(Bt[n][k], At[m][k], acc[ai][bj][m][n], 0, 0, 0); __builtin_amdgcn_s_setprio(0); } while (0)
#define PG8_WAIT_V(n) asm volatile("s_waitcnt vmcnt(" #n ")" ::: "memory")
#define PG8_WAIT_L(n) asm volatile("s_waitcnt lgkmcnt(" #n ")" ::: "memory")
#define PG8_BAR __builtin_amdgcn_s_barrier()
#define PG8_SCHED __builtin_amdgcn_sched_barrier(0)
    Unit cur, nxt; int ui = 0;
    if (!S.next(0, cur)) return;
    f32x4 acc[2][2][4][2];
#pragma unroll
    for (int a = 0; a < 2; ++a)
#pragma unroll
        for (int b = 0; b < 2; ++b)
#pragma unroll
            for (int m = 0; m < 4; ++m)
#pragma unroll
                for (int n = 0; n < 2; ++n) acc[a][b][m][n] = (f32x4){0.f, 0.f, 0.f, 0.f};
    bf16x8 At[4][2], B0[2][2], B1[2][2];
    const char* A0 = (const char*)g.A; const char* cB = (const char*)g.Bt + (size_t)cur.pn * tstep;
    unsigned cv[2][2], nv[2][2];
    PG8_FILLA(cv, cur);
    S.a_ready(cur);
    if constexpr (SP2) {
        PG8_STAGE(PG8_SB(0, 0), cB, voffB); PG8_STAGE(PG8_SB(0, 1), cB + hstep, voffB); PG8_STAGE_A(PG8_SA(0, 0), 0, cv[0][0], cv[0][1]); PG8_STAGE_A(PG8_SA(0, 1), 0, cv[1][0], cv[1][1]);
        if (wr == 1) PG8_BAR;
        PG8_WAIT_V(2); PG8_BAR;
        PG8_STAGE(PG8_SB(1, 0), cB + kstep, voffB); PG8_STAGE_A(PG8_SA(1, 0), kstep, cv[0][0], cv[0][1]); PG8_STAGE(PG8_SB(1, 1), cB + hstep + kstep, voffB);
        PG8_WAIT_V(6); PG8_BAR;
    } else {
        PG8_STAGE(PG8_SB(0, 0), cB, voffB); PG8_STAGE_A(PG8_SA(0, 0), 0, cv[0][0], cv[0][1]); PG8_STAGE(PG8_SB(0, 1), cB + hstep, voffB); PG8_STAGE_A(PG8_SA(0, 1), 0, cv[1][0], cv[1][1]);
        if (wr == 1) PG8_BAR;
        PG8_WAIT_V(4); PG8_BAR;
        PG8_STAGE(PG8_SB(1, 0), cB + kstep, voffB); PG8_STAGE_A(PG8_SA(1, 0), kstep, cv[0][0], cv[0][1]); PG8_STAGE(PG8_SB(1, 1), cB + hstep + kstep, voffB);
        PG8_WAIT_V(6); PG8_BAR;
    }
    for (;;) {
        const bool has_next = S.next(ui + 1, nxt);
        const char* nB = has_next ? (const char*)g.Bt + (size_t)nxt.pn * tstep : cB;
        if (has_next && nxt.pm != cur.pm) PG8_FILLA(nv, nxt);
        else { nv[0][0] = cv[0][0]; nv[0][1] = cv[0][1]; nv[1][0] = cv[1][0]; nv[1][1] = cv[1][1]; }
        for (int t = 0; t < nt; t += 2) {
            const bool last = (t == nt - 2);
            const size_t k1 = (size_t)(t + 1) * kstep, k2 = last ? (size_t)0 : (size_t)(t + 2) * kstep; const char* b2 = last ? nB : cB + (size_t)(t + 2) * kstep;
            const unsigned w00 = last ? nv[0][0] : cv[0][0], w01 = last ? nv[0][1] : cv[0][1], w10 = last ? nv[1][0] : cv[1][0], w11 = last ? nv[1][1] : cv[1][1];
            const char* b3 = b2 + kstep;
            if (last && has_next) S.a_ready(nxt);
            if constexpr (SP2) {
            PG8_LDB(B0, 0, 0); PG8_LDB(B1, 0, 1); PG8_SCHED; PG8_LDA(At, 0, 0); PG8_STAGE_A(PG8_SA(1, 1), k1, cv[1][0], cv[1][1]);
            PG8_WAIT_V(8); PG8_WAIT_L(0); PG8_BAR; PG8_MMA(0, 0, At, B0); PG8_MMA(0, 1, At, B1); PG8_BAR; PG8_SCHED;
            PG8_LDA(At, 0, 1); PG8_STAGE(PG8_SB(0, 0), b2, voffB); PG8_STAGE(PG8_SB(0, 1), b2 + hstep, voffB); PG8_STAGE_A(PG8_SA(0, 0), k2, w00, w01);
            PG8_WAIT_V(8); PG8_WAIT_L(0); PG8_BAR; PG8_MMA(1, 0, At, B0); PG8_MMA(1, 1, At, B1); PG8_BAR; PG8_SCHED;
            PG8_LDB(B0, 1, 0); PG8_LDB(B1, 1, 1); PG8_SCHED; PG8_LDA(At, 1, 0); PG8_STAGE_A(PG8_SA(0, 1), k2, w10, w11);
            PG8_WAIT_V(8); PG8_WAIT_L(0); PG8_BAR; PG8_MMA(0, 0, At, B0); PG8_MMA(0, 1, At, B1); PG8_BAR; PG8_SCHED;
            PG8_LDA(At, 1, 1); PG8_STAGE(PG8_SB(1, 0), b3, voffB); PG8_STAGE(PG8_SB(1, 1), b3 + hstep, voffB); PG8_STAGE_A(PG8_SA(1, 0), k2 + kstep, w00, w01);
            PG8_WAIT_V(8); PG8_WAIT_L(0); PG8_BAR; PG8_MMA(1, 0, At, B0); PG8_MMA(1, 1, At, B1); PG8_BAR; PG8_SCHED;
            } else {
            PG8_LDB(B0, 0, 0); PG8_SCHED; PG8_LDA(At, 0, 0); PG8_STAGE_A(PG8_SA(1, 1), k1, cv[1][0], cv[1][1]);
            PG8_WAIT_L(8); PG8_BAR; PG8_WAIT_L(0); PG8_MMA(0, 0, At, B0); PG8_BAR; PG8_SCHED;
            PG8_LDB(B1, 0, 1); PG8_STAGE(PG8_SB(0, 0), b2, voffB);
            PG8_BAR; PG8_WAIT_L(0); PG8_MMA(0, 1, At, B1); PG8_BAR;
            PG8_LDA(At, 0, 1); PG8_STAGE_A(PG8_SA(0, 0), k2, w00, w01);
            PG8_BAR; PG8_WAIT_L(0); PG8_MMA(1, 0, At, B0); PG8_BAR; PG8_SCHED;
            PG8_STAGE(PG8_SB(0, 1), b2 + hstep, voffB);
            PG8_WAIT_V(6); PG8_BAR; PG8_MMA(1, 1, At, B1); PG8_BAR;
            PG8_LDB(B0, 1, 0); PG8_SCHED; PG8_LDA(At, 1, 0); PG8_STAGE_A(PG8_SA(0, 1), k2, w10, w11);
            PG8_WAIT_L(8); PG8_BAR; PG8_WAIT_L(0); PG8_MMA(0, 0, At, B0); PG8_BAR; PG8_SCHED;
            PG8_LDB(B1, 1, 1); PG8_STAGE(PG8_SB(1, 0), b3, voffB);
            PG8_BAR; PG8_WAIT_L(0); PG8_MMA(0, 1, At, B1); PG8_BAR;
            PG8_LDA(At, 1, 1); PG8_STAGE_A(PG8_SA(1, 0), k2 + kstep, w00, w01);
            PG8_BAR; PG8_WAIT_L(0); PG8_MMA(1, 0, At, B0); PG8_BAR; PG8_SCHED;
            PG8_STAGE(PG8_SB(1, 1), b3 + hstep, voffB);
            PG8_WAIT_V(6); PG8_BAR; PG8_MMA(1, 1, At, B1); PG8_BAR;
            }
        }
        if constexpr (ALIGN_EPI) { if (wr == 0) PG8_BAR; }
        if constexpr (!Epi::AFTER_DRAIN) { E(acc, cur, wr, wc, fr, fq); S.done(cur); }
        if (!has_next) break;
#pragma unroll
        for (int a = 0; a < 2; ++a)
#pragma unroll
            for (int b = 0; b < 2; ++b)
#pragma unroll
                for (int m = 0; m < 4; ++m)
#pragma unroll
                    for (int n = 0; n < 2; ++n) acc[a][b][m][n] = (f32x4){0.f, 0.f, 0.f, 0.f};
        cur = nxt; cB = nB; ++ui; cv[0][0] = nv[0][0]; cv[0][1] = nv[0][1]; cv[1][0] = nv[1][0]; cv[1][1] = nv[1][1];
        if constexpr (ALIGN_EPI) { if (wr == 1) PG8_BAR; }
    }
    PG8_WAIT_V(0);
    if constexpr (!ALIGN_EPI) { if (wr == 0) PG8_BAR; }
    PG8_BAR;
    if constexpr (Epi::AFTER_DRAIN) { E.fused(acc, cur, wr, wc, fr, fq, lds, wid, lane); S.done(cur); }
#undef PG8_SA
#undef PG8_SB
#undef PG8_STAGE
#undef PG8_STAGE_A
#undef PG8_FILLA
#undef PG8_LDA
#undef PG8_LDB
#undef PG8_MMA
#undef PG8_WAIT_V
#undef PG8_WAIT_L
#undef PG8_BAR
#undef PG8_SCHED
}
}

constexpr int NB = 8, SEQ = 4096, D = 1024, T = NB * SEQ, DEPTH = 2;
constexpr int INW = 3224, PW = 3328;
constexpr int FF = 2816, FFE = 3584, NEXP = 8;
constexpr int NWAVES = 8, NTHR = 512;
constexpr float NORM_EPS = 1e-6f, LOG2E = 1.4426950408889634f, QSCALE = 0.125f * 1.4426950408889634f;
constexpr int C_MQ = 0, C_MK = 256, C_MV = 512, C_MO = 768, C_FQ = 1024, C_FK = 1280, C_FV = 1536, C_SQ = 1792, C_SK = 2048, C_SV = 2304,
              C_NQ = 2560, C_KC = 2816, C_VC = 2880, C_KS = 2944, C_VS = 3008, C_KW = 3072, C_VW = 3136, C_MIF = 3200, C_FF = 3208, C_NG = 3212;
__host__ __device__ __forceinline__ int map_in_col(int c) {
    if (c < 1024) return c;
    if (c < 1792) return 1032 + (c - 1024);
    if (c < 2560) return 1804 + (c - 1792);
    if (c < 2816) return 2572 + (c - 2560);
    if (c < 3200) return 2828 + (c - 2816);
    if (c < 3208) return 1024 + (c - 3200);
    if (c < 3212) return 1800 + (c - 3208);
    if (c < 3224) return 3212 + (c - 3212);
    return -1;
}
constexpr size_t MiB = 1u << 20;
constexpr size_t WS_CTL = 0, CTL_ZERO_BYTES = 1 * MiB;
constexpr size_t WS_MODP = 1 * MiB;
constexpr size_t WS_MOD = 7 * MiB;
constexpr size_t WS_BL = 7 * MiB + 512 * 1024;
constexpr size_t WS_KCMP = 8 * MiB, WS_VCMP = 8 * MiB + 256 * 1024;
constexpr size_t WS_GB = 8 * MiB + 512 * 1024, WS_GI = 9 * MiB, WS_FLOC = 9 * MiB + 512 * 1024, WS_F2 = 10 * MiB;
constexpr size_t WS_G = 10 * MiB + 512 * 1024, WS_MLOC = WS_G + 8192, WS_MPREV = WS_G + 16384, WS_FTOT = WS_G + 24576;
constexpr size_t WS_NCH = 11 * MiB;
constexpr size_t WS_NG = 12 * MiB;
constexpr size_t WS_TOKOF = 14 * MiB, WS_TOKW = 15 * MiB;
constexpr size_t WS_ROWTOK = 16 * MiB, WS_ROWW = 16 * MiB + 512 * 1024;
constexpr size_t WS_WCT = 17 * MiB;
constexpr size_t WS_P0 = WS_BL + 4096;
constexpr size_t WS_GT = WS_BL + 8192;
constexpr size_t WS_U = 1 * MiB;
constexpr size_t WS_WIN = 18 * MiB;
constexpr size_t WS_WOUT = 31 * MiB;
constexpr size_t WS_WGU = 35 * MiB;
constexpr size_t WS_WD = 46 * MiB;
constexpr size_t WS_MWGU = 52 * MiB;
constexpr size_t WS_MWD = 164 * MiB;
constexpr size_t WS_H = 220 * MiB;
constexpr size_t WS_QKC = WS_H, WS_STATE = WS_H + 32 * MiB;
constexpr size_t WS_PROJ = 284 * MiB;
constexpr size_t WS_MIX = 492 * MiB;
constexpr size_t WS_ACT = WS_PROJ;
constexpr size_t WS_Y1 = WS_PROJ;
constexpr size_t WS_ACTE = WS_PROJ + 132 * MiB;
constexpr size_t WS_ACT2 = WS_ACTE + 112 * MiB;
constexpr size_t WS_END = 556 * MiB;
static_assert(WS_ACT2 + (size_t)8 * 256 * 3584 * 2 <= WS_END && WS_ACTE + (size_t)16384 * 3584 * 2 <= WS_ACT2 && WS_Y1 + (size_t)T * D * 2 <= WS_ACTE, "ws map");
constexpr int CHUNK_TILES = 64;
constexpr int CW_TMO = 0, CW_QUEUE = 64, CW_ECNT = 512, CW_BAR = 4096;
constexpr int LDS_BYTES = 160 * 1024, MISC_OFF = LDS_BYTES - 512;

#define GAS __attribute__((address_space(1)))
#define LAS __attribute__((address_space(3)))
#define DI __device__ __forceinline__
typedef unsigned short bf16;
typedef unsigned v4u __attribute__((ext_vector_type(4)));
typedef unsigned v2u __attribute__((ext_vector_type(2)));
typedef float f32x4 __attribute__((ext_vector_type(4)));
typedef float f32x16 __attribute__((ext_vector_type(16)));
typedef short bf16x8 __attribute__((ext_vector_type(8)));
typedef short s16x4 __attribute__((ext_vector_type(4)));
typedef GAS unsigned gu32;
#define RLX_AGENT __ATOMIC_RELAXED, __HIP_MEMORY_SCOPE_AGENT
DI float bf2f(bf16 v) { return __uint_as_float(((unsigned)v) << 16); }
DI float bflo(unsigned w) { return __uint_as_float(w << 16); }
DI float bfhi(unsigned w) { return __uint_as_float(w & 0xffff0000u); }
DI unsigned pk2(float lo, float hi) { typedef float f2_t __attribute__((ext_vector_type(2))); typedef __bf16 b2_t __attribute__((ext_vector_type(2))); f2_t v = {lo, hi}; b2_t b = __builtin_convertvector(v, b2_t); return __builtin_bit_cast(unsigned, b); }
DI bf16 f2bf(float f) { return (bf16)(pk2(f, 0.f) & 0xffffu); }
DI float ex2(float x) { return __builtin_amdgcn_exp2f(x); }
DI float lg2(float x) { return __builtin_amdgcn_logf(x); }
DI float rcp(float x) { return __builtin_amdgcn_rcpf(x); }
DI float wave_sum(float v) {
#pragma unroll
    for (int o = 1; o < 64; o <<= 1) v += __shfl_xor(v, o);
    return v;
}
DI float wave_max(float v) {
#pragma unroll
    for (int o = 1; o < 64; o <<= 1) v = fmaxf(v, __shfl_xor(v, o));
    return v;
}
DI float log_sigmoid(float x) { return fminf(x, 0.f) - 0.6931471805599453f * lg2(1.0f + ex2(-fabsf(x) * LOG2E)); }
DI float sigmoid_f(float x) { return rcp(1.0f + ex2(-x * LOG2E)); }
DI float silu(float x) { return x * sigmoid_f(x); }
#define BLOCK_SYNC() __syncthreads()
#define LDS_BARRIER() asm volatile("s_waitcnt lgkmcnt(0)\n\ts_barrier" ::: "memory")
typedef short v4i16_tr __attribute__((ext_vector_type(4)));
DI s16x4 att_trr(LAS const char* p) { return __builtin_bit_cast(s16x4, __builtin_amdgcn_ds_read_tr16_b64_v4i16((LAS v4i16_tr*)p)); }
#define XB_TMO      128
#define XB_XCNT(j)  (256  + 64 * (j))
#define XB_XSUB(j)  (1280 + 64 * (j))
#define XB_XGEN(j)  (2304 + 64 * (j))
#define XB_TOP      3328
#define XB_TOPGEN   3392
#define XCD_BAR_WORDS 3456
#define XB_SPIN_CAP (1u << 18)

__device__ __forceinline__ unsigned xb_ld(unsigned* p)              { return __hip_atomic_load(p, __ATOMIC_RELAXED, __HIP_MEMORY_SCOPE_AGENT); }
__device__ __forceinline__ unsigned xb_add(unsigned* p, unsigned v) { return __hip_atomic_fetch_add(p, v, __ATOMIC_RELAXED, __HIP_MEMORY_SCOPE_AGENT); }
__device__ __forceinline__ unsigned xb_xcc_id() { return (unsigned)__builtin_amdgcn_s_getreg((3 << 11) | 20) & 0xFu; }
#define XB_SPIN(cond, bar) do { unsigned _sp = 0; while (cond) { __builtin_amdgcn_s_sleep(1); \
    if ((++_sp & 255u) == 0u) { if (xb_ld(&(bar)[XB_TMO])) break; if (_sp > XB_SPIN_CAP) { atomicAdd(&(bar)[XB_TMO], 1u); break; } } } } while (0)

struct XcdBarrier {
    unsigned* bar; unsigned x;
    volatile LAS unsigned* st;
};

__device__ __forceinline__ XcdBarrier xcd_barrier_post(unsigned* bar, volatile LAS unsigned* st) {
    XcdBarrier b; b.bar = bar; b.x = xb_xcc_id(); b.st = st;
    if (threadIdx.x == 0) (void)xb_add(&bar[XB_XCNT(b.x)], 1u);
    return b;
}
__device__ __forceinline__ void xcd_barrier_complete(unsigned* bar, unsigned x, unsigned& nloc, unsigned& nx) {
    const unsigned G = gridDim.x * gridDim.y * gridDim.z;
    unsigned sum, cnt, mine, sp = 0u;
    for (;;) {
        sum = 0u; cnt = 0u; mine = 0u;
#pragma unroll
        for (unsigned j = 0; j < 16; ++j) { const unsigned c = xb_ld(&bar[XB_XCNT(j)]); sum += c; cnt += (c > 0u) ? 1u : 0u; mine = (j == x) ? c : mine; }
        if (sum == G) break;
        __builtin_amdgcn_s_sleep(1);
        if ((++sp & 255u) == 0u) { if (xb_ld(&bar[XB_TMO])) break; if (sp > XB_SPIN_CAP) { atomicAdd(&bar[XB_TMO], 1u); break; } }
    }
    nloc = mine > 0u ? mine : 1u; nx = cnt > 0u ? cnt : 1u;
}

__device__ __forceinline__ void xcd_barrier(const XcdBarrier& b) {
    asm volatile("s_waitcnt vmcnt(0)" ::: "memory");
    __syncthreads();
    if (threadIdx.x == 0) {
        unsigned* bar = b.bar;
        __builtin_amdgcn_s_waitcnt(0);
        unsigned nloc = b.st[0], nx = b.st[1];
        if (nloc == 0u) { xcd_barrier_complete(bar, b.x, nloc, nx); b.st[0] = nloc; b.st[1] = nx; }
        const unsigned old = xb_add(&bar[XB_XSUB(b.x)], 1u);
        const unsigned gen = old / nloc;
        if (old + 1u == (gen + 1u) * nloc) {
            __builtin_amdgcn_fence(__ATOMIC_RELEASE, "agent");
            asm volatile("s_waitcnt vmcnt(0)" ::: "memory");
            const unsigned og = xb_add(&bar[XB_TOP], 1u);
            const unsigned tg = og / nx;
            if (og + 1u == (tg + 1u) * nx) xb_add(&bar[XB_TOPGEN], 1u);
            else XB_SPIN(xb_ld(&bar[XB_TOPGEN]) == tg, bar);
            __builtin_amdgcn_fence(__ATOMIC_ACQUIRE, "agent");
            xb_add(&bar[XB_XGEN(b.x)], 1u);
            asm volatile("s_waitcnt vmcnt(0)" ::: "memory");
        } else {
            XB_SPIN(xb_ld(&bar[XB_XGEN(b.x)]) == gen, bar);
            __builtin_amdgcn_fence(__ATOMIC_ACQUIRE, "agent");
            asm volatile("s_waitcnt vmcnt(0)" ::: "memory");
        }
    }
    __syncthreads();
}

struct Ctx {
    LAS unsigned char* lds;
    volatile LAS unsigned* MISC;
    gu32* ctl;
    int tid, lane, wave, G, blk;
    float* out; unsigned char* ws;
    const void __attribute__((address_space(4)))* ka;
};
#define WSP(T_, off) ((T_*)(C.ws + (off)))
#define KIN(k) (((const float* const __attribute__((address_space(4)))*)C.ka)[k])

DI void tr_load(float (&v_)[32], const float* W, int ldw, int k0, int sc, int lane) {
    const GAS float* wp_ = (const GAS float*)(W + (size_t)(k0 + (lane >> 5)) * ldw + (sc >= 0 ? sc : 0));
#pragma unroll
    for (int i = 0; i < 32; ++i) v_[i] = wp_[(size_t)(2 * i) * ldw];
}
DI void tr_finish(const float (&v_)[32], int sc, int k0, bf16* WT, int ldt, int dstrow0, LAS float* scr, int lane) {
#pragma unroll
    for (int i = 0; i < 32; ++i) scr[(2 * i + (lane >> 5)) * 33 + (lane & 31)] = sc >= 0 ? v_[i] : 0.f;
    asm volatile("s_waitcnt lgkmcnt(0)" ::: "memory");
    const int c = lane & 7;
#pragma unroll
    for (int j = 0; j < 4; ++j) { const int n = (lane >> 3) + 8 * j; const LAS float* s = scr + (8 * c) * 33 + n;
        v4u o; o.x = pk2(s[0 * 33], s[1 * 33]); o.y = pk2(s[2 * 33], s[3 * 33]); o.z = pk2(s[4 * 33], s[5 * 33]); o.w = pk2(s[6 * 33], s[7 * 33]);
        *(GAS v4u*)(WT + (size_t)(dstrow0 + n) * ldt + k0 + 8 * c) = o; }
    asm volatile("s_waitcnt lgkmcnt(0)" ::: "memory");
}
DI void tr_item(const float* W, int ldw, int k0, int sc, bf16* WT, int ldt, int dstrow0, LAS float* scr, int lane) {
    float v_[32];
    tr_load(v_, W, ldw, k0, sc, lane);
    tr_finish(v_, sc, k0, WT, ldt, dstrow0, scr, lane);
}
DI void p_prologue(Ctx& C) {
    const int gw = C.blk * NWAVES + C.wave, NGW = C.G * NWAVES, lane = C.lane;
    LAS float* SC = (LAS float*)(C.lds + 96 * 1024);
    { const GAS float* cin = (const GAS float*)KIN(1);
      for (int i = C.tid; i < NB * D; i += NTHR) SC[i] = silu(cin[i]); }
    BLOCK_SYNC();
    {
        float* MODP = WSP(float, WS_MODP);
        for (int it = gw; it < 2 * 96 * 16; it += NGW) {
            const int ks = it & 15, nb = (it >> 4) % 96, l = it / (16 * 96);
            const int n = nb * 64 + lane; const GAS float* wp = (const GAS float*)(KIN(3) + (size_t)l * D * 6144 + (size_t)(ks * 64) * 6144 + n);
            float acc[8];
#pragma unroll
            for (int b = 0; b < 8; ++b) acc[b] = 0.f;
#pragma unroll 16
            for (int k = 0; k < 64; ++k) { const float w = wp[(size_t)k * 6144];
#pragma unroll
                for (int b = 0; b < 8; ++b) acc[b] += SC[b * D + ks * 64 + k] * w; }
#pragma unroll
            for (int b = 0; b < 8; ++b) MODP[(((size_t)ks * 2 + l) * 8 + b) * 6144 + n] = acc[b];
        }
    }
    if (C.blk == 0 && C.tid < 129) {
        const int n = C.tid; int bucket;
        if (n < 16) bucket = n; else { const int large = 16 + (int)(logf((float)n / 16.0f) / 2.0794415416798357f * 16.0f); bucket = large < 31 ? large : 31; }
        if (n == 128) bucket = 31;
        float* BL = WSP(float, WS_BL);
#pragma unroll
        for (int h = 0; h < 4; ++h) BL[h * 132 + n] = KIN(2)[bucket * 4 + h] * LOG2E;
    }
    if (C.blk == 1 && C.tid < 128) { const int l = C.tid >> 6, d = C.tid & 63; float* gt = WSP(float, WS_GT) + l * 384 + d;
        gt[0] = KIN(13)[l * 64 + d] * QSCALE; gt[64] = KIN(14)[l * 64 + d]; gt[128] = QSCALE; gt[192] = KIN(15)[l * 64 + d] * QSCALE;
        gt[256] = KIN(16)[l * 192 + 64 + d]; gt[320] = KIN(16)[l * 192 + 128 + d]; }
    if (C.blk >= C.G - 4) { const int q = C.blk - (C.G - 4), l = q >> 1, kv = q & 1; LAS float* PS = (LAS float*)(C.lds + 133120);
        const GAS float* W = (const GAS float*)((kv ? KIN(19) : KIN(18)) + (size_t)l * 2048 * 64 + (size_t)(256 * C.wave) * 64 + lane); const GAS float* pos = (const GAS float*)(KIN(17) + (size_t)l * 2048 + 256 * C.wave);
        float a0 = 0.f, a1 = 0.f, a2 = 0.f, a3 = 0.f;
        for (int i0 = 0; i0 < 256; i0 += 32) { float wv[32], pv[32];
#pragma unroll
            for (int i = 0; i < 32; ++i) { wv[i] = W[(size_t)(i0 + i) * 64]; pv[i] = pos[i0 + i]; }
#pragma unroll
            for (int i = 0; i < 32; i += 4) { a0 += pv[i] * wv[i]; a1 += pv[i + 1] * wv[i + 1]; a2 += pv[i + 2] * wv[i + 2]; a3 += pv[i + 3] * wv[i + 3]; } }
        PS[C.wave * 64 + lane] = (a0 + a1) + (a2 + a3);
        BLOCK_SYNC();
        if (C.wave == 0) { float t = 0.f;
#pragma unroll
            for (int w8 = 0; w8 < 8; ++w8) t += PS[w8 * 64 + lane];
            WSP(float, WS_P0)[(l * 2 + kv) * 64 + lane] = t; } }
    LAS float* scr = (LAS float*)(C.lds + C.wave * 8448);
    constexpr int I_IN = 16 * (PW / 32), I_OUT = 16 * 32, I_GU = 16 * (2 * FF / 32), I_D = (FF / 64) * 32;
    constexpr int I_WC = 2 * 2 * 2 * 16 * 2;
    constexpr int NITEMS = 2 * I_IN + 2 * I_OUT + I_GU + I_D + I_WC;
    for (int it = gw; it < NITEMS; it += NGW) {
        int r = it;
        if (r < 2 * I_IN) { const int l = r / I_IN; r -= l * I_IN; const int nblk = PW / 32, kb = r / nblk, nb = r % nblk;
            tr_item(KIN(7) + (size_t)l * D * INW, INW, 64 * kb, map_in_col(32 * nb + (lane & 31)), WSP(bf16, WS_WIN) + (size_t)l * PW * D, D, 32 * nb, scr, lane); continue; }
        r -= 2 * I_IN;
        if (r < 2 * I_OUT) { const int l = r / I_OUT; r -= l * I_OUT; const int kb = r / 32, nb = r % 32;
            tr_item(KIN(8) + (size_t)l * D * D, D, 64 * kb, 32 * nb + (lane & 31), WSP(bf16, WS_WOUT) + (size_t)l * D * D, D, 32 * nb, scr, lane); continue; }
        r -= 2 * I_OUT;
        if (r < I_GU) { const int nblk = 2 * FF / 32, kb = r / nblk, nb = r % nblk; const int pn = nb >> 3, jb = nb & 7;
            tr_item(jb < 4 ? KIN(21) : KIN(22), FF, 64 * kb, pn * 128 + (jb & 3) * 32 + (lane & 31), WSP(bf16, WS_WGU), D, 32 * nb, scr, lane); continue; }
        r -= I_GU;
        if (r < I_D) { const int kb = r / 32, nb = r % 32;
            tr_item(KIN(23), D, 64 * kb, 32 * nb + (lane & 31), WSP(bf16, WS_WD), FF, 32 * nb, scr, lane); continue; }
        r -= I_D;
        { const int nb = r & 1, kb = (r >> 1) & 15, a = (r >> 5) & 1, kv = (r >> 6) & 1, l = r >> 7;
            tr_item((kv ? KIN(19) : KIN(18)) + (size_t)l * 2048 * 64 + (size_t)a * 1024 * 64, 64, 64 * kb, 32 * nb + (lane & 31), WSP(bf16, WS_WCT) + (size_t)(l * 2 + kv) * 128 * 1024, 1024, a * 64 + 32 * nb, scr, lane); }
    }
}
constexpr int MOE_I_MGU = 16 * (2 * FFE / 32), MOE_I_MD = (FFE / 64) * 32, MOE_CONV_ITEMS = NEXP * (MOE_I_MGU + MOE_I_MD);
struct ConvIt { const float* W; int ldw, k0, sc, ldt, dstrow0; bf16* WT; };
DI ConvIt moe_conv_decode(Ctx& C, int r) {
    const int lane = C.lane; ConvIt q;
    if (r < NEXP * MOE_I_MGU) { const int e = r / MOE_I_MGU; r -= e * MOE_I_MGU; const int nblk = 2 * FFE / 32, kb = r / nblk, nb = r % nblk; const int pn = nb >> 3, jb = nb & 7;
        q.W = (jb < 4 ? KIN(26) : KIN(27)) + (size_t)e * D * FFE; q.ldw = FFE; q.k0 = 64 * kb; q.sc = pn * 128 + (jb & 3) * 32 + (lane & 31); q.WT = WSP(bf16, WS_MWGU) + (size_t)e * 2 * FFE * D; q.ldt = D; q.dstrow0 = 32 * nb; return q; }
    r -= NEXP * MOE_I_MGU;
    { const int e = r / MOE_I_MD; r -= e * MOE_I_MD; const int kb = r / 32, nb = r % 32;
        q.W = KIN(28) + (size_t)e * FFE * D; q.ldw = D; q.k0 = 64 * kb; q.sc = 32 * nb + (lane & 31); q.WT = WSP(bf16, WS_MWD) + (size_t)e * D * FFE; q.ldt = FFE; q.dstrow0 = 32 * nb; return q; }
}
DI void moe_conv_items4(Ctx& C, int r0, LAS float* scr) {
    const ConvIt q0 = moe_conv_decode(C, r0), q1 = moe_conv_decode(C, r0 + 1), q2 = moe_conv_decode(C, r0 + 2), q3 = moe_conv_decode(C, r0 + 3);
    float v0[32], v1[32], v2[32], v3[32];
    tr_load(v0, q0.W, q0.ldw, q0.k0, q0.sc, C.lane); tr_load(v1, q1.W, q1.ldw, q1.k0, q1.sc, C.lane); tr_load(v2, q2.W, q2.ldw, q2.k0, q2.sc, C.lane); tr_load(v3, q3.W, q3.ldw, q3.k0, q3.sc, C.lane);
    tr_finish(v0, q0.sc, q0.k0, q0.WT, q0.ldt, q0.dstrow0, scr, C.lane); tr_finish(v1, q1.sc, q1.k0, q1.WT, q1.ldt, q1.dstrow0, scr, C.lane);
    tr_finish(v2, q2.sc, q2.k0, q2.WT, q2.ldt, q2.dstrow0, scr, C.lane); tr_finish(v3, q3.sc, q3.k0, q3.WT, q3.ldt, q3.dstrow0, scr, C.lane);
}
DI void p_modfin(Ctx& C) {
    const float* MODP = WSP(float, WS_MODP); float* MOD = WSP(float, WS_MOD);
    for (int i = C.blk * NTHR + C.tid; i < 2 * 8 * 6144; i += C.G * NTHR) {
        const int n = i % 6144, l = i / (8 * 6144); float s = KIN(4)[l * 6144 + n];
#pragma unroll
        for (int ks = 0; ks < 16; ++ks) s += MODP[(size_t)ks * (2 * 8 * 6144) + i];
        MOD[i] = s;
    }
}

template <bool ROUTE> DI void p_norm(Ctx& C, int l, const float* xin, const float* gain, int off_sh, int off_sc) {
    const int lane = C.lane; bf16* H = WSP(bf16, WS_H);
    const int rows_per_blk = T / C.G;
    const int m_base = C.blk * rows_per_blk, b = m_base >> 12;
    const float* MOD = WSP(float, WS_MOD) + (size_t)(l * 8 + b) * 6144;
    f32x4 gs[4], sh[4];
#pragma unroll
    for (int j = 0; j < 4; ++j) { const int c0 = 4 * lane + 256 * j; const f32x4 g = *(const f32x4*)(gain + c0), sc = *(const f32x4*)(MOD + off_sc + c0); gs[j] = g * (sc + 1.0f); sh[j] = *(const f32x4*)(MOD + off_sh + c0); }
    LAS int* cntL = (LAS int*)(C.lds);
    LAS int* baseL = (LAS int*)(C.lds + 64);
    LAS int* recE = (LAS int*)(C.lds + 1024);
    LAS int* recS = (LAS int*)(C.lds + 1024 + 2048);
    LAS float* recW = (LAS float*)(C.lds + 1024 + 4096);
    LAS float* RW = (LAS float*)(C.lds + 8192);
    if (ROUTE) { if (C.tid < 8) cntL[C.tid] = 0; for (int i = C.tid; i < D * 8 / 4; i += NTHR) *(LAS f32x4*)(RW + 4 * i) = *(const GAS f32x4*)(KIN(24) + 4 * i); BLOCK_SYNC(); }
    f32x4 vn[4];
    { const GAS f32x4* xr0 = (const GAS f32x4*)(xin + (size_t)(m_base + C.wave) * D) + lane;
#pragma unroll
      for (int j = 0; j < 4; ++j) vn[j] = xr0[64 * j]; }
    for (int r = C.wave; r < rows_per_blk; r += NWAVES) {
        const int m = m_base + r;
        f32x4 v[4]; float s = 0.f;
#pragma unroll
        for (int j = 0; j < 4; ++j) v[j] = vn[j];
        if (r + NWAVES < rows_per_blk) { const GAS f32x4* xr1 = (const GAS f32x4*)(xin + (size_t)(m + NWAVES) * D) + lane;
#pragma unroll
            for (int j = 0; j < 4; ++j) vn[j] = xr1[64 * j]; }
#pragma unroll
        for (int j = 0; j < 4; ++j) s += (v[j].x * v[j].x + v[j].y * v[j].y) + (v[j].z * v[j].z + v[j].w * v[j].w);
        const float rstd = 1.0f / sqrtf(wave_sum(s) * (1.0f / D) + NORM_EPS);
        v2u* o8 = (v2u*)(H + (size_t)m * D) + lane;
#pragma unroll
        for (int j = 0; j < 4; ++j) { v[j] = v[j] * rstd * gs[j] + sh[j]; v2u w; w.x = pk2(v[j].x, v[j].y); w.y = pk2(v[j].z, v[j].w); o8[64 * j] = w; }
        if (ROUTE) {
            float lg[8];
#pragma unroll
            for (int e = 0; e < 8; ++e) lg[e] = 0.f;
#pragma unroll
            for (int j = 0; j < 4; ++j)
#pragma unroll
                for (int i = 0; i < 4; ++i) { const LAS float* rw = RW + (4 * lane + 256 * j + i) * 8; const f32x4 w0 = *(const LAS f32x4*)rw, w1 = *(const LAS f32x4*)(rw + 4); const float hv = v[j][i];
                    lg[0] += hv * w0.x; lg[1] += hv * w0.y; lg[2] += hv * w0.z; lg[3] += hv * w0.w; lg[4] += hv * w1.x; lg[5] += hv * w1.y; lg[6] += hv * w1.z; lg[7] += hv * w1.w; }
#pragma unroll
            for (int e = 0; e < 8; ++e) lg[e] = wave_sum(lg[e]) + KIN(25)[e];
            int e0 = 0; float l0 = lg[0];
#pragma unroll
            for (int e = 1; e < 8; ++e) if (lg[e] > l0) { l0 = lg[e]; e0 = e; }
            int e1 = -1; float l1 = -3.0e38f;
#pragma unroll
            for (int e = 0; e < 8; ++e) if (e != e0 && lg[e] > l1) { l1 = lg[e]; e1 = e; }
            const float p1 = ex2((l1 - l0) * LOG2E), w0 = 1.0f / (1.0f + p1), w1 = p1 * w0;
            if (lane == 0) { const int s0 = atomicAdd((int*)&cntL[e0], 1), s1 = atomicAdd((int*)&cntL[e1], 1);
                recE[2 * r] = e0; recE[2 * r + 1] = e1; recS[2 * r] = s0; recS[2 * r + 1] = s1; recW[2 * r] = w0; recW[2 * r + 1] = w1; }
        }
    }
    if (ROUTE) {
        BLOCK_SYNC();
        if (C.tid < 8) baseL[C.tid] = (int)__hip_atomic_fetch_add((unsigned*)(C.ctl + CW_ECNT + C.tid), (unsigned)cntL[C.tid], RLX_AGENT);
        BLOCK_SYNC();
        int* TOKOF = WSP(int, WS_TOKOF); float* TOKW = WSP(float, WS_TOKW);
        for (int i = C.tid; i < 2 * rows_per_blk; i += NTHR) { const int e = recE[i], slot = baseL[e] + recS[i], tok = m_base + (i >> 1);
            TOKOF[e * T + slot] = tok | ((i & 1) << 30); TOKW[e * T + slot] = recW[i]; }
    }
}

DI void prep_unit(Ctx& C, int l, int b, int c, int mode) {
    const int tid = C.tid, lane = C.lane, wave = C.wave;
    bf16* PROJ = WSP(bf16, WS_PROJ); bf16* QKC = WSP(bf16, WS_QKC);
    const int t0 = 64 * c; const size_t m0 = (size_t)b * SEQ + t0;
    LAS char* KWt = (LAS char*)(C.lds); LAS char* Vt = (LAS char*)(C.lds + 49152); LAS float* EW = (LAS float*)(C.lds + 98304);
    constexpr int VP = 192, VTB = 64 * 192;
    v4u xr[11], vr[4];
    { const int rg = tid >> 6, ch0 = (tid & 63) * 8;
#pragma unroll
      for (int i = 0; i < 11; ++i) { const int r = 8 * rg - 3 + i; xr[i] = (r >= 0 || c > 0) ? *(const GAS v4u*)(PROJ + (long)((long)m0 + r) * PW + ch0) : (v4u){0u, 0u, 0u, 0u}; }
#pragma unroll
      for (int hh = 0; hh < 4; ++hh) { const int r = tid >> 3, c8 = tid & 7; vr[hh] = *(const GAS v4u*)(PROJ + (m0 + r) * PW + C_MV + hh * 64 + c8 * 8); } }
    {
        const int hd = wave & 3, bh = b * 4 + hd; const size_t m = m0 + lane;
        if (wave < 4) {
            const float ig = bf2f(PROJ[m * PW + C_MIF + hd]) + KIN(10)[l * 8 + hd], fg = bf2f(PROJ[m * PW + C_MIF + 4 + hd]) + KIN(10)[l * 8 + 4 + hd];
            float bcs = log_sigmoid(fg);
#pragma unroll
            for (int o = 1; o < 64; o <<= 1) { const float t = __shfl_up(bcs, o); if (lane >= o) bcs += t; }
            const float g = __shfl(bcs, 63), w = g - bcs + ig, mloc = wave_max(w);
            EW[hd * 64 + lane] = ex2((w - mloc) * LOG2E);
            WSP(float, WS_GB)[(size_t)bh * SEQ + t0 + lane] = bcs; WSP(float, WS_GI)[(size_t)bh * SEQ + t0 + lane] = ig;
            if (lane == 0) { WSP(float, WS_G)[bh * 64 + c] = g; WSP(float, WS_MLOC)[bh * 64 + c] = mloc; }
        } else {
            const float ff = bf2f(PROJ[m * PW + C_FF + hd]) + KIN(12)[l * 4 + hd];
            float fcs = log_sigmoid(ff);
#pragma unroll
            for (int o = 1; o < 64; o <<= 1) { const float t = __shfl_up(fcs, o); if (lane >= o) fcs += t; }
            WSP(float, WS_FLOC)[(size_t)bh * SEQ + t0 + lane] = fcs;
            if (lane == 63) WSP(float, WS_FTOT)[bh * 64 + c] = fcs;
        }
    }
    LDS_BARRIER();
    {
        const int rg = tid >> 6, cp = tid & 63, ch0 = cp * 8; const float* cw = KIN(9) + (size_t)l * 4 * 512 + ch0;
        float wj[4][8];
#pragma unroll
        for (int j = 0; j < 4; ++j) { const f32x4 a = *(const f32x4*)(cw + j * 512), b4 = *(const f32x4*)(cw + j * 512 + 4); wj[j][0] = a.x; wj[j][1] = a.y; wj[j][2] = a.z; wj[j][3] = a.w; wj[j][4] = b4.x; wj[j][5] = b4.y; wj[j][6] = b4.z; wj[j][7] = b4.w; }
        const bool isk = ch0 >= 256; const int kh = (ch0 - 256) >> 6, kc = ch0 & 63;
#pragma unroll
        for (int i = 0; i < 8; ++i) { const int r = 8 * rg + i; float y[8];
#pragma unroll
            for (int e = 0; e < 8; ++e) { float acc = 0.f;
#pragma unroll
                for (int j = 0; j < 4; ++j) { const v4u xv = xr[i + 3 - j]; const unsigned wd = (e < 2) ? xv.x : (e < 4) ? xv.y : (e < 6) ? xv.z : xv.w; acc += wj[j][e] * ((e & 1) ? bfhi(wd) : bflo(wd)); }
                y[e] = silu(acc) * (isk ? 0.125f : 1.0f); }
            v4u o; o.x = pk2(y[0], y[1]); o.y = pk2(y[2], y[3]); o.z = pk2(y[4], y[5]); o.w = pk2(y[6], y[7]);
            *(GAS v4u*)(QKC + (m0 + r) * 512 + ch0) = o;
            if (isk) { const float ew = EW[kh * 64 + r]; v4u k2; k2.x = pk2(y[0] * ew, y[1] * ew); k2.y = pk2(y[2] * ew, y[3] * ew); k2.z = pk2(y[4] * ew, y[5] * ew); k2.w = pk2(y[6] * ew, y[7] * ew);
                *(LAS v4u*)(KWt + kh * VTB + r * VP + kc * 2) = k2; } }
#pragma unroll
        for (int hh = 0; hh < 4; ++hh) { const int r = tid >> 3, c8 = tid & 7; *(LAS v4u*)(Vt + hh * VTB + r * VP + c8 * 16) = vr[hh]; }
    }
    LDS_BARRIER();
    {
        const int hd = wave & 3, dvh = wave >> 2, bh = b * 4 + hd, h = lane >> 5, i16 = lane & 15, q4 = i16 >> 2, p = i16 & 3, blk = (lane >> 4) & 1;
        LAS const char* va = Vt + hd * VTB + (8 * h + q4) * VP + (32 * dvh + 16 * blk + 4 * p) * 2;
        LAS const char* kb = KWt + hd * VTB + (8 * h + q4) * VP + (16 * blk + 4 * p) * 2;
        float* ST = WSP(float, WS_STATE) + ((size_t)bh * 64 + c) * 4096;
#pragma unroll
        for (int nt = 0; nt < 2; ++nt) {
            f32x16 acc;
#pragma unroll
            for (int r = 0; r < 16; ++r) acc[r] = 0.f;
#pragma unroll
            for (int s = 0; s < 4; ++s) {
                const s16x4 alo = att_trr(va + 16 * s * VP), ahi = att_trr(va + (16 * s + 4) * VP), blo = att_trr(kb + 16 * s * VP + nt * 64), bhi = att_trr(kb + (16 * s + 4) * VP + nt * 64);
                acc = __builtin_amdgcn_mfma_f32_32x32x16_bf16(__builtin_shufflevector(alo, ahi, 0, 1, 2, 3, 4, 5, 6, 7), __builtin_shufflevector(blo, bhi, 0, 1, 2, 3, 4, 5, 6, 7), acc, 0, 0, 0);
            }
#pragma unroll
            for (int r = 0; r < 16; ++r) ST[(32 * dvh + (r & 3) + 8 * (r >> 2) + 4 * h) * 64 + 32 * nt + (lane & 31)] = acc[r];
        }
        if (tid < 256) { const int hh = tid >> 6, dk = tid & 63; float s = 0.f;
#pragma unroll 8
            for (int r = 0; r < 64; ++r) s += bf2f(*(LAS const bf16*)(KWt + hh * VTB + r * VP + dk * 2));
            WSP(float, WS_NCH)[((size_t)(b * 4 + hh) * 64 + c) * 64 + dk] = s; }
    }
    for (int i = tid; i < 64 * 12; i += NTHR) { const int r = i / 12, j = i % 12; WSP(float, WS_NG)[(m0 + r) * 16 + j] = sigmoid_f(bf2f(PROJ[(m0 + r) * PW + C_NG + j]) + KIN(20)[l * 12 + j]); }
    LDS_BARRIER();
}
DI void compress_tile(Ctx& C, int l, int wt) {
    const int lane = C.lane, h = lane >> 5, r32 = lane & 31;
    const int nt = wt & 3, mt = (wt >> 2) & 7, b = (wt >> 5) & 7, kv = wt >> 8;
    const bf16* PROJ = WSP(bf16, WS_PROJ);
    const bf16* ap = PROJ + ((size_t)b * SEQ + 16 * (mt * 32 + r32)) * PW + (kv ? C_VC : C_KC) + 8 * h;
    const bf16* bp = WSP(bf16, WS_WCT) + ((size_t)(l * 2 + kv) * 128 + nt * 32 + r32) * 1024 + 8 * h;
    f32x16 acc;
#pragma unroll
    for (int r = 0; r < 16; ++r) acc[r] = 0.f;
    for (int kq = 0; kq < 4; ++kq) {
        bf16x8 av[16], bv[16];
#pragma unroll
        for (int i = 0; i < 16; ++i) { const int ks = 16 * kq + i;
            av[i] = *(const GAS bf16x8*)(ap + (size_t)(ks >> 2) * PW + 16 * (ks & 3)); bv[i] = *(const GAS bf16x8*)(bp + 16 * ks); }
#pragma unroll
        for (int i = 0; i < 16; ++i) acc = __builtin_amdgcn_mfma_f32_32x32x16_bf16(av[i], bv[i], acc, 0, 0, 0);
    }
    float* U = WSP(float, WS_U) + (((size_t)kv * 8 + b) * 256 + mt * 32) * 128 + nt * 32 + r32;
#pragma unroll
    for (int r = 0; r < 16; ++r) U[(size_t)((r & 3) + 8 * (r >> 2) + 4 * h) * 128] = acc[r];
}
DI void p_prep(Ctx& C, int l, int mode) {
    { const int gw = C.blk * NWAVES + C.wave; if (gw < 512) compress_tile(C, l, gw); }
    for (int u = C.blk; u < NB * 64; u += C.G) prep_unit(C, l, u >> 6, u & 63, mode);
}

DI void p_scan(Ctx& C, int l, bool dry) {
    { const int gw = C.blk * NWAVES + C.wave, NGW = C.G * NWAVES, lane = C.lane; const float* U = WSP(float, WS_U); const float* P0 = WSP(float, WS_P0) + l * 128;
      for (int it = gw; it < 8 * 256; it += NGW) { const int b = it >> 8, n = it & 255; float kx = 0.f, vx = 0.f;
          if (n < 255) { const float* u0 = U + ((size_t)b * 256 + n) * 128; const float* u1 = U + ((size_t)(8 + b) * 256 + n) * 128;
              kx = u0[lane] + u0[128 + 64 + lane] + P0[lane]; vx = u1[lane] + u1[128 + 64 + lane] + P0[64 + lane];
              const float ss = wave_sum(kx * kx); kx = kx / sqrtf(ss * (1.0f / 64.0f) + NORM_EPS) * KIN(16)[l * 192 + lane]; }
          if (!dry) { WSP(bf16, WS_KCMP)[((size_t)b * 256 + n) * 64 + lane] = f2bf(kx); WSP(bf16, WS_VCMP)[((size_t)b * 256 + n) * 64 + lane] = f2bf(vx); } } }
    const int gid = C.blk * NTHR + C.tid;
    for (int g = gid; g < 32 * 4096; g += C.G * NTHR) {
        const int bh = g >> 12, e = g & 4095;
        const float* Gp = WSP(float, WS_G) + bh * 64; const float* ML = WSP(float, WS_MLOC) + bh * 64;
        float* ST = WSP(float, WS_STATE) + (size_t)bh * 64 * 4096 + e; float* NC = WSP(float, WS_NCH) + (size_t)bh * 64 * 64 + e;
        float Cst = 0.f, nst = 0.f, m = 0.f;
        float cc[64];
#pragma unroll
        for (int c = 0; c < 64; ++c) cc[c] = *(const GAS float*)(ST + (size_t)c * 4096);
        const float gq = Gp[C.lane], mq = ML[C.lane];
#pragma unroll
        for (int c = 0; c < 64; ++c) {
            const float nc = (e < 64) ? *(const GAS float*)(NC + c * 64) : 0.f;
            if (!dry) { ST[(size_t)c * 4096] = Cst; if (e < 64) NC[c * 64] = nst;
                if (e == 0) WSP(float, WS_MPREV)[bh * 64 + c] = m; }
            const float gc = __shfl(gq, c), ml = __shfl(mq, c), mn = fmaxf(gc + m, ml), a = ex2((gc + m - mn) * LOG2E), bb = ex2((ml - mn) * LOG2E);
            Cst = a * Cst + bb * cc[c]; nst = a * nst + bb * nc; m = mn;
        }
        { const float* FT = WSP(float, WS_FTOT) + bh * 64; const int ch = e >> 6; const float off = wave_sum((C.lane < ch) ? FT[C.lane] : 0.f);
          const float f2v = (WSP(float, WS_FLOC)[g] + off) * LOG2E; if (!dry) WSP(float, WS_F2)[g] = f2v; else if (f2v == 123.456f) WSP(float, WS_F2)[g] = Cst + nst; }
    }
}

namespace att {
constexpr int KP = 144, VP = 192;
constexpr int KT = 64 * KP, VT = 64 * VP;
constexpr int L_K0 = 0, L_V0 = 3 * KT, L_F = 3 * KT + 3 * VT  , L_BL = L_F + 512, L_IMP = 67584, L_TOT = L_IMP + 65536, L_SEL = L_TOT + 16384, L_FLAG = L_SEL + 512, L_EL = L_FLAG + 64  , L_BL2 = L_EL + 4 * 320 * 4  , L_NST = L_BL2 + 4 * 132 * 4  , L_END = L_NST + 64;
static_assert(L_BL + 4 * 132 * 4 <= L_IMP && L_END <= MISC_OFF, "attention LDS map");
typedef short v4i16_t __attribute__((ext_vector_type(4)));
#define MFMA32(a, b, c) __builtin_amdgcn_mfma_f32_32x32x16_bf16((a), (b), (c), 0, 0, 0)
DI int crow(int r, int h) { return (r & 3) + 8 * (r >> 2) + 4 * h; }
DI s16x4 trr(LAS const char* p) { return __builtin_bit_cast(s16x4, __builtin_amdgcn_ds_read_tr16_b64_v4i16((LAS v4i16_t*)p)); }
struct Stg { v4u k, v; };
DI void stage_load(Stg& s, const bf16* Kg, const bf16* Vg, int ld, int tid) { const int row = tid >> 3, ch = tid & 7; s.k = *(const GAS v4u*)(Kg + (size_t)row * ld + ch * 8); s.v = *(const GAS v4u*)(Vg + (size_t)row * ld + ch * 8); }
DI void stage_store(const Stg& s, LAS char* Kt, LAS char* Vt, int tid) { const int row = tid >> 3, ch = tid & 7; *(LAS v4u*)(Kt + row * KP + ch * 16) = s.k; *(LAS v4u*)(Vt + row * VP + ch * 16) = s.v; }
DI void qkt(f32x16& p0, f32x16& p1, LAS const char* Kt, const bf16x8 (&qf)[4], int lane) {
    LAS const char* kb = Kt + (lane & 31) * KP + (lane >> 5) * 16;
#pragma unroll
    for (int d0 = 0; d0 < 4; ++d0) {
        const bf16x8 a0 = *(LAS const bf16x8*)(kb + d0 * 32), a1 = *(LAS const bf16x8*)(kb + 32 * KP + d0 * 32);
        p0 = MFMA32(a0, qf[d0], p0); p1 = MFMA32(a1, qf[d0], p1);
    }
}
DI bf16x8 pack8(const f32x16& p, int b) { v4u w; w.x = pk2(p[b], p[b + 1]); w.y = pk2(p[b + 2], p[b + 3]); w.z = pk2(p[b + 4], p[b + 5]); w.w = pk2(p[b + 6], p[b + 7]); return __builtin_bit_cast(bf16x8, w); }
DI void pv_packed(f32x16 (&o)[2], LAS const char* Vt, const bf16x8 (&pb)[4], int lane) {
    const int h = lane >> 5, i16 = lane & 15, q4 = i16 >> 2, p = i16 & 3, blk = (lane >> 4) & 1;
    LAS const char* vb = Vt + (4 * h + q4) * VP + (16 * blk + 4 * p) * 2;
#pragma unroll
    for (int hf = 0; hf < 2; ++hf) {
        s16x4 lo[4], hi[4];
#pragma unroll
        for (int i = 0; i < 4; ++i) { const int s = 2 * hf + (i >> 1), dh = i & 1; lo[i] = trr(vb + (16 * s) * VP + dh * 64); hi[i] = trr(vb + (16 * s + 8) * VP + dh * 64); }
        __builtin_amdgcn_sched_barrier(0);
#pragma unroll
        for (int i = 0; i < 4; ++i) { const int s = 2 * hf + (i >> 1), dh = i & 1;
            o[dh] = MFMA32(__builtin_shufflevector(lo[i], hi[i], 0, 1, 2, 3, 4, 5, 6, 7), pb[s], o[dh]); }
    }
}
DI void pack_p(bf16x8 (&pb)[4], const f32x16& p0, const f32x16& p1) { pb[0] = pack8(p0, 0); pb[1] = pack8(p0, 8); pb[2] = pack8(p1, 0); pb[3] = pack8(p1, 8); }
DI void pv(f32x16 (&o)[2], LAS const char* Vt, const f32x16& p0, const f32x16& p1, int lane) { bf16x8 pb[4]; pack_p(pb, p0, p1); pv_packed(o, Vt, pb, lane); }
DI float half_max(float v) { return fmaxf(v, __shfl_xor(v, 32)); }
DI float half_sum(float v) { return v + __shfl_xor(v, 32); }
template <bool MASKED> DI void osm(f32x16& p0, f32x16& p1, float& m_run, float& lsum, f32x16 (&o)[2]) {
    float tm = -1e30f;
#pragma unroll
    for (int r = 0; r < 16; ++r) tm = fmaxf(tm, fmaxf(p0[r], p1[r]));
    tm = half_max(tm);
    const float mn = fmaxf(m_run, tm);
    if (__any(mn > m_run)) {
        const float f = ex2(m_run - mn); m_run = mn; lsum *= f;
#pragma unroll
        for (int r = 0; r < 16; ++r) { o[0][r] *= f; o[1][r] *= f; }
    }
    float ps = 0.f;
#pragma unroll
    for (int r = 0; r < 16; ++r) { float a = ex2(p0[r] - mn), b = ex2(p1[r] - mn); if (MASKED) { a = p0[r] > -1e29f ? a : 0.f; b = p1[r] > -1e29f ? b : 0.f; } p0[r] = a; p1[r] = b; ps += a + b; }
    lsum += ps;
}
DI void osm_fast(f32x16& p0, f32x16& p1, float cb, bool active, float& m_run, float& lsum, f32x16 (&o)[2]) {
    float t0 = fmaxf(p0[0], p1[0]), t1 = fmaxf(p0[1], p1[1]);
#pragma unroll
    for (int r = 2; r < 16; r += 2) { t0 = fmaxf(t0, fmaxf(p0[r], p1[r])); t1 = fmaxf(t1, fmaxf(p0[r + 1], p1[r + 1])); }
    float tm = active ? fmaxf(t0, t1) + cb : -1e30f;
    tm = half_max(tm);
    const float mn = fmaxf(m_run, tm);
    if (__any(mn > m_run)) {
        const float f = ex2(m_run - mn); m_run = mn; lsum *= f;
#pragma unroll
        for (int r = 0; r < 16; ++r) { o[0][r] *= f; o[1][r] *= f; }
    }
    const float e = active ? mn - cb : 1e30f;
    float ps0 = 0.f, ps1 = 0.f;
#pragma unroll
    for (int r = 0; r < 16; ++r) { const float a = ex2(p0[r] - e), b = ex2(p1[r] - e); p0[r] = a; p1[r] = b; ps0 += a; ps1 += b; }
    lsum += ps0 + ps1;
}
DI void store_o(bf16* orow, const f32x16 (&o)[2], float sc, int h) {
#pragma unroll
    for (int dh = 0; dh < 2; ++dh)
#pragma unroll
        for (int g = 0; g < 4; ++g) { v2u w; w.x = pk2(o[dh][4 * g] * sc, o[dh][4 * g + 1] * sc); w.y = pk2(o[dh][4 * g + 2] * sc, o[dh][4 * g + 3] * sc); *(v2u*)(orow + 32 * dh + 8 * g + 4 * h) = w; }
}

DI void fox_tile(LAS const char* Kt, LAS const char* Vt, const LAS float* fk, const bf16x8 (&qf)[4], int key0, bool diag, int tq, float f2q, float& m_run, float& lsum, f32x16 (&o)[2], int lane) {
    const int h = lane >> 5;
    f32x16 p0, p1;
#pragma unroll
    for (int r = 0; r < 16; ++r) { p0[r] = 0.f; p1[r] = 0.f; }
    qkt(p0, p1, Kt, qf, lane);
    if (diag) {
#pragma unroll
        for (int g = 0; g < 4; ++g) { const f32x4 fa = *(const LAS f32x4*)(fk + 8 * g + 4 * h), fb = *(const LAS f32x4*)(fk + 32 + 8 * g + 4 * h);
#pragma unroll
            for (int i = 0; i < 4; ++i) { const int r = 4 * g + i, ka = key0 + 8 * g + 4 * h + i; float sa = p0[r] + (f2q - fa[i]), sb = p1[r] + (f2q - fb[i]);
                if (ka > tq) sa = -1e30f; if (ka + 32 > tq) sb = -1e30f; p0[r] = sa; p1[r] = sb; } }
        osm<true>(p0, p1, m_run, lsum, o);
    } else {
#pragma unroll
        for (int g = 0; g < 4; ++g) { const f32x4 fa = *(const LAS f32x4*)(fk + 8 * g + 4 * h), fb = *(const LAS f32x4*)(fk + 32 + 8 * g + 4 * h);
#pragma unroll
            for (int i = 0; i < 4; ++i) { p0[4 * g + i] -= fa[i]; p1[4 * g + i] -= fb[i]; } }
        osm_fast(p0, p1, f2q, true, m_run, lsum, o);
    }
    pv(o, Vt, p0, p1, lane);
}
DI void fox_tile_s(LAS const char* Kt, LAS const char* Vt, const LAS float* fk, const bf16x8 (&qf)[4], int key0, bool diag, int tq, const f32x16& cq, float& lsum, f32x16 (&o)[2], int lane) {
    const int h = lane >> 5;
    f32x16 p0 = cq, p1 = cq;
    qkt(p0, p1, Kt, qf, lane);
    float ps0 = 0.f, ps1 = 0.f;
    if (diag) {
#pragma unroll
        for (int g = 0; g < 4; ++g) { const f32x4 fa = *(const LAS f32x4*)(fk + 8 * g + 4 * h), fb = *(const LAS f32x4*)(fk + 32 + 8 * g + 4 * h);
#pragma unroll
            for (int i = 0; i < 4; ++i) { const int r = 4 * g + i, ka = key0 + 8 * g + 4 * h + i; float sa = p0[r] - fa[i], sb = p1[r] - fb[i];
                if (ka > tq) sa = -1e30f; if (ka + 32 > tq) sb = -1e30f; const float a = ex2(sa), b = ex2(sb); p0[r] = a; p1[r] = b; ps0 += a; ps1 += b; } }
    } else {
#pragma unroll
        for (int g = 0; g < 4; ++g) { const f32x4 fa = *(const LAS f32x4*)(fk + 8 * g + 4 * h), fb = *(const LAS f32x4*)(fk + 32 + 8 * g + 4 * h);
#pragma unroll
            for (int i = 0; i < 4; ++i) { const int r = 4 * g + i; const float a = ex2(p0[r] - fa[i]), b = ex2(p1[r] - fb[i]); p0[r] = a; p1[r] = b; ps0 += a; ps1 += b; } }
    }
    lsum += ps0 + ps1;
    pv(o, Vt, p0, p1, lane);
}
constexpr int RING = 5, L_KR = 0, L_VR = RING * KT, L_FR = RING * (KT + VT);
static_assert(L_FR + RING * 256 <= L_FLAG, "ring LDS map");
DI void fox_unit(Ctx& C, int l, int b, int hd, int qb) {
    const int tid = C.tid, lane = C.lane, w = C.wave, r32 = lane & 31, h = lane >> 5;
    const bf16* PROJ = WSP(bf16, WS_PROJ); const size_t m0 = (size_t)b * SEQ;
    const bf16* Kg = PROJ + m0 * PW + C_FK + hd * 64; const bf16* Vg = PROJ + m0 * PW + C_FV + hd * 64;
    const float* F2 = WSP(float, WS_F2) + (size_t)(b * 4 + hd) * SEQ;
    LAS char* lds = (LAS char*)C.lds; LAS float* Fr = (LAS float*)(lds + L_FR); volatile LAS int* flag = (volatile LAS int*)(lds + L_FLAG);
    const int tq = 256 * qb + 32 * w + r32;
    bf16x8 qf[4];
    { const bf16* qp = PROJ + (m0 + tq) * PW + C_FQ + hd * 64 + 8 * h;
#pragma unroll
      for (int d0 = 0; d0 < 4; ++d0) qf[d0] = *(const bf16x8*)(qp + 16 * d0); }
    const float f2q = F2[tq];
    const float sbound = ((const LAS float*)(lds + L_NST))[4];
    float lsum = 0.f; f32x16 o[2]; f32x16 cq;
#pragma unroll
    for (int r = 0; r < 16; ++r) { o[0][r] = 0.f; o[1][r] = 0.f; cq[r] = f2q; }
    const int j0 = 4 * qb, jd = j0 + (w >> 1);
#define FOX_LD(S_, F_, j_) do { stage_load(S_, Kg + (size_t)(j_) * 64 * PW, Vg + (size_t)(j_) * 64 * PW, PW, tid); if (tid < 64) F_ = *(const GAS float*)(F2 + (j_) * 64 + tid); } while (0)
#define FOX_ST(S_, F_, j_) do { stage_store(S_, lds + L_KR + ((j_) % RING) * KT, lds + L_VR + ((j_) % RING) * VT, tid); if (tid < 64) Fr[((j_) % RING) * 64 + tid] = F_; } while (0)
    Stg sA, sB; float fA = 0.f, fB = 0.f;
    { Stg s0, s1, s2, s3; float f0 = 0.f, f1 = 0.f, f2 = 0.f, f3 = 0.f; FOX_LD(s0, f0, j0 + 3); FOX_LD(s1, f1, j0 + 2); FOX_LD(s2, f2, j0 + 1); FOX_LD(s3, f3, j0);
      if (j0 - 1 >= 0) FOX_LD(sA, fA, j0 - 1);
      if (j0 - 2 >= 0) FOX_LD(sB, fB, j0 - 2);
      FOX_ST(s0, f0, j0 + 3); FOX_ST(s1, f1, j0 + 2); FOX_ST(s2, f2, j0 + 1); FOX_ST(s3, f3, j0); }
    if (tid < 16) flag[tid] = 0;
    LDS_BARRIER();
#define FOX_STEP(s_, DIAG_, SX_, FX_) { const int t_ = jd - (s_); bool done = true; \
        if (t_ >= 0) { LAS const char* kt_ = lds + L_KR + (t_ % RING) * KT; LAS const char* vt_ = lds + L_VR + (t_ % RING) * VT; const LAS float* ft_ = Fr + (t_ % RING) * 64; asm volatile("" : "+v"(kt_), "+v"(vt_), "+v"(ft_)); \
            fox_tile_s(kt_, vt_, ft_, qf, 64 * t_, DIAG_, tq, cq, lsum, o, lane); \
            if (t_ > 0) { const float fl = *(const GAS float*)(F2 + 64 * t_ - 1); done = __all(sbound + f2q - fl + 40.0f < lg2(lsum)); } } \
        if (lane == 0) flag[((s_) & 1) * 8 + w] = done ? 1 : 0; \
        if (j0 - (s_) - 1 >= 0) FOX_ST(SX_, FX_, j0 - (s_) - 1); \
        LDS_BARRIER(); \
        int alld = 1; _Pragma("unroll") for (int i = 0; i < 8; ++i) alld &= flag[((s_) & 1) * 8 + i]; \
        if (alld) break; \
        if (j0 - (s_) - 3 >= 0) FOX_LD(SX_, FX_, j0 - (s_) - 3); }
    for (int s = 0; ; s += 2) {
        if (s == 0) FOX_STEP(0, true, sA, fA) else FOX_STEP(s, false, sA, fA)
        FOX_STEP(s + 1, false, sB, fB)
    }
#undef FOX_LD
#undef FOX_ST
#undef FOX_STEP
    LDS_BARRIER();
    lsum = half_sum(lsum);
    { int tq2 = tq; asm volatile("" : "+v"(tq2)); store_o(WSP(bf16, WS_MIX) + (m0 + tq2) * 1024 + 256 + hd * 64, o, 1.0f / lsum, h); }
}

DI void fox_unit_safe(Ctx& C, int l, int b, int hd, int qb) {
    const int tid = C.tid, lane = C.lane, w = C.wave, r32 = lane & 31, h = lane >> 5;
    const bf16* PROJ = WSP(bf16, WS_PROJ); const size_t m0 = (size_t)b * SEQ;
    const bf16* Kg = PROJ + m0 * PW + C_FK + hd * 64; const bf16* Vg = PROJ + m0 * PW + C_FV + hd * 64;
    const float* F2 = WSP(float, WS_F2) + (size_t)(b * 4 + hd) * SEQ;
    LAS char* lds = (LAS char*)C.lds; LAS float* Ft = (LAS float*)(lds + L_F);
    const int tq = 256 * qb + 32 * w + r32;
    bf16x8 qf[4];
    { const bf16* qp = PROJ + (m0 + tq) * PW + C_FQ + hd * 64 + 8 * h;
#pragma unroll
      for (int d0 = 0; d0 < 4; ++d0) qf[d0] = *(const bf16x8*)(qp + 16 * d0); }
    const float f2q = F2[tq];
    float m_run = -1e30f, lsum = 0.f; f32x16 o[2];
#pragma unroll
    for (int r = 0; r < 16; ++r) { o[0][r] = 0.f; o[1][r] = 0.f; }
    const int jtop = 4 * qb + 3, jd = 4 * qb + (w >> 1);
    for (int j = jtop; j >= 0; --j) {
        Stg st; stage_load(st, Kg + (size_t)j * 64 * PW, Vg + (size_t)j * 64 * PW, PW, tid); float fv = 0.f; if (tid < 64) fv = F2[j * 64 + tid];
        stage_store(st, lds + L_K0, lds + L_V0, tid); if (tid < 64) Ft[tid] = fv;
        LDS_BARRIER();
        if (j <= jd) fox_tile(lds + L_K0, lds + L_V0, Ft, qf, 64 * j, j == jd, tq, f2q, m_run, lsum, o, lane);
        LDS_BARRIER();
    }
    lsum = half_sum(lsum);
    store_o(WSP(bf16, WS_MIX) + (m0 + tq) * 1024 + 256 + hd * 64, o, 1.0f / lsum, h);
}

constexpr float SB_CUT = -48.0f;
template <bool diag> DI void sb_tile(LAS const char* Kt, LAS const char* Vt, const bf16x8 (&qf)[4], int key0, int tq, float& R2, f32x16 (&o)[2], int lane) {
    const int h = lane >> 5;
    f32x16 p0, p1;
#pragma unroll
    for (int r = 0; r < 16; ++r) { p0[r] = 0.f; p1[r] = 0.f; }
    qkt(p0, p1, Kt, qf, lane);
    float sp[2][16], gs[8];
#pragma unroll
    for (int pi = 0; pi < 2; ++pi)
#pragma unroll
        for (int r = 0; r < 16; ++r) { const float z = pi ? p1[r] : p0[r]; float s = fmaxf(z, 0.f) + lg2(1.0f + ex2(-fabsf(z)));
            if (diag && (key0 + 32 * pi + crow(r, h) >= tq)) s = 0.f; sp[pi][r] = s; }
#pragma unroll
    for (int k = 0; k < 8; ++k) { const int pi = k >> 2, c4 = k & 3; gs[k] = (sp[pi][4 * c4] + sp[pi][4 * c4 + 1]) + (sp[pi][4 * c4 + 2] + sp[pi][4 * c4 + 3]); }
    float Tk[8]; float run = 0.f;
    float og[8];
#pragma unroll
    for (int k = 0; k < 8; ++k) og[k] = __shfl_xor(gs[k], 32);
#pragma unroll
    for (int k = 7; k >= 0; --k) { Tk[k] = run; run += gs[k] + og[k]; }
#pragma unroll
    for (int pi = 0; pi < 2; ++pi)
#pragma unroll
        for (int c4 = 0; c4 < 4; ++c4) { const int k = 4 * pi + c4; const float later = Tk[k] + (h == 0 ? og[k] : 0.f);
            const float s1 = sp[pi][4 * c4 + 1], s2 = sp[pi][4 * c4 + 2], s3 = sp[pi][4 * c4 + 3];
            const float e3 = later, e2 = later + s3, e1 = e2 + s2, e0 = e1 + s1;
            const float ee[4] = {e0, e1, e2, e3};
#pragma unroll
            for (int i = 0; i < 4; ++i) { const int r = 4 * c4 + i; const float z = pi ? p1[r] : p0[r]; const bool msk = diag && (key0 + 32 * pi + crow(r, h) >= tq);
                const float a = msk ? 0.f : ex2(z - sp[pi][r] + R2 - ee[i]); if (pi) p1[r] = a; else p0[r] = a; } }
    R2 -= run;
    pv(o, Vt, p0, p1, lane);
}
DI void sb_unit(Ctx& C, int b, int hd, int qb) {
    const int tid = C.tid, lane = C.lane, w = C.wave, r32 = lane & 31, h = lane >> 5;
    const bf16* PROJ = WSP(bf16, WS_PROJ); const size_t m0 = (size_t)b * SEQ;
    const bf16* Kg = PROJ + m0 * PW + C_SK + hd * 64; const bf16* Vg = PROJ + m0 * PW + C_SV + hd * 64;
    LAS char* lds = (LAS char*)C.lds; volatile LAS int* flag = (volatile LAS int*)(lds + L_FLAG);
    const int tq = 256 * qb + 32 * w + r32;
    bf16x8 qf[4];
    { const bf16* qp = PROJ + (m0 + tq) * PW + C_SQ + hd * 64 + 8 * h;
#pragma unroll
      for (int d0 = 0; d0 < 4; ++d0) qf[d0] = *(const bf16x8*)(qp + 16 * d0); }
    float R2 = 0.f; f32x16 o[2];
#pragma unroll
    for (int r = 0; r < 16; ++r) { o[0][r] = 0.f; o[1][r] = 0.f; }
    const int j0 = 4 * qb, jd = j0 + (w >> 1);
#define SB_LD(S_, j_) stage_load(S_, Kg + (size_t)(j_) * 64 * PW, Vg + (size_t)(j_) * 64 * PW, PW, tid)
#define SB_ST(S_, j_) stage_store(S_, lds + L_KR + ((j_) % RING) * KT, lds + L_VR + ((j_) % RING) * VT, tid)
    Stg sA, sB;
    { Stg s0, s1, s2, s3; SB_LD(s0, j0 + 3); SB_LD(s1, j0 + 2); SB_LD(s2, j0 + 1); SB_LD(s3, j0);
      if (j0 - 1 >= 0) SB_LD(sA, j0 - 1);
      if (j0 - 2 >= 0) SB_LD(sB, j0 - 2);
      SB_ST(s0, j0 + 3); SB_ST(s1, j0 + 2); SB_ST(s2, j0 + 1); SB_ST(s3, j0); }
    if (tid < 16) flag[tid] = 0;
    LDS_BARRIER();
#define SB_STEP(s_, DIAG_, SX_) { const int t_ = jd - (s_); bool done = true; \
        if (t_ >= 0) { done = __all(R2 < SB_CUT); if (!done) { LAS const char* kt_ = lds + L_KR + (t_ % RING) * KT; LAS const char* vt_ = lds + L_VR + (t_ % RING) * VT; asm volatile("" : "+v"(kt_), "+v"(vt_));   \
            sb_tile<DIAG_>(kt_, vt_, qf, 64 * t_, tq, R2, o, lane); done = __all(R2 < SB_CUT); } } \
        if (lane == 0) flag[((s_) & 1) * 8 + w] = done ? 1 : 0; \
        if (j0 - (s_) - 1 >= 0) SB_ST(SX_, j0 - (s_) - 1); \
        LDS_BARRIER(); \
        int alld = 1; _Pragma("unroll") for (int i = 0; i < 8; ++i) alld &= flag[((s_) & 1) * 8 + i]; \
        if (alld) break; \
        if (j0 - (s_) - 3 >= 0) SB_LD(SX_, j0 - (s_) - 3); }
    for (int s = 0; ; s += 2) {
        if (s == 0) SB_STEP(0, true, sA) else SB_STEP(s, false, sA)
        SB_STEP(s + 1, false, sB)
    }
#undef SB_LD
#undef SB_ST
#undef SB_STEP
    LDS_BARRIER();
    { int tq2 = tq; asm volatile("" : "+v"(tq2));
      store_o(WSP(bf16, WS_MIX) + (m0 + tq2) * 1024 + 512 + hd * 64, o, 1.0f, h); }
}
}

namespace att {
template <int MODE> DI void nsa_tile(LAS const char* Kt, LAS const char* Vt, const bf16x8 (&qf)[4], int j, int t, int c, bool active, const LAS float* el, float bfar, float& m_run, float& lsum, f32x16 (&o)[2], int lane, int dry) {
    const int h = lane >> 5;
    f32x16 p0, p1;
#pragma unroll
    for (int r = 0; r < 16; ++r) { p0[r] = 0.f; p1[r] = 0.f; }
    qkt(p0, p1, Kt, qf, lane);
    if (j >= c - 2) {
        const int bd = t - 64 * j - 4 * h; const LAS float* eb = el + (255 - bd); const int bde = active ? bd : -1;
        float bv0[16], bv1[16];
#pragma unroll
        for (int r = 0; r < 16; ++r) { bv0[r] = eb[8 * (r >> 2) + (r & 3)]; bv1[r] = eb[32 + 8 * (r >> 2) + (r & 3)]; }
#pragma unroll
        for (int r = 0; r < 16; ++r) { asm volatile("" : "+v"(bv0[r])); asm volatile("" : "+v"(bv1[r])); }
#pragma unroll
        for (int r = 0; r < 16; ++r) { const int kc = 8 * (r >> 2) + (r & 3);
            p0[r] = (kc <= bde) ? p0[r] + bv0[r] : -1e30f; p1[r] = (kc + 32 <= bde) ? p1[r] + bv1[r] : -1e30f; }
        osm<true>(p0, p1, m_run, lsum, o);
    } else if (MODE == 1 && j == c - 8) {
        const int bd = t - 64 * j - 4 * h - 512;
#pragma unroll
        for (int pi = 0; pi < 2; ++pi)
#pragma unroll
            for (int r = 0; r < 16; ++r) { const int kc = 32 * pi + 8 * (r >> 2) + (r & 3); const bool valid = kc > bd;
                const float s = valid ? (pi ? p1[r] : p0[r]) + bfar : -1e30f; if (pi) p1[r] = s; else p0[r] = s; }
        osm<true>(p0, p1, m_run, lsum, o);
    } else {
        if (!(dry & 16)) osm_fast(p0, p1, bfar, active, m_run, lsum, o);
    }
    if (!(dry & 8)) pv(o, Vt, p0, p1, lane);
}
template <int MODE> DI void nsa_branch(Ctx& C, const bf16* Kg, const bf16* Vg, int j_lo, int j_hi, const bf16* qp, int t, int c, unsigned sel_lo, unsigned sel_hi,
                                       const LAS float* bl, float gate, LAS float* RES, bf16* orow, int dry) {
    const int tid = C.tid, lane = C.lane, h = lane >> 5; LAS char* lds = (LAS char*)C.lds;
    bf16x8 qf[4];
    asm volatile("" : "+v"(qp));
#pragma unroll
    for (int d0 = 0; d0 < 4; ++d0) qf[d0] = *(const bf16x8*)(qp + 16 * d0);
    float m_run = -1e30f, lsum = 0.f; f32x16 o[2];
#pragma unroll
    for (int r = 0; r < 16; ++r) { o[0][r] = 0.f; o[1][r] = 0.f; }
    const float bfar = bl[128]; const LAS float* el = (const LAS float*)(lds + L_EL) + (bl - (const LAS float*)(lds + L_BL2)) / 132 * 320;
    Stg sA, sB;
#define NB_LD(S_, j_) stage_load(S_, Kg + (size_t)(j_) * 64 * PW, Vg + (size_t)(j_) * 64 * PW, PW, tid)
#define NB_ST(S_, buf_) stage_store(S_, lds + L_K0 + (buf_) * KT, lds + L_V0 + (buf_) * VT, tid)
#define NB_ACT(j_) ((MODE == 1) ? true : ((((j_) < 32 ? (sel_lo >> (j_)) : (sel_hi >> ((j_) - 32))) & 1u) != 0u))
    NB_LD(sA, j_lo); NB_ST(sA, 0); if (j_lo + 1 <= j_hi) NB_LD(sB, j_lo + 1);
    LDS_BARRIER();
    for (int j = j_lo; j <= j_hi; j += 2) {
        if (j + 2 <= j_hi && !(dry & 32)) NB_LD(sA, j + 2);
        { const bool act = NB_ACT(j); if (__any(act) && !(dry & 64)) nsa_tile<MODE>(lds + L_K0, lds + L_V0, qf, j, t, c, act, el, bfar, m_run, lsum, o, lane, dry); }
        if (j + 1 <= j_hi && !(dry & 32)) NB_ST(sB, 1);
        LDS_BARRIER();
        if (j + 1 > j_hi) break;
        if (j + 3 <= j_hi && !(dry & 32)) NB_LD(sB, j + 3);
        { const bool act = NB_ACT(j + 1); if (__any(act) && !(dry & 64)) nsa_tile<MODE>(lds + L_K0 + KT, lds + L_V0 + VT, qf, j + 1, t, c, act, el, bfar, m_run, lsum, o, lane, dry); }
        if (j + 2 <= j_hi && !(dry & 32)) NB_ST(sA, 0);
        LDS_BARRIER();
    }
#undef NB_LD
#undef NB_ST
#undef NB_ACT
    lsum = half_sum(lsum); const float sc = lsum > 0.f ? gate / lsum : 0.f;
#pragma unroll
    for (int dh = 0; dh < 2; ++dh)
#pragma unroll
        for (int r = 0; r < 16; ++r) { const float v = RES[(dh * 16 + r) * 64 + lane] + o[dh][r] * sc; if (MODE == 1) o[dh][r] = v; else RES[(dh * 16 + r) * 64 + lane] = v; }
    if (MODE == 1 && orow) store_o(orow, o, 1.0f, h);
}
DI void nsa_selwin(Ctx& C, const bf16* Ks, const bf16* Vs, const bf16* Kw, const bf16* Vw, const bf16* qp, int t, int c, unsigned sel_lo, unsigned sel_hi,
                   const LAS float* bl, float g_sel, float g_win, LAS float* RES, bf16* orow, int dry) {
    const int tid = C.tid, lane = C.lane, h = lane >> 5; LAS char* lds = (LAS char*)C.lds;
    bf16x8 qf[4];
    asm volatile("" : "+v"(qp));
#pragma unroll
    for (int d0 = 0; d0 < 4; ++d0) qf[d0] = *(const bf16x8*)(qp + 16 * d0);
    float m_run = -1e30f, lsum = 0.f; f32x16 o[2];
#pragma unroll
    for (int r = 0; r < 16; ++r) { o[0][r] = 0.f; o[1][r] = 0.f; }
    const float bfar = bl[128]; const LAS float* el = (const LAS float*)(lds + L_EL) + (bl - (const LAS float*)(lds + L_BL2)) / 132 * 320;
    const int nsel = c + 1, jw0 = c >= 8 ? c - 8 : 0, ntot = nsel + (c - jw0 + 1);
    Stg sA, sB;
#define SW_J(v_) ((v_) < nsel ? (v_) : jw0 + ((v_) - nsel))
#define SW_LD(S_, v_) do { const int j_ = SW_J(v_); if ((v_) < nsel) stage_load(S_, Ks + (size_t)j_ * 64 * PW, Vs + (size_t)j_ * 64 * PW, PW, tid); else stage_load(S_, Kw + (size_t)j_ * 64 * PW, Vw + (size_t)j_ * 64 * PW, PW, tid); } while (0)
#define SW_ST(S_, buf_) stage_store(S_, lds + L_K0 + (buf_) * KT, lds + L_V0 + (buf_) * VT, tid)
#define SW_CLOSE() do { lsum = half_sum(lsum); const float sc_ = lsum > 0.f ? g_sel / lsum : 0.f; \
        _Pragma("unroll") for (int dh = 0; dh < 2; ++dh) _Pragma("unroll") for (int r = 0; r < 16; ++r) { RES[(dh * 16 + r) * 64 + lane] += o[dh][r] * sc_; o[dh][r] = 0.f; } \
        m_run = -1e30f; lsum = 0.f; } while (0)
#define SW_TILE(v_, buf_) do { const int j_ = SW_J(v_); \
        if ((v_) == nsel) SW_CLOSE(); \
        if ((v_) < nsel) { const bool act = (((j_ < 32 ? (sel_lo >> j_) : (sel_hi >> (j_ - 32))) & 1u) != 0u); if (__any(act)) nsa_tile<0>(lds + L_K0 + (buf_) * KT, lds + L_V0 + (buf_) * VT, qf, j_, t, c, act, el, bfar, m_run, lsum, o, lane, dry); } \
        else nsa_tile<1>(lds + L_K0 + (buf_) * KT, lds + L_V0 + (buf_) * VT, qf, j_, t, c, true, el, bfar, m_run, lsum, o, lane, dry); } while (0)
    SW_LD(sA, 0); SW_ST(sA, 0); SW_LD(sB, 1);
    LDS_BARRIER();
    for (int v = 0; v < ntot; v += 2) {
        if (v + 2 < ntot) SW_LD(sA, v + 2);
        SW_TILE(v, 0);
        if (v + 1 < ntot) SW_ST(sB, 1);
        LDS_BARRIER();
        if (v + 1 >= ntot) break;
        if (v + 3 < ntot) SW_LD(sB, v + 3);
        SW_TILE(v + 1, 1);
        if (v + 2 < ntot) SW_ST(sA, 0);
        LDS_BARRIER();
    }
#undef SW_J
#undef SW_LD
#undef SW_ST
#undef SW_CLOSE
#undef SW_TILE
    lsum = half_sum(lsum); const float sc = lsum > 0.f ? g_win / lsum : 0.f;
#pragma unroll
    for (int dh = 0; dh < 2; ++dh)
#pragma unroll
        for (int r = 0; r < 16; ++r) o[dh][r] = RES[(dh * 16 + r) * 64 + lane] + o[dh][r] * sc;
    if (orow) store_o(orow, o, 1.0f, h);
}
template <int MODE> DI void nsa_tile_s(LAS const char* Kt, LAS const char* Vt, const bf16x8 (&qf)[4], int j, int t, int c, bool active, const LAS float* el, float& lsum, f32x16 (&o)[2], int lane, int dry) {
    const int h = lane >> 5;
    f32x16 p0, p1;
#pragma unroll
    for (int r = 0; r < 16; ++r) { p0[r] = 0.f; p1[r] = 0.f; }
    LAS const char* kb = Kt + (lane & 31) * KP + h * 16;
    const int i16 = lane & 15, q4 = i16 >> 2, pp = i16 & 3, blk = (lane >> 4) & 1;
    LAS const char* vb = Vt + (4 * h + q4) * VP + (16 * blk + 4 * pp) * 2;
    bf16x8 ka[4], kc2[4]; s16x4 lo[8], hi[8];
#pragma unroll
    for (int d0 = 0; d0 < 4; ++d0) { if (dry & 64) { ka[d0] = qf[d0]; kc2[d0] = qf[d0]; } else { ka[d0] = *(LAS const bf16x8*)(kb + d0 * 32); kc2[d0] = *(LAS const bf16x8*)(kb + 32 * KP + d0 * 32); } }
#pragma unroll
    for (int i = 0; i < 4; ++i) { const int s = i >> 1, dh = i & 1; if (dry & 128) { lo[i] = s16x4{0,0,0,0}; hi[i] = lo[i]; } else { lo[i] = trr(vb + (16 * s) * VP + dh * 64); hi[i] = trr(vb + (16 * s + 8) * VP + dh * 64); } }
    __builtin_amdgcn_sched_barrier(0);
    if (!(dry & 8)) {
#pragma unroll
        for (int d0 = 0; d0 < 4; ++d0) { p0 = MFMA32(ka[d0], qf[d0], p0); p1 = MFMA32(kc2[d0], qf[d0], p1); } }
#pragma unroll
    for (int i = 4; i < 8; ++i) { const int s = i >> 1, dh = i & 1; if (dry & 128) { lo[i] = s16x4{0,0,0,0}; hi[i] = lo[i]; } else { lo[i] = trr(vb + (16 * s) * VP + dh * 64); hi[i] = trr(vb + (16 * s + 8) * VP + dh * 64); } }
    __builtin_amdgcn_sched_barrier(0);
    bf16x8 pb[4];
    float ps0 = 0.f, ps1 = 0.f;
    if (j >= c - 2 && !(dry & 256)) {
        const int bd = t - 64 * j - 4 * h; const LAS float* eb = el + (255 - bd); const int bde = active ? bd : -1;
        float bv0[16], bv1[16];
#pragma unroll
        for (int r = 0; r < 16; ++r) { bv0[r] = eb[8 * (r >> 2) + (r & 3)]; bv1[r] = eb[32 + 8 * (r >> 2) + (r & 3)]; }
#pragma unroll
        for (int r = 0; r < 16; ++r) { asm volatile("" : "+v"(bv0[r])); asm volatile("" : "+v"(bv1[r])); }
#pragma unroll
        for (int r = 0; r < 16; ++r) { const int kc = 8 * (r >> 2) + (r & 3);
            const float a = ex2((kc <= bde) ? p0[r] + bv0[r] : -1e30f), b = ex2((kc + 32 <= bde) ? p1[r] + bv1[r] : -1e30f); p0[r] = a; p1[r] = b; ps0 += a; ps1 += b; }
        pack_p(pb, p0, p1);
    } else if (MODE == 1 && j == c - 8 && !(dry & 256)) {
        const int bd = t - 64 * j - 4 * h - 512;
#pragma unroll
        for (int r = 0; r < 16; ++r) { const int kc = 8 * (r >> 2) + (r & 3);
            const float a = ex2((kc > bd) ? p0[r] : -1e30f), b = ex2((kc + 32 > bd) ? p1[r] : -1e30f); p0[r] = a; p1[r] = b; ps0 += a; ps1 += b; }
        pack_p(pb, p0, p1);
    } else {
        if (!(dry & 2)) {
#pragma unroll
        for (int r = 0; r < 16; ++r) { const float a = ex2(p0[r]), b = ex2(p1[r]); p0[r] = a; p1[r] = b; ps0 += a; ps1 += b; } }
        if (dry & 512) { pb[0] = qf[0]; pb[1] = qf[1]; pb[2] = qf[2]; pb[3] = qf[3]; } else pack_p(pb, p0, p1);
        if (MODE == 0 && !(dry & 512)) {
#pragma unroll
            for (int i = 0; i < 4; ++i) { v4u w = __builtin_bit_cast(v4u, pb[i]); w.x = active ? w.x : 0u; w.y = active ? w.y : 0u; w.z = active ? w.z : 0u; w.w = active ? w.w : 0u; pb[i] = __builtin_bit_cast(bf16x8, w); }
            ps0 = active ? ps0 : 0.f; ps1 = active ? ps1 : 0.f;
        }
    }
    lsum += ps0 + ps1;
    __builtin_amdgcn_sched_barrier(0);
    if (!(dry & 4)) {
#pragma unroll
        for (int i = 0; i < 8; ++i) { const int s = i >> 1, dh = i & 1; o[dh] = MFMA32(__builtin_shufflevector(lo[i], hi[i], 0, 1, 2, 3, 4, 5, 6, 7), pb[s], o[dh]); } }
}
DI void nsa_selwin_s(Ctx& C, const bf16* Ks, const bf16* Vs, const bf16* Kw, const bf16* Vw, const bf16* qp, int t, int c, unsigned sel_lo, unsigned sel_hi,
                     const LAS float* bl, float g_sel, float g_win, LAS float* RES, bf16* orow, int dry) {
    const int tid = C.tid, lane = C.lane, h = lane >> 5; LAS char* lds = (LAS char*)C.lds;
    bf16x8 qf[4];
    asm volatile("" : "+v"(qp));
#pragma unroll
    for (int d0 = 0; d0 < 4; ++d0) qf[d0] = *(const bf16x8*)(qp + 16 * d0);
    float lsum = 0.f; f32x16 o[2];
#pragma unroll
    for (int r = 0; r < 16; ++r) { o[0][r] = 0.f; o[1][r] = 0.f; }
    const float fbf = ex2(bl[128]); const LAS float* el = (const LAS float*)(lds + L_EL) + (bl - (const LAS float*)(lds + L_BL2)) / 132 * 320;
    const int nsel = c + 1, jw0 = c >= 8 ? c - 8 : 0, ntot = nsel + (c - jw0 + 1);
    Stg sA, sB;
#define SW_J(v_) ((v_) < nsel ? (v_) : jw0 + ((v_) - nsel))
#define SW_LD(S_, v_) do { const int j_ = SW_J(v_); if ((v_) < nsel) stage_load(S_, Ks + (size_t)j_ * 64 * PW, Vs + (size_t)j_ * 64 * PW, PW, tid); else stage_load(S_, Kw + (size_t)j_ * 64 * PW, Vw + (size_t)j_ * 64 * PW, PW, tid); } while (0)
#define SW_ST(S_, buf_) stage_store(S_, lds + L_K0 + (buf_) * KT, lds + L_V0 + (buf_) * VT, tid)
#define SW_CLOSE() do { lsum = half_sum(lsum); const float sc_ = lsum > 0.f ? g_sel / lsum : 0.f; \
        _Pragma("unroll") for (int dh = 0; dh < 2; ++dh) _Pragma("unroll") for (int r = 0; r < 16; ++r) { RES[(dh * 16 + r) * 64 + lane] += o[dh][r] * sc_; o[dh][r] = 0.f; } \
        lsum = 0.f; } while (0)
#define SW_TILE(v_, buf_) do { const int j_ = SW_J(v_); \
        if ((v_) == nsel) SW_CLOSE(); \
        if (j_ == c - 2) { lsum *= fbf; _Pragma("unroll") for (int r = 0; r < 16; ++r) { o[0][r] *= fbf; o[1][r] *= fbf; } } \
        if ((v_) < nsel) { const bool act = (((j_ < 32 ? (sel_lo >> j_) : (sel_hi >> (j_ - 32))) & 1u) != 0u); if (!(dry & 16)) nsa_tile_s<0>(lds + L_K0 + (buf_) * KT, lds + L_V0 + (buf_) * VT, qf, j_, t, c, act, el, lsum, o, lane, dry); } \
        else if (!(dry & 16)) nsa_tile_s<1>(lds + L_K0 + (buf_) * KT, lds + L_V0 + (buf_) * VT, qf, j_, t, c, true, el, lsum, o, lane, dry); } while (0)
    SW_LD(sA, 0); SW_ST(sA, 0); SW_LD(sB, 1);
    LDS_BARRIER();
    for (int v = 0; v < ntot; v += 2) {
        if (v + 2 < ntot && !(dry & 32)) SW_LD(sA, v + 2);
        SW_TILE(v, 0);
        if (v + 1 < ntot && !(dry & 32)) SW_ST(sB, 1);
        LDS_BARRIER();
        if (v + 1 >= ntot) break;
        if (v + 3 < ntot && !(dry & 32)) SW_LD(sB, v + 3);
        SW_TILE(v + 1, 1);
        if (v + 2 < ntot && !(dry & 32)) SW_ST(sA, 0);
        LDS_BARRIER();
    }
#undef SW_J
#undef SW_LD
#undef SW_ST
#undef SW_CLOSE
#undef SW_TILE
    lsum = half_sum(lsum); const float sc = lsum > 0.f ? g_win / lsum : 0.f;
#pragma unroll
    for (int dh = 0; dh < 2; ++dh)
#pragma unroll
        for (int r = 0; r < 16; ++r) o[dh][r] = RES[(dh * 16 + r) * 64 + lane] + o[dh][r] * sc;
    if (orow) store_o(orow, o, 1.0f, h);
}
DI void nsa_unit(Ctx& C, int b, int c, int dry) {
    const int tid = C.tid, lane = C.lane, w = C.wave, r32 = lane & 31, h = lane >> 5, hd = w & 3, th = w >> 2;
    const bf16* PROJ = WSP(bf16, WS_PROJ); const size_t m0 = (size_t)b * SEQ;
    LAS char* lds = (LAS char*)C.lds; LAS float* BLl = (LAS float*)(lds + L_BL2); LAS float* IMP = (LAS float*)(lds + L_IMP); LAS float* TOT = (LAS float*)(lds + L_TOT); LAS unsigned* SEL = (LAS unsigned*)(lds + L_SEL);
    const int tl = 32 * th + r32, t = 64 * c + tl;
    bf16x8 qf[4];
    { const bf16* qp = PROJ + (m0 + t) * PW + C_NQ + hd * 64 + 8 * h;
#pragma unroll
      for (int d0 = 0; d0 < 4; ++d0) qf[d0] = *(const bf16x8*)(qp + 16 * d0); }
    const float g0 = WSP(float, WS_NG)[(m0 + t) * 16 + hd * 3];
    const LAS float* bl = BLl + hd * 132;
    f32x16 res[2];
#pragma unroll
    for (int r = 0; r < 16; ++r) { res[0][r] = 0.f; res[1][r] = 0.f; }
    LAS float* MREF = (LAS float*)(lds);
    LAS float* MFIN = (LAS float*)(lds + 4096);
    if (!(dry & 1)) {
        const bf16* Kc = WSP(bf16, WS_KCMP) + (size_t)b * 256 * 64; const bf16* Vc = WSP(bf16, WS_VCMP) + (size_t)b * 256 * 64;
        const int ntc = (4 * c + 2) / 64 + 1, nlim = (t >= 31) ? ((t - 31) >> 4) : -1;
        float m_run = -1e30f, lsum = 0.f, carry = 0.f, mref0 = 0.f, mref1 = 0.f, mref2 = 0.f, mref3 = 0.f; f32x16 o[2];
#pragma unroll
        for (int r = 0; r < 16; ++r) { o[0][r] = 0.f; o[1][r] = 0.f; }
        const float bfar_c = bl[128];
        Stg st; stage_load(st, Kc, Vc, 64, tid); stage_store(st, lds + L_K0, lds + L_V0, tid);
        LDS_BARRIER();
        for (int nt = 0; nt < ntc; ++nt) {
            const int cur = nt & 1;
            if (nt + 1 < ntc) stage_load(st, Kc + (size_t)(nt + 1) * 64 * 64, Vc + (size_t)(nt + 1) * 64 * 64, 64, tid);
            f32x16 p0, p1;
#pragma unroll
            for (int r = 0; r < 16; ++r) { p0[r] = 0.f; p1[r] = 0.f; }
            qkt(p0, p1, lds + L_K0 + cur * KT, qf, lane);
            float tm = -1e30f;
            const bool allfar = c >= 16 * nt + 19;
            if (allfar) {
                float t0 = fmaxf(p0[0], p1[0]), t1 = fmaxf(p0[1], p1[1]);
#pragma unroll
                for (int r = 2; r < 16; r += 2) { t0 = fmaxf(t0, fmaxf(p0[r], p1[r])); t1 = fmaxf(t1, fmaxf(p0[r + 1], p1[r + 1])); }
                tm = fmaxf(t0, t1) + bfar_c;
            } else {
#pragma unroll
            for (int pi = 0; pi < 2; ++pi)
#pragma unroll
                for (int r = 0; r < 16; ++r) { const int n = 64 * nt + 32 * pi + crow(r, h), dist = t - 16 * n - 31; const bool valid = n <= nlim;
                    const int idx = dist < 0 ? 0 : (dist > 128 ? 128 : dist);
                    float bvv = bl[idx]; asm volatile("" : "+v"(bvv));
                    const float s = valid ? (pi ? p1[r] : p0[r]) + bvv : -1e30f; if (pi) p1[r] = s; else p0[r] = s; tm = fmaxf(tm, s); if ((r & 7) == 7) __builtin_amdgcn_sched_barrier(0); }
            }
            tm = half_max(tm); const float mn = fmaxf(m_run, tm), f = ex2(m_run - mn);
            m_run = mn; lsum *= f; carry *= f;
#pragma unroll
            for (int r = 0; r < 16; ++r) { o[0][r] *= f; o[1][r] *= f; }
            float ps = 0.f;
            if (allfar) { const float e = mn - bfar_c;
#pragma unroll
                for (int r = 0; r < 16; ++r) { p0[r] = ex2(p0[r] - e); p1[r] = ex2(p1[r] - e); ps += p0[r] + p1[r]; }
            } else {
#pragma unroll
            for (int r = 0; r < 16; ++r) { p0[r] = p0[r] > -1e29f ? ex2(p0[r] - mn) : 0.f; p1[r] = p1[r] > -1e29f ? ex2(p1[r] - mn) : 0.f; ps += p0[r] + p1[r]; }
            }
            lsum += ps;
            if (nt == 0) mref0 = mn; else if (nt == 1) mref1 = mn; else if (nt == 2) mref2 = mn; else mref3 = mn;
            float A[8], Bp[8], ob[8];
#pragma unroll
            for (int k = 0; k < 8; ++k) { const int pi = k >> 2, c4 = k & 3; const float x0 = pi ? p1[4 * c4] : p0[4 * c4], x1 = pi ? p1[4 * c4 + 1] : p0[4 * c4 + 1], x2 = pi ? p1[4 * c4 + 2] : p0[4 * c4 + 2], x3 = pi ? p1[4 * c4 + 3] : p0[4 * c4 + 3];
                Bp[k] = 0.5f * x3; A[k] = (x0 + x1) + (x2 + Bp[k]); }
#pragma unroll
            for (int k = 0; k < 8; ++k) ob[k] = __shfl_xor(Bp[k], 32);
            LAS float* ip = IMP + (hd * 64 + tl) * 64 + 16 * nt + h;
#pragma unroll
            for (int k = 0; k < 8; ++k) { const float add = (h == 1) ? ob[k] : (k == 0 ? carry : ob[k > 0 ? k - 1 : 0]); ip[2 * k] = A[k] + add; }
            carry = ob[7];
            pv(o, lds + L_V0 + cur * VT, p0, p1, lane);
            if (nt + 1 < ntc) stage_store(st, lds + L_K0 + (cur ^ 1) * KT, lds + L_V0 + (cur ^ 1) * VT, tid);
            LDS_BARRIER();
        }
        lsum = half_sum(lsum); const float inv = lsum > 0.f ? 1.0f / lsum : 0.f;
        if (h == 0) { LAS float* mr = MREF + (hd * 64 + tl) * 4; mr[0] = mref0; mr[1] = mref1; mr[2] = mref2; mr[3] = mref3; MFIN[(hd * 64 + tl) * 2] = m_run; MFIN[(hd * 64 + tl) * 2 + 1] = inv; }
#pragma unroll
        for (int r = 0; r < 16; ++r) { res[0][r] += o[0][r] * (g0 * inv); res[1][r] += o[1][r] * (g0 * inv); }
        LDS_BARRIER();
    }
    if (dry & 1) { if (tid < 128) SEL[tid] = 0xffffffffu; LDS_BARRIER(); } else {
        const int tok = tid >> 3, sub = tid & 7;
        float wsc[4][4];
#pragma unroll
        for (int hh = 0; hh < 4; ++hh) { const float mf = MFIN[(hh * 64 + tok) * 2], il = MFIN[(hh * 64 + tok) * 2 + 1];
#pragma unroll
            for (int q = 0; q < 4; ++q) wsc[hh][q] = ex2(MREF[(hh * 64 + tok) * 4 + q] - mf) * il; }
#pragma unroll
        for (int i = 0; i < 8; ++i) { const int j = sub * 8 + i; float sc;
            if (j == 0 || j == c || j == c - 1) sc = 1e30f * (1.0f - (float)j * 1e-6f); else if (j <= c) sc = ((IMP[(0 * 64 + tok) * 64 + j] * wsc[0][j >> 4] + IMP[(1 * 64 + tok) * 64 + j] * wsc[1][j >> 4]) + IMP[(2 * 64 + tok) * 64 + j] * wsc[2][j >> 4]) + IMP[(3 * 64 + tok) * 64 + j] * wsc[3][j >> 4]; else sc = -1e30f * (1.0f + (float)j * 1e-6f);
            TOT[tok * 64 + j] = sc; }
        LDS_BARRIER();
        float sj[8]; int rk[8];
        { const f32x4 a = *(const LAS f32x4*)(TOT + tok * 64 + sub * 8), b4 = *(const LAS f32x4*)(TOT + tok * 64 + sub * 8 + 4); sj[0] = a.x; sj[1] = a.y; sj[2] = a.z; sj[3] = a.w; sj[4] = b4.x; sj[5] = b4.y; sj[6] = b4.z; sj[7] = b4.w; }
#pragma unroll
        for (int i = 0; i < 8; ++i) rk[i] = 0;
#pragma unroll
        for (int k4 = 0; k4 < 16; ++k4) { const f32x4 v = *(const LAS f32x4*)(TOT + tok * 64 + 4 * k4);
#pragma unroll
            for (int i = 0; i < 8; ++i) rk[i] += (v.x > sj[i] ? 1 : 0) + (v.y > sj[i] ? 1 : 0) + (v.z > sj[i] ? 1 : 0) + (v.w > sj[i] ? 1 : 0); }
        unsigned mlo = 0u, mhi = 0u;
#pragma unroll
        for (int i = 0; i < 8; ++i) { const int j = sub * 8 + i; if (rk[i] < 16) { if (j < 32) mlo |= 1u << j; else mhi |= 1u << (j - 32); } }
        mlo |= __shfl_xor(mlo, 1); mlo |= __shfl_xor(mlo, 2); mlo |= __shfl_xor(mlo, 4);
        mhi |= __shfl_xor(mhi, 1); mhi |= __shfl_xor(mhi, 2); mhi |= __shfl_xor(mhi, 4);
        if (sub == 0) { SEL[tok * 2] = mlo; SEL[tok * 2 + 1] = mhi; }
        LDS_BARRIER();
    }
    const unsigned sel_lo = SEL[tl * 2], sel_hi = SEL[tl * 2 + 1];
    LAS float* RES = IMP + w * 2048;
#pragma unroll
    for (int dh = 0; dh < 2; ++dh)
#pragma unroll
        for (int r = 0; r < 16; ++r) RES[(dh * 16 + r) * 64 + lane] = res[dh][r];
    const bf16* qp2 = PROJ + (m0 + t) * PW + C_NQ + hd * 64 + 8 * h;
    const float* ng2 = WSP(float, WS_NG) + (m0 + t) * 16 + hd * 3;
    {
        const bool stat = NSA_STATIC && __builtin_amdgcn_readfirstlane((int)(((const LAS float*)(lds + L_NST))[hd] <= 100.0f));
        bf16* orow = dry ? (bf16*)nullptr : WSP(bf16, WS_MIX) + (m0 + t) * 1024 + 768 + hd * 64;
        if (stat) nsa_selwin_s(C, PROJ + m0 * PW + C_KS, PROJ + m0 * PW + C_VS, PROJ + m0 * PW + C_KW, PROJ + m0 * PW + C_VW, qp2, t, c, sel_lo, sel_hi, bl, ng2[1], ng2[2], RES, orow, dry);
        else nsa_selwin(C, PROJ + m0 * PW + C_KS, PROJ + m0 * PW + C_VS, PROJ + m0 * PW + C_KW, PROJ + m0 * PW + C_VW, qp2, t, c, sel_lo, sel_hi, bl, ng2[1], ng2[2], RES, orow, 0);
    }
    LDS_BARRIER();
}
}

DI void mlstm_out_unit(Ctx& C, int l, int b, int c) {
    using namespace att;
    const int tid = C.tid, lane = C.lane, w = C.wave, r32 = lane & 31, h = lane >> 5, hd = w & 3, lh = w >> 2;
    const bf16* PROJ = WSP(bf16, WS_PROJ); const bf16* QKC = WSP(bf16, WS_QKC);
    const int t0 = 64 * c; const size_t m0 = (size_t)b * SEQ + t0; const int bh = b * 4 + hd;
    LAS char* lds = (LAS char*)C.lds; LAS char* Kt = lds; LAS char* Vt = lds + 4 * KT; LAS char* Ct = lds + 4 * KT + 4 * VT;
    LAS float* vb = (LAS float*)(lds + 122880); LAS float* vi = (LAS float*)(lds + 123904); LAS float* vn = (LAS float*)(lds + 124928);
    { const int row = tid >> 3, ch = tid & 7;
#pragma unroll
      for (int hh = 0; hh < 4; ++hh) {
          *(LAS v4u*)(Kt + hh * KT + row * KP + ch * 16) = *(const GAS v4u*)(QKC + (m0 + row) * 512 + 256 + hh * 64 + ch * 8);
          *(LAS v4u*)(Vt + hh * VT + row * VP + ch * 16) = *(const GAS v4u*)(PROJ + (m0 + row) * PW + C_MV + hh * 64 + ch * 8);
          const float* cp = WSP(float, WS_STATE) + ((size_t)(b * 4 + hh) * 64 + c) * 4096 + row * 64 + ch * 8; const f32x4 c0 = *(const GAS f32x4*)cp, c1 = *(const GAS f32x4*)(cp + 4);
          v4u pc; pc.x = pk2(c0.x, c0.y); pc.y = pk2(c0.z, c0.w); pc.z = pk2(c1.x, c1.y); pc.w = pk2(c1.z, c1.w);
          *(LAS v4u*)(Ct + hh * KT + row * KP + ch * 16) = pc; }
      if (tid < 256) { const int hh = tid >> 6, i = tid & 63, bh2 = b * 4 + hh; vb[tid] = *(const GAS float*)(WSP(float, WS_GB) + (size_t)bh2 * SEQ + t0 + i); vi[tid] = *(const GAS float*)(WSP(float, WS_GI) + (size_t)bh2 * SEQ + t0 + i); vn[tid] = *(const GAS float*)(WSP(float, WS_NCH) + ((size_t)bh2 * 64 + c) * 64 + i); } }
    const int lq = 32 * lh + r32; const size_t m = m0 + lq;
    bf16x8 qf[4];
    { const bf16* qp = QKC + m * 512 + hd * 64 + 8 * h;
#pragma unroll
      for (int d0 = 0; d0 < 4; ++d0) qf[d0] = *(const bf16x8*)(qp + 16 * d0); }
    const float mprev = WSP(float, WS_MPREV)[bh * 64 + c];
    LDS_BARRIER();
    const float b_l = vb[hd * 64 + lq];
    f32x16 p0, p1;
#pragma unroll
    for (int r = 0; r < 16; ++r) { p0[r] = 0.f; p1[r] = 0.f; }
    qkt(p0, p1, Kt + hd * KT, qf, lane);
    float dl0[16], dl1[16]; float dmax = -1e30f;
#pragma unroll
    for (int g = 0; g < 4; ++g) { const f32x4 ba = *(const LAS f32x4*)(vb + hd * 64 + 8 * g + 4 * h), bb = *(const LAS f32x4*)(vb + hd * 64 + 32 + 8 * g + 4 * h), ia = *(const LAS f32x4*)(vi + hd * 64 + 8 * g + 4 * h), ib = *(const LAS f32x4*)(vi + hd * 64 + 32 + 8 * g + 4 * h);
#pragma unroll
        for (int i = 0; i < 4; ++i) { const int r = 4 * g + i, s = 8 * g + 4 * h + i; const float da = (s <= lq) ? b_l - ba[i] + ia[i] : -1e30f, db = (s + 32 <= lq) ? b_l - bb[i] + ib[i] : -1e30f; dl0[r] = da; dl1[r] = db; dmax = fmaxf(dmax, fmaxf(da, db)); } }
    dmax = half_max(dmax);
    const float m_inter = b_l + mprev, m_t = fmaxf(dmax, m_inter), inter_w = ex2((m_inter - m_t) * LOG2E);
    float dsum = 0.f;
#pragma unroll
    for (int r = 0; r < 16; ++r) { const float wa = dl0[r] > -1e29f ? ex2((dl0[r] - m_t) * LOG2E) : 0.f, wb = dl1[r] > -1e29f ? ex2((dl1[r] - m_t) * LOG2E) : 0.f; p0[r] *= wa; p1[r] *= wb; dsum += p0[r] + p1[r]; }
    dsum = half_sum(dsum);
    float nq = 0.f;
#pragma unroll
    for (int d0 = 0; d0 < 4; ++d0)
#pragma unroll
        for (int j = 0; j < 8; ++j) nq += bf2f((bf16)qf[d0][j]) * vn[hd * 64 + 16 * d0 + 8 * h + j];
    nq = half_sum(nq);
    const float den = dsum + inter_w * nq, dinv = 1.0f / fmaxf(fabsf(den), ex2(-m_t * LOG2E));
    f32x16 o[2];
#pragma unroll
    for (int r = 0; r < 16; ++r) { o[0][r] = 0.f; o[1][r] = 0.f; }
    qkt(o[0], o[1], Ct + hd * KT, qf, lane);
#pragma unroll
    for (int r = 0; r < 16; ++r) { o[0][r] *= inter_w; o[1][r] *= inter_w; }
    pv(o, Vt + hd * VT, p0, p1, lane);
    float ss = 0.f;
#pragma unroll
    for (int r = 0; r < 16; ++r) { o[0][r] *= dinv; o[1][r] *= dinv; ss += o[0][r] * o[0][r] + o[1][r] * o[1][r]; }
    ss = half_sum(ss);
    const float rs = 1.0f / sqrtf(ss * (1.0f / 64.0f) + NORM_EPS);
    const bf16* op = PROJ + m * PW + C_MO + hd * 64; const float* og = KIN(11) + l * 256 + hd * 64; bf16* orow = WSP(bf16, WS_MIX) + m * 1024 + hd * 64;
    v2u owv[2][4]; f32x4 ggv[2][4];
#pragma unroll
    for (int dh = 0; dh < 2; ++dh)
#pragma unroll
        for (int g = 0; g < 4; ++g) { const int d = 32 * dh + 8 * g + 4 * h; owv[dh][g] = *(const GAS v2u*)(op + d); ggv[dh][g] = *(const GAS f32x4*)(og + d); }
#pragma unroll
    for (int dh = 0; dh < 2; ++dh)
#pragma unroll
        for (int g = 0; g < 4; ++g) { const int d = 32 * dh + 8 * g + 4 * h; const v2u ow = owv[dh][g]; const f32x4 gg = ggv[dh][g];
            const float y0 = o[dh][4 * g] * rs * gg.x * sigmoid_f(bflo(ow.x)), y1 = o[dh][4 * g + 1] * rs * gg.y * sigmoid_f(bfhi(ow.x)), y2 = o[dh][4 * g + 2] * rs * gg.z * sigmoid_f(bflo(ow.y)), y3 = o[dh][4 * g + 3] * rs * gg.w * sigmoid_f(bfhi(ow.y));
            v2u pw; pw.x = pk2(y0, y1); pw.y = pk2(y2, y3); *(v2u*)(orow + d) = pw; }
    LDS_BARRIER();
}

DI void p_mix(Ctx& C0, int l, int rp) {
    volatile LAS unsigned* bc = C0.MISC + 4;
    {
      const GAS float* BLg = (const GAS float*)(C0.ws + WS_BL); LAS float* BLl = (LAS float*)(C0.lds + att::L_BL2); LAS float* ELl = (LAS float*)(C0.lds + att::L_EL);
      for (int i = C0.tid; i < 4 * 132; i += NTHR) BLl[i] = BLg[i];
      for (int i = C0.tid; i < 4 * 320; i += NTHR) { const int hh = i / 320, dist = 255 - (i % 320); ELl[i] = dist >= 128 ? BLg[hh * 132 + 128] : (dist >= 0 ? BLg[hh * 132 + dist] : 0.f); }
      if (C0.wave == 0) { const Ctx& C = C0;
          const int ln = C0.lane; const float gq = wave_max(fabsf(KIN(15)[l * 64 + ln])), gk = wave_max(fmaxf(fabsf(KIN(16)[l * 192 + 64 + ln]), fabsf(KIN(16)[l * 192 + 128 + ln])));
          const float b0 = 64.0f * QSCALE * gq * gk * 1.02f + 0.5f;
          { const float fq = wave_max(fabsf(KIN(13)[l * 64 + ln])), fk = wave_max(fabsf(KIN(14)[l * 64 + ln])); if (ln == 0) ((LAS float*)(C0.lds + att::L_NST))[4] = 64.0f * QSCALE * fq * fk * 1.02f + 0.5f; }
#pragma unroll
          for (int hh = 0; hh < 4; ++hh) { const float mb = wave_max(fmaxf(fmaxf(fabsf(BLg[hh * 132 + ln]), fabsf(BLg[hh * 132 + 64 + ln])), fabsf(BLg[hh * 132 + 128]))); if (ln == 0) ((LAS float*)(C0.lds + att::L_NST))[hh] = b0 + mb; } }
      LDS_BARRIER(); }
    constexpr int NREG = 16 * 96 + 512, NCONV = MOE_CONV_ITEMS / 32;
    const int total = (l == 0) ? 14 * ((NCONV + 5) / 6 > (NREG + 7) / 8 ? (NCONV + 5) / 6 : (NREG + 7) / 8) : NREG;
    for (;;) {
        Ctx C = C0; { unsigned char* wsv = C0.ws; asm volatile("" : "+s"(wsv)); C.ws = wsv; int t_ = C0.tid; asm volatile("" : "+v"(t_)); C.tid = t_; C.lane = t_ & 63; }
        if (C.tid == 0) bc[0] = __hip_atomic_fetch_add((unsigned*)(C.ctl + CW_QUEUE + 64 * l + 16 * rp), 1u, RLX_AGENT);
        LDS_BARRIER();
        const int vidx = (int)bc[0];
        LDS_BARRIER();
        if (vidx >= total) break;
        int idx = vidx, cidx = -1;
#if QORDER == 1
        if (l == 0) { if (vidx >= NREG) { idx = NREG; cidx = vidx - NREG; } }
#else
        if (l == 0) { const int g = vidx / 14, r13 = vidx % 14; if (r13 < 8) idx = 8 * g + r13; else { idx = NREG; cidx = 6 * g + (r13 - 8); } }
#endif
        if (cidx >= 0) { if (cidx < NCONV && rp == 0) { LAS float* scr = (LAS float*)(C.lds + C.wave * 8448);
                moe_conv_items4(C, cidx * 32 + C.wave * 4, scr); LDS_BARRIER(); }
            continue; }
        if (idx >= NREG) continue;
        if (idx < 16 * 96) { const int lvl = idx / 96, r = idx % 96, qb = 15 - lvl;
            if (r < 32) { if (MIX_FOX && (rp == 0 || (RPF & 1))) { const bool fst = (FOX_STATIC == 2) || FOX_STATIC && __builtin_amdgcn_readfirstlane((int)(((const LAS float*)(C.lds + att::L_NST))[4] <= 100.0f)); if (fst) att::fox_unit(C, l, r >> 2, r & 3, qb); else att::fox_unit_safe(C, l, r >> 2, r & 3, qb); } }
            else if (r < 64) { if (MIX_SB && (rp == 0 || (RPF & 2))) att::sb_unit(C, (r - 32) >> 2, (r - 32) & 3, qb); }
            else { if (MIX_NSA && (rp == 0 || (RPF & 4))) att::nsa_unit(C, (r - 64) >> 2, 4 * qb + ((r - 64) & 3), rp == 0 ? 0 : NSADRY); } }
        else { if (MIX_MLSTM && (rp == 0 || (RPF & 8))) mlstm_out_unit(C, l, (idx - 16 * 96) >> 6, (idx - 16 * 96) & 63); }
    }
}

struct MoeL { int c0, c1, c2, c3, c4, c5, c6, c7, p1, p2, p3, p4, p5, p6, p7, p8; };
DI MoeL moe_layout(Ctx& C) {
    MoeL L;
#define LDC(e) ((int)__hip_atomic_load(C.ctl + CW_ECNT + (e), RLX_AGENT))
    L.c0 = LDC(0); L.c1 = LDC(1); L.c2 = LDC(2); L.c3 = LDC(3); L.c4 = LDC(4); L.c5 = LDC(5); L.c6 = LDC(6); L.c7 = LDC(7);
#undef LDC
    L.p1 = (L.c0 + 255) >> 8; L.p2 = L.p1 + ((L.c1 + 255) >> 8); L.p3 = L.p2 + ((L.c2 + 255) >> 8); L.p4 = L.p3 + ((L.c3 + 255) >> 8);
    L.p5 = L.p4 + ((L.c4 + 255) >> 8); L.p6 = L.p5 + ((L.c5 + 255) >> 8); L.p7 = L.p6 + ((L.c6 + 255) >> 8); L.p8 = L.p7 + ((L.c7 + 255) >> 8);
    return L;
}
DI void p_combine(Ctx& C, bool dry) {
    const bf16* Y1 = WSP(bf16, WS_Y1);
    const size_t N8 = (size_t)T * D / 8, st = (size_t)C.G * NTHR;
    for (size_t i = (size_t)C.blk * NTHR + C.tid; i < N8; i += 2 * st) {
        const size_t i2 = i + st; const bool two = i2 < N8; const size_t j2 = two ? i2 : i;
        const v4u y = *(const GAS v4u*)(Y1 + i * 8), y2 = *(const GAS v4u*)(Y1 + j2 * 8); f32x4* o = (f32x4*)(C.out + i * 8); f32x4* o2 = (f32x4*)(C.out + j2 * 8);
        f32x4 a = *(const GAS f32x4*)o, b = *(const GAS f32x4*)(o + 1), a2 = *(const GAS f32x4*)o2, b2 = *(const GAS f32x4*)(o2 + 1);
        a.x += bflo(y.x); a.y += bfhi(y.x); a.z += bflo(y.y); a.w += bfhi(y.y); b.x += bflo(y.z); b.y += bfhi(y.z); b.z += bflo(y.w); b.w += bfhi(y.w);
        a2.x += bflo(y2.x); a2.y += bfhi(y2.x); a2.z += bflo(y2.y); a2.w += bfhi(y2.y); b2.x += bflo(y2.z); b2.y += bfhi(y2.z); b2.z += bflo(y2.w); b2.w += bfhi(y2.w);
        if (!dry) { o[0] = a; o[1] = b; if (two) { o2[0] = a2; o2[1] = b2; } } else if (a.x == 123.456f) o[0] = b2;
    }
}

constexpr int PH_L = 20, NPH = 2 + 2 * PH_L;
struct Args { const float* in[29]; float* out; unsigned char* ws; int ph_lo, ph_hi; };
extern __shared__ __attribute__((aligned(16))) unsigned char lds_raw[];
template <class P> DI P* uni(P* p) { const unsigned long long v = (unsigned long long)p; const unsigned lo = __builtin_amdgcn_readfirstlane((unsigned)v), hi = __builtin_amdgcn_readfirstlane((unsigned)(v >> 32)); return (P*)(((unsigned long long)hi << 32) | lo); }
DI int uni(int v) { return __builtin_amdgcn_readfirstlane(v); }
DI MoeL uni(MoeL L) { MoeL R; R.c0 = uni(L.c0); R.c1 = uni(L.c1); R.c2 = uni(L.c2); R.c3 = uni(L.c3); R.c4 = uni(L.c4); R.c5 = uni(L.c5); R.c6 = uni(L.c6); R.c7 = uni(L.c7);
    R.p1 = uni(L.p1); R.p2 = uni(L.p2); R.p3 = uni(L.p3); R.p4 = uni(L.p4); R.p5 = uni(L.p5); R.p6 = uni(L.p6); R.p7 = uni(L.p7); R.p8 = uni(L.p8); return R; }
DI pg8::MoeMap mk_map(const MoeL& L, unsigned char* ws) { pg8::MoeMap m; m.c0 = L.c0; m.c1 = L.c1; m.c2 = L.c2; m.c3 = L.c3; m.c4 = L.c4; m.c5 = L.c5; m.c6 = L.c6; m.c7 = L.c7;
    m.p1 = L.p1; m.p2 = L.p2; m.p3 = L.p3; m.p4 = L.p4; m.p5 = L.p5; m.p6 = L.p6; m.p7 = L.p7; m.tokof = (const int*)(ws + WS_TOKOF); m.tokw = (const float*)(ws + WS_TOKW); return m; }
DI void mk_ctx(Ctx& C, unsigned char* ws, float* out) {
    ws = uni(ws); out = uni(out);
    { const void __attribute__((address_space(4)))* ka = (const void __attribute__((address_space(4)))*)__builtin_amdgcn_kernarg_segment_ptr(); asm volatile("" : "+s"(ka), "+s"(ws), "+s"(out)); C.ka = ka; }
    C.lds = (LAS unsigned char*)lds_raw; C.MISC = (volatile LAS unsigned*)(C.lds + MISC_OFF);
    { int t_ = threadIdx.x; asm volatile("" : "+v"(t_)); C.tid = t_; }
    C.lane = C.tid & 63; C.wave = __builtin_amdgcn_readfirstlane(C.tid >> 6); C.G = gridDim.x; C.blk = blockIdx.x;
    C.ws = ws; C.ctl = (gu32*)(ws + WS_CTL); C.out = out;
}
#ifndef PH_NOINLINE
#define PH_NOINLINE 0
#endif
#if PH_NOINLINE
#define PHFN __device__ __noinline__ void
#else
#define PHFN DI void
#endif
PHFN f_prologue(unsigned char* ws, float* out) { Ctx C; mk_ctx(C, ws, out); p_prologue(C); }
PHFN f_modfin(unsigned char* ws, float* out) { Ctx C; mk_ctx(C, ws, out); p_modfin(C); }
PHFN f_norm1(unsigned char* ws, float* out, int l) { l = uni(l); Ctx C; mk_ctx(C, ws, out); out = C.out; p_norm<false>(C, l, (l == 0) ? KIN(0) : (const float*)out, KIN(5) + l * D, 0, 1024); }
PHFN f_norm2(unsigned char* ws, float* out, int l) { l = uni(l); Ctx C; mk_ctx(C, ws, out); out = C.out; p_norm<false>(C, l, out, KIN(6) + l * D, 3072, 4096); }
PHFN f_norm2r(unsigned char* ws, float* out, int l) { l = uni(l); Ctx C; mk_ctx(C, ws, out); out = C.out; p_norm<true>(C, l, out, KIN(6) + l * D, 3072, 4096); }
PHFN f_gemm_in(unsigned char* ws, float* out, int l, int dry) { l = uni(l); dry = uni(dry); Ctx C; mk_ctx(C, ws, out);
    pg8::Gemm g{WSP(bf16, WS_H), WSP(bf16, WS_WIN) + (size_t)l * PW * D, T, PW, D}; pg8::StaticOrder S; S.init(T, PW, C.G, C.blk);
    pg8::EpiBf16N E{WSP(bf16, WS_PROJ), PW, WSP(float, WS_GT) + l * 384, (PG8_LAS float*)(C.lds + 131072), dry}; pg8::gemm_phase<pg8::EpiBf16N, pg8::StaticOrder, true, true>(C.lds, g, S, E); }
PHFN f_prep(unsigned char* ws, float* out, int l, int mode) { l = uni(l); mode = uni(mode); Ctx C; mk_ctx(C, ws, out); p_prep(C, l, mode); }
PHFN f_scan(unsigned char* ws, float* out, int l, int dry) { l = uni(l); dry = uni(dry); Ctx C; mk_ctx(C, ws, out); p_scan(C, l, dry != 0); }
PHFN f_mix(unsigned char* ws, float* out, int l, int rp) { l = uni(l); rp = uni(rp); Ctx C; mk_ctx(C, ws, out); p_mix(C, l, rp); }
PHFN f_gemm_res(unsigned char* ws, float* out, const bf16* A, const bf16* Bt, int K, const float* base, const float* gate, int dry) { dry = uni(dry); A = uni(A); Bt = uni(Bt); K = uni(K); base = uni(base); gate = uni(gate); Ctx C; mk_ctx(C, ws, out); out = C.out;
    pg8::Gemm g{A, Bt, T, D, K}; pg8::StaticOrder S; S.init(T, D, C.G, C.blk);
    pg8::EpiResGate E{base, out, gate, D, 6144, dry}; pg8::gemm_phase<pg8::EpiResGate, pg8::StaticOrder, true, true>(C.lds, g, S, E); }
PHFN f_gu(unsigned char* ws, float* out, int dry) { dry = uni(dry); Ctx C; mk_ctx(C, ws, out);
    pg8::Gemm g{WSP(bf16, WS_H), WSP(bf16, WS_WGU), T, 2 * FF, D}; pg8::StaticOrder S; S.init(T, 2 * FF, C.G, C.blk);
    pg8::EpiSwiGLU E{WSP(bf16, WS_ACT), FF, 2 * FF / 256, 0, dry}; pg8::gemm_phase<pg8::EpiSwiGLU, pg8::StaticOrder, GU_ALIGN, true>(C.lds, g, S, E); }
PHFN f_mgu(unsigned char* ws, float* out, MoeL L, int t0, int nt, int dry) { dry = uni(dry); L = uni(L); t0 = uni(t0); nt = uni(nt); Ctx C; mk_ctx(C, ws, out);
    pg8::Gemm g{WSP(bf16, WS_H), WSP(bf16, WS_MWGU), 0, 0, D};
    pg8::MoeOrder S{t0, nt, 2 * FFE / 256, C.G, C.blk, 0, mk_map(L, C.ws)};
    pg8::EpiSwiGLU E{t0 == 256 ? WSP(bf16, WS_ACT2) : WSP(bf16, WS_ACTE), FFE, 2 * FFE / 256, t0 * 256, dry}; pg8::gemm_phase_ga<pg8::EpiSwiGLU, pg8::MoeOrder, GU_ALIGN, true>(C.lds, g, S, E); }
PHFN f_mdown(unsigned char* ws, float* out, MoeL L, int t0, int nt, const float* gate, int dry) { dry = uni(dry); L = uni(L); t0 = uni(t0); nt = uni(nt); gate = uni(gate); Ctx C; mk_ctx(C, ws, out); out = C.out;
    pg8::Gemm g{t0 == 256 ? WSP(bf16, WS_ACT2) : WSP(bf16, WS_ACTE), WSP(bf16, WS_MWD), 0, 0, FFE};
    pg8::MoeOrder S{t0, nt, D / 256, C.G, C.blk, t0, mk_map(L, C.ws)};
    pg8::EpiMoeDown E{mk_map(L, C.ws), out, WSP(bf16, WS_Y1), gate, 6144, t0, D / 256, dry};
    pg8::gemm_phase<pg8::EpiMoeDown, pg8::MoeOrder, true, true>(C.lds, g, S, E); }
PHFN f_mgu_tail(unsigned char* ws, float* out, MoeL L, int t0, int ntail, const float* gate) { L = uni(L); t0 = uni(t0); ntail = uni(ntail); gate = uni(gate); Ctx C; mk_ctx(C, ws, out); out = C.out;
    { pg8::Gemm g{WSP(bf16, WS_ACT2), WSP(bf16, WS_MWD), 0, 0, FFE};
      pg8::MoeOrder S{256, ntail, D / 256, C.G, C.blk, 256, mk_map(L, C.ws)};
      pg8::EpiMoeDown E{mk_map(L, C.ws), out, WSP(bf16, WS_Y1), gate, 6144, 256, D / 256, 0};
      pg8::gemm_phase<pg8::EpiMoeDown, pg8::MoeOrder, true, true>(C.lds, g, S, E); }
    { pg8::Gemm g{WSP(bf16, WS_H), WSP(bf16, WS_MWGU), 0, 0, D};
      pg8::MoeOrderB S{t0, 2 * FFE / 256, C.blk, 4 * ntail, mk_map(L, C.ws)};
      pg8::EpiSwiGLU E{WSP(bf16, WS_ACTE), FFE, 2 * FFE / 256, t0 * 256, 0}; pg8::gemm_phase_ga<pg8::EpiSwiGLU, pg8::MoeOrderB, GU_ALIGN, true>(C.lds, g, S, E); }
}
PHFN f_combine(unsigned char* ws, float* out, int dry) { dry = uni(dry); Ctx C; mk_ctx(C, ws, out); p_combine(C, dry != 0); }

__global__ void __launch_bounds__(NTHR, 2) fwd(Args args) {
    unsigned char* const ws = args.ws; float* const out = args.out;
    volatile LAS unsigned* MISC = (volatile LAS unsigned*)((LAS unsigned char*)lds_raw + MISC_OFF);
    for (int u = threadIdx.x; u < (LDS_BYTES - MISC_OFF) / 4; u += NTHR) MISC[u] = 0u;
    __syncthreads();
    const int lo = args.ph_lo, hi = args.ph_hi;
    XcdBarrier bar; bar.bar = (unsigned*)(ws + WS_CTL) + CW_BAR; bar.x = 0; bar.st = nullptr;
    if (hi - lo > 1) bar = xcd_barrier_post((unsigned*)(ws + WS_CTL) + CW_BAR, MISC + 0);
#define IN(k) (lo <= (k) && (k) < hi)
#define SEAM(k) do { if (IN(k) && IN((k) + 1)) xcd_barrier(bar); } while (0)
    if (EN_PRO && IN(0)) for (int rp_ = 0; rp_ < REP_PRO; ++rp_) f_prologue(ws, out); SEAM(0);
    if (EN_PRO && IN(1)) f_modfin(ws, out); SEAM(1);
    for (int xb_ = 0; xb_ < XTRA_BAR; ++xb_) xcd_barrier(bar);
#pragma unroll 1
    for (int l = 0; l < DEPTH; ++l) {
        const int pb = 2 + PH_L * l;
        const float* MOD = (const float*)(ws + WS_MOD) + (size_t)l * 8 * 6144;
        if (EN_NORM && IN(pb + 0)) for (int rp_ = 0; rp_ < REP_NORM; ++rp_) f_norm1(ws, out, l); SEAM(pb + 0);
        if (EN_GIN && IN(pb + 1)) for (int rp_ = 0; rp_ < REP_GIN; ++rp_) f_gemm_in(ws, out, l, rp_ ? GDRY : 0); SEAM(pb + 1);
        if (EN_PREP && IN(pb + 2)) for (int rp_ = 0; rp_ < REP_PREP; ++rp_) f_prep(ws, out, l, rp_ == 0 ? 0 : PREP_RMODE); SEAM(pb + 2);
        if (EN_SCAN && IN(pb + 3)) for (int rp_ = 0; rp_ < REP_THIN; ++rp_) f_scan(ws, out, l, rp_); SEAM(pb + 3);
        if (EN_MIX && IN(pb + 4)) for (int rp_ = 0; rp_ < REP_MIX; ++rp_) f_mix(ws, out, l, rp_); SEAM(pb + 4);
        if (EN_GOUT && IN(pb + 5)) for (int rp_ = 0; rp_ < REP_RES; ++rp_) f_gemm_res(ws, out, (const bf16*)(ws + WS_MIX), (const bf16*)(ws + WS_WOUT) + (size_t)l * D * D, D, (l == 0) ? ((const float* const __attribute__((address_space(4)))*)__builtin_amdgcn_kernarg_segment_ptr())[0] : (const float*)out, MOD + 2048, rp_); SEAM(pb + 5);
        if (l == 0) {
            if (EN_NORM && IN(pb + 6)) for (int rp_ = 0; rp_ < REP_THIN; ++rp_) f_norm2(ws, out, l); SEAM(pb + 6);
            if (EN_GU && IN(pb + 7)) for (int rp_ = 0; rp_ < REP_GU; ++rp_) f_gu(ws, out, rp_ ? GDRY : 0); SEAM(pb + 7);
            if (EN_DOWN && IN(pb + 8)) for (int rp_ = 0; rp_ < REP_RES; ++rp_) f_gemm_res(ws, out, (const bf16*)(ws + WS_ACT), (const bf16*)(ws + WS_WD), FF, out, MOD + 5120, rp_); SEAM(pb + 8);
        } else {
            if (EN_MOE && IN(pb + 6)) f_norm2r(ws, out, l); SEAM(pb + 6);
            Ctx C; mk_ctx(C, ws, out);
            const MoeL L = uni(moe_layout(C));
            const int ntail = L.p8 - 4 * CHUNK_TILES;
            if (EN_MGU && IN(pb + 8)) for (int rp_ = 0; rp_ < REP_GU; ++rp_) f_mgu(ws, out, L, 0, CHUNK_TILES, rp_ ? GDRY : 0); SEAM(pb + 8);
            if (EN_MDOWN && IN(pb + 9)) f_mdown(ws, out, L, 0, CHUNK_TILES, MOD + 5120, 0); SEAM(pb + 9);
            if (ntail > 0) { if (EN_MGU && IN(pb + 10)) f_mgu(ws, out, L, 4 * CHUNK_TILES, ntail, 0); SEAM(pb + 10); }
            if (ntail > 0) { if (EN_MGU && IN(pb + 11)) f_mgu_tail(ws, out, L, CHUNK_TILES, ntail, MOD + 5120); }
            else { if (EN_MGU && IN(pb + 11)) f_mgu(ws, out, L, CHUNK_TILES, CHUNK_TILES, 0); }
            SEAM(pb + 11);
            if (EN_MDOWN && IN(pb + 12)) f_mdown(ws, out, L, CHUNK_TILES, CHUNK_TILES, MOD + 5120, 0); SEAM(pb + 12);
            if (EN_MGU && IN(pb + 13)) for (int rp_ = 0; rp_ < REP_GU; ++rp_) f_mgu(ws, out, L, 2 * CHUNK_TILES, CHUNK_TILES, rp_ ? GDRY : 0); SEAM(pb + 13);
            if (EN_MDOWN && IN(pb + 14)) f_mdown(ws, out, L, 2 * CHUNK_TILES, CHUNK_TILES, MOD + 5120, 0); SEAM(pb + 14);
            if (EN_MGU && IN(pb + 15)) for (int rp_ = 0; rp_ < REP_GU; ++rp_) f_mgu(ws, out, L, 3 * CHUNK_TILES, CHUNK_TILES, rp_ ? GDRY : 0); SEAM(pb + 15);
            if (EN_MDOWN && IN(pb + 16)) f_mdown(ws, out, L, 3 * CHUNK_TILES, CHUNK_TILES, MOD + 5120, 0); SEAM(pb + 16);
            if (EN_MOE && IN(pb + 18)) for (int rp_ = 0; rp_ < REP_THIN; ++rp_) f_combine(ws, out, rp_);
        }
    }
#undef IN
#undef SEAM
}

extern "C" void kernel_launch(void* const* d_in, const int* in_sizes, int n_in, void* d_out, int out_size, void* d_ws, size_t ws_size, hipStream_t stream) {
    static int grid = 0;
    if (grid == 0) {
        if (n_in != 29 || in_sizes[0] != T * D || out_size != T * D || ws_size < WS_END) { fprintf(stderr, "kernel_launch: unexpected shapes (n_in %d, in0 %d, out %d, ws %zu)\n", n_in, n_in > 0 ? in_sizes[0] : -1, out_size, ws_size); grid = -1; return; }
        if (hipFuncSetAttribute((const void*)fwd, hipFuncAttributeMaxDynamicSharedMemorySize, LDS_BYTES) != hipSuccess) { fprintf(stderr, "kernel_launch: hipFuncSetAttribute failed\n"); grid = -1; return; }
        int dev = 0, cus = 0, per_cu = 0;
        (void)hipGetDevice(&dev); (void)hipDeviceGetAttribute(&cus, hipDeviceAttributeMultiprocessorCount, dev);
        if (hipOccupancyMaxActiveBlocksPerMultiprocessor(&per_cu, (const void*)fwd, NTHR, LDS_BYTES) != hipSuccess || per_cu < 1) fprintf(stderr, "kernel_launch: occupancy query says %d per CU\n", per_cu);
        (void)hipGetLastError();
        grid = 256;
        if (cus < 256) fprintf(stderr, "kernel_launch: device has %d CUs; this kernel needs 256\n", cus);
    }
    if (grid < 0) return;
    (void)hipMemsetAsync((char*)d_ws + WS_CTL, 0, CTL_ZERO_BYTES, stream);
    Args a{};
    for (int i = 0; i < 29; ++i) a.in[i] = (const float*)d_in[i];
    a.out = (float*)d_out; a.ws = (unsigned char*)d_ws;
#if N_LAUNCHES == 1
    a.ph_lo = 0; a.ph_hi = NPH;
    hipLaunchKernelGGL(fwd, dim3(grid), dim3(NTHR), LDS_BYTES, stream, a);
#else
    for (int k = 0; k < NPH; ++k) {
        const int r = (k - 2) % PH_L; if (k >= 2 && ((k < 2 + PH_L && r > 8) || (k >= 2 + PH_L && r > 18))) continue;
        a.ph_lo = k; a.ph_hi = k + 1;
        hipLaunchKernelGGL(fwd, dim3(grid), dim3(NTHR), LDS_BYTES, stream, a);
    }
#endif
}
```
